# Optimizing an MI355X kernel written in HIP

```python
import math
import jax, jax.numpy as jnp
from jax import lax
import numpy as np

D_MODEL = 2048
BATCH = 1
SEQ = 8192
DEPTH = 1

CHUNK = 64
MIX_WIDTH = D_MODEL
ATTN_WIDTH = MIX_WIDTH // 2
HEAD_DIM = 128
N_ATTN_HEADS = ATTN_WIDTH // HEAD_DIM
SSM_WIDTH = MIX_WIDTH - ATTN_WIDTH
SSM_GROUP = 16
N_SSM_GROUPS = SSM_WIDTH // SSM_GROUP
SSM_STATE = 64
IN_WIDTH = 3 * ATTN_WIDTH + N_ATTN_HEADS + SSM_WIDTH
D_FF = 256 * ((8 * D_MODEL // 3 + 255) // 256)
CONV_WIDTH = 3
Q_BLOCK = 128
N_MOD = 6
EPS = 1e-6
DT_MIN = 1e-3
DT_MAX = 1e-1

kernel_name = "hybrid_fox_s5_convffn_adaln"


def rms_norm(x, g):
    xf = x.astype(jnp.float32)
    y = xf * lax.rsqrt(jnp.mean(xf * xf, axis=-1, keepdims=True) + EPS)
    return (y * g.astype(jnp.float32)).astype(x.dtype)


def modulate(h, shift, scale):
    return h * (1 + scale[:, None, :]) + shift[:, None, :]


def forgetting_attention(q, k, v, f_logit):
    B, S, H, Dh = q.shape
    log_f = jax.nn.log_sigmoid(f_logit.astype(jnp.float32))
    cum = jnp.transpose(jnp.cumsum(log_f, axis=1), (0, 2, 1))
    scale = Dh ** -0.5
    outs = []
    for blk in range(S // Q_BLOCK):
        q0 = blk * Q_BLOCK
        q1 = q0 + Q_BLOCK
        qb = q[:, q0:q1]
        kb = k[:, :q1]
        vb = v[:, :q1]
        s = jnp.einsum('bqhd,bkhd->bhqk', qb, kb, preferred_element_type=jnp.float32) * scale
        s = s + (cum[:, :, q0:q1, None] - cum[:, :, None, :q1])
        t_idx = q0 + jnp.arange(Q_BLOCK)
        s_idx = jnp.arange(q1)
        causal = s_idx[None, :] <= t_idx[:, None]
        s = jnp.where(causal, s, -jnp.inf)
        p = jax.nn.softmax(s, axis=-1)
        outs.append(jnp.einsum('bhqk,bkhd->bqhd', p.astype(vb.dtype), vb))
    return jnp.concatenate(outs, axis=1)


def s5_ssm(u, a_re, a_im, log_dt, b_re, b_im, c_re, c_im, d_skip):
    B, S, _ = u.shape
    uf = u.astype(jnp.float32).reshape(B, S, N_SSM_GROUPS, SSM_GROUP)
    a_re = a_re.astype(jnp.float32)
    a_im = a_im.astype(jnp.float32)
    dt = jnp.exp(log_dt.astype(jnp.float32))[:, None]
    mag = jnp.exp(dt * a_re)
    ab_re = mag * jnp.cos(dt * a_im)
    ab_im = mag * jnp.sin(dt * a_im)
    n_re = ab_re - 1
    n_im = ab_im
    den = a_re * a_re + a_im * a_im
    z_re = (n_re * a_re + n_im * a_im) / den
    z_im = (n_im * a_re - n_re * a_im) / den
    bu_re = jnp.einsum('bsgh,gph->bsgp', uf, b_re.astype(jnp.float32))
    bu_im = jnp.einsum('bsgh,gph->bsgp', uf, b_im.astype(jnp.float32))
    e_re = z_re * bu_re - z_im * bu_im
    e_im = z_re * bu_im + z_im * bu_re
    a_re_t = jnp.broadcast_to(ab_re, e_re.shape)
    a_im_t = jnp.broadcast_to(ab_im, e_im.shape)

    def combine(left, right):
        a1r, a1i, b1r, b1i = left
        a2r, a2i, b2r, b2i = right
        return (a2r * a1r - a2i * a1i,
                a2r * a1i + a2i * a1r,
                a2r * b1r - a2i * b1i + b2r,
                a2r * b1i + a2i * b1r + b2i)

    _, _, x_re, x_im = lax.associative_scan(combine, (a_re_t, a_im_t, e_re, e_im), axis=1)
    y = (jnp.einsum('bsgp,ghp->bsgh', x_re, c_re.astype(jnp.float32))
         - jnp.einsum('bsgp,ghp->bsgh', x_im, c_im.astype(jnp.float32))
         + d_skip.astype(jnp.float32) * uf)
    return y.reshape(B, S, SSM_WIDTH).astype(u.dtype)


def causal_dwconv(a, w, bias):
    S = a.shape[1]
    ap = jnp.pad(a, ((0, 0), (CONV_WIDTH - 1, 0), (0, 0)))
    out = bias
    for i in range(CONV_WIDTH):
        out = out + w[i] * ap[:, i:i + S]
    return out


def setup_inputs(seed: int = 0) -> dict:
    key = jax.random.key(seed)
    ks = jax.random.split(key, 32)
    L, D = DEPTH, D_MODEL
    G, P, Hc = N_SSM_GROUPS, SSM_STATE, SSM_GROUP
    nrm = lambda k, shape, s: jax.random.normal(k, shape, jnp.float32) * s
    gain = lambda k, shape: 1.0 + 0.02 * jax.random.normal(k, shape, jnp.float32)
    n_idx = jnp.arange(P, dtype=jnp.float32)
    return {
        "x": nrm(ks[0], (BATCH, SEQ, D), 1.0),
        "c": nrm(ks[1], (BATCH, D), 1.0),
        "w_ada": nrm(ks[2], (L, D, N_MOD * D), 0.5 * D ** -0.5),
        "b_ada": nrm(ks[3], (L, N_MOD * D), 0.02),
        "g_mix": gain(ks[4], (L, D)),
        "w_in": nrm(ks[5], (L, D, IN_WIDTH), D ** -0.5),
        "b_f": 2.0 + 0.5 * jax.random.normal(ks[6], (L, N_ATTN_HEADS), jnp.float32),
        "a_re": -0.5 + nrm(ks[7], (L, G, P), 0.01),
        "a_im": math.pi * n_idx + nrm(ks[8], (L, G, P), 0.01),
        "log_dt": jax.random.uniform(ks[9], (L, G), jnp.float32, math.log(DT_MIN), math.log(DT_MAX)),
        "ssm_b_re": nrm(ks[10], (L, G, P, Hc), (2 * Hc) ** -0.5),
        "ssm_b_im": nrm(ks[11], (L, G, P, Hc), (2 * Hc) ** -0.5),
        "ssm_c_re": nrm(ks[12], (L, G, Hc, P), (2 * P) ** -0.5 * 4.0),
        "ssm_c_im": nrm(ks[13], (L, G, Hc, P), (2 * P) ** -0.5 * 4.0),
        "ssm_d": nrm(ks[14], (L, G, Hc), 0.5),
        "w_glu": nrm(ks[15], (L, SSM_WIDTH, SSM_WIDTH), SSM_WIDTH ** -0.5),
        "b_glu": nrm(ks[16], (L, SSM_WIDTH), 0.02),
        "g_attn_out": gain(ks[17], (L, ATTN_WIDTH)),
        "g_ssm_out": gain(ks[18], (L, SSM_WIDTH)),
        "w_out": nrm(ks[19], (L, MIX_WIDTH, D), MIX_WIDTH ** -0.5),
        "g_ffn": gain(ks[20], (L, D)),
        "w_up": nrm(ks[21], (L, D, 2 * D_FF), D ** -0.5),
        "conv_w": nrm(ks[22], (L, CONV_WIDTH, D_FF), CONV_WIDTH ** -0.5),
        "conv_b": nrm(ks[23], (L, D_FF), 0.02),
        "w_down": nrm(ks[24], (L, D_FF, D), D_FF ** -0.5),
        "g_final": gain(ks[25], (D,)),
    }


def reference(x, c, w_ada, b_ada, g_mix, w_in, b_f, a_re, a_im, log_dt, ssm_b_re, ssm_b_im,
              ssm_c_re, ssm_c_im, ssm_d, w_glu, b_glu, g_attn_out, g_ssm_out, w_out, g_ffn,
              w_up, conv_w, conv_b, w_down, g_final):
    B, S, D = x.shape
    h = x
    cond = jax.nn.silu(c)
    splits = [ATTN_WIDTH, 2 * ATTN_WIDTH, 3 * ATTN_WIDTH, 3 * ATTN_WIDTH + N_ATTN_HEADS]
    for l in range(DEPTH):
        mod = cond @ w_ada[l] + b_ada[l]
        sh1, sc1, gt1, sh2, sc2, gt2 = jnp.split(mod, N_MOD, axis=-1)

        hn = modulate(rms_norm(h, g_mix[l]), sh1, sc1)
        proj = hn @ w_in[l]
        q, k, v, f_logit, u = jnp.split(proj, splits, axis=-1)
        q = q.reshape(B, S, N_ATTN_HEADS, HEAD_DIM)
        k = k.reshape(B, S, N_ATTN_HEADS, HEAD_DIM)
        v = v.reshape(B, S, N_ATTN_HEADS, HEAD_DIM)
        attn = forgetting_attention(q, k, v, f_logit + b_f[l]).reshape(B, S, ATTN_WIDTH)

        y = s5_ssm(u, a_re[l], a_im[l], log_dt[l], ssm_b_re[l], ssm_b_im[l],
                   ssm_c_re[l], ssm_c_im[l], ssm_d[l])
        y = jax.nn.gelu(y)
        y = y * jax.nn.sigmoid(y @ w_glu[l] + b_glu[l])

        mixed = jnp.concatenate([rms_norm(attn, g_attn_out[l]), rms_norm(y, g_ssm_out[l])], axis=-1)
        h = h + gt1[:, None, :] * (mixed @ w_out[l])

        hn = modulate(rms_norm(h, g_ffn[l]), sh2, sc2)
        up = hn @ w_up[l]
        a_br, b_br = jnp.split(up, 2, axis=-1)
        a_br = causal_dwconv(a_br, conv_w[l], conv_b[l])
        h = h + gt2[:, None, :] * ((jax.nn.silu(a_br) * b_br) @ w_down[l])
    return rms_norm(h, g_final)
```

```cpp
#include <hip/hip_runtime.h>
#include <hip/hip_cooperative_groups.h>
#include <cstdio>
#include <cstdint>
namespace cg = cooperative_groups;

constexpr int SEQ = 8192, DM = 2048, AW = 1024, HD = 128, NH = 8, SW = 1024, NG = 64, GCH = 16, NP = 64, INW = 4104, DFF = 5632;
constexpr int CL = 32, NCH = SEQ / CL;
constexpr int KA = CL * GCH + 2 * NP;
constexpr float EPS = 1e-6f;
constexpr size_t MiB = 1u << 20, KiB = 1024;
constexpr size_t WS_CTL = 0, CTL_ZERO_BYTES = 1 * MiB;
constexpr size_t WS_MODP = 1 * MiB;
constexpr size_t WS_MOD = 2 * MiB;
constexpr size_t WS_LF = 2 * MiB + 64 * KiB;
constexpr size_t WS_CBR = 2 * MiB + 320 * KiB;
constexpr size_t WS_P32 = 2 * MiB + 576 * KiB;
constexpr size_t WS_SSQ = 3 * MiB;
constexpr size_t WS_SSQ2 = 4 * MiB;
constexpr size_t WS_WDT = 8 * MiB;
constexpr size_t WS_W1T = 30 * MiB;
constexpr size_t WS_WGT = 46 * MiB;
constexpr size_t WS_WOT = 48 * MiB;
constexpr size_t WS_WUT = 56 * MiB;
constexpr size_t WS_GC = 100 * MiB;
constexpr size_t WS_WEND = 140 * MiB;
constexpr size_t WS_AALL = 156 * MiB;
constexpr size_t WS_QKV = 176 * MiB;
constexpr size_t WS_YB = 224 * MiB;
constexpr size_t WS_MIX = 240 * MiB;
constexpr size_t WS_HN = 280 * MiB;
constexpr size_t WS_ABUF = 100 * MiB;
constexpr size_t WS_BBUF = 188 * MiB;
constexpr size_t WS_END = 312 * MiB;
static_assert(WS_ABUF + (size_t)SEQ * DFF * 2 <= WS_BBUF && WS_BBUF + (size_t)SEQ * DFF * 2 <= WS_HN && WS_HN + (size_t)SEQ * DM * 2 <= WS_END, "ws map");
static_assert(WS_WUT + (size_t)2 * DFF * DM * 2 <= WS_GC && WS_GC + (size_t)NG * 512 * KA * 2 <= WS_WEND && WS_WEND + (size_t)NG * 256 * 512 * 2 <= WS_AALL && WS_AALL + (size_t)NG * 256 * KA * 2 <= WS_QKV, "ws map 2");
static_assert(WS_QKV + (size_t)3 * SEQ * AW * 2 <= WS_YB && WS_YB + (size_t)SEQ * SW * 2 <= WS_MIX && WS_MIX + (size_t)SEQ * DM * 2 <= WS_HN, "ws map 3");
static_assert(WS_WDT + (size_t)DM * DFF * 2 <= WS_W1T && WS_W1T + (size_t)4096 * DM * 2 <= WS_WGT && WS_WOT + (size_t)DM * DM * 2 <= WS_WUT, "ws map 4");
constexpr int LDS_BYTES = 147456;
constexpr int RING_BYTES = 131072;

typedef float f32x4_t __attribute__((ext_vector_type(4)));
typedef unsigned u32x4_t __attribute__((ext_vector_type(4)));
typedef unsigned u32x2_t __attribute__((ext_vector_type(2)));
__device__ __forceinline__ float bf_lo(unsigned w) { return __uint_as_float(w << 16); }
__device__ __forceinline__ float bf_hi(unsigned w) { return __uint_as_float(w & 0xffff0000u); }
__device__ __forceinline__ float fast_sigmoid(float z) { return __builtin_amdgcn_rcpf(1.0f + __builtin_amdgcn_exp2f(-1.4426950408889634f * z)); }
__device__ __forceinline__ float gelu_tanh(float v) { const float z = 1.5957691216057308f * (v + 0.044715f * v * v * v); return v * fast_sigmoid(z); }

namespace pg8 {
#define PG8_LAS __attribute__((address_space(3)))
typedef unsigned short bf16_t;
typedef short bf16x8 __attribute__((ext_vector_type(8)));
typedef float f32x4 __attribute__((ext_vector_type(4)));
typedef unsigned u32x4 __attribute__((ext_vector_type(4)));
constexpr int BM = 256, BK = 64, HALF = 128, HTB = HALF * BK * 2  , STAGE_BYTES = 8 * HTB, NXCD = 8, WGM = 8;

__host__ __device__ __forceinline__ int lds_byte(int r, int c) { const int st = (r >> 4) * 2 + (c >> 5), rr = r & 15, cc = c & 31, ob = rr * 64 + cc * 2; return st * 1024 + (ob ^ (((ob >> 9) & 1) << 5)); }
__host__ __device__ __forceinline__ void stage_rc(int b, int& R, int& C) { const int st = b / 1024, sb = b % 1024, swz = sb ^ (((sb >> 9) & 1) << 5); R = (st >> 1) * 16 + swz / 64; C = (st & 1) * 32 + (swz % 64) / 2; }
__host__ __device__ __forceinline__ int perm32(int rho) { const int n = rho >> 4, i = rho & 15; return 8 * (i >> 2) + 4 * n + (i & 3); }

struct Unit { int pm, pn; };
struct Gemm { const bf16_t* A; const bf16_t* Bt; int M, N, K, lda, ldb; };

struct StaticOrder {
    int nM, nN, nwg, G, c;
    __host__ __device__ void init(int M, int N, int G_, int c_) { nM = M / BM; nN = N / BM; nwg = nM * nN; G = G_; c = c_; }
    __host__ __device__ bool next(int i, Unit& u) const {
        const long L = (long)i * G + c; if (L >= nwg) return false;
        int wgid = (int)L; { const int q = nwg / NXCD, r = nwg % NXCD, xcd = wgid % NXCD, off = wgid / NXCD; wgid = (xcd < r ? xcd * (q + 1) : r * (q + 1) + (xcd - r) * q) + off; }
        const int nig = WGM * nN, gid = wgid / nig, fm = gid * WGM, gsz = (nM - fm) < WGM ? (nM - fm) : WGM;
        u.pm = fm + ((wgid % nig) % gsz); u.pn = (wgid % nig) / gsz; return true;
    }
    __device__ __forceinline__ void a_ready(const Unit&) const {}
    __device__ __forceinline__ void done(const Unit&) const {}
};


template <class Epi, class Sched, bool ALIGN_EPI = false, bool SP2 = false>
__device__ __forceinline__ void gemm_phase(PG8_LAS unsigned char* lds, const Gemm g, const Sched& S, const Epi& E) {
    int tid_ = threadIdx.x; asm volatile("" : "+v"(tid_));
    const int tid = tid_, wid = __builtin_amdgcn_readfirstlane(tid >> 6), lane = tid & 63, wr = wid >> 2, wc = wid & 3, fr = lane & 15, fq = lane >> 4;
    const int K = g.K, nt = K / BK;
    unsigned voffA[2], voffB[2];
#pragma unroll
    for (int i = 0; i < 2; ++i) { int R, C; stage_rc(tid * 16 + i * 8192, R, C); const int Rb = Epi::PERM ? ((R & ~31) + perm32(R & 31)) : R;
        voffA[i] = (unsigned)(R * g.lda + C) * 2u; voffB[i] = (unsigned)(Rb * g.ldb + C) * 2u; }
    const size_t kstep = (size_t)(BK * 2);
    const size_t hstepA = (size_t)HALF * g.lda * 2, hstepB = (size_t)HALF * g.ldb * 2;
    const size_t tstepA = 2 * hstepA, tstepB = 2 * hstepB;
    const unsigned ldsw = (unsigned)wid * 1024u;
    const int aoff = lds_byte(wr * 64 + fr, fq * 8), boff = lds_byte(wc * 32 + fr, fq * 8);
#define PG8_SA(b, h) (((b) * 2 + (h)) * HTB)
#define PG8_SB(b, h) ((4 + (b) * 2 + (h)) * HTB)
#define PG8_STAGE(bufoff, gbase, voff) do { _Pragma("unroll") for (int _i = 0; _i < 2; ++_i) \
        __builtin_amdgcn_global_load_lds((const unsigned*)((const char*)(gbase) + (voff)[_i]), (PG8_LAS unsigned*)(lds + (bufoff) + ldsw + _i * 8192), 16, 0, 0); } while (0)
#define PG8_LDA(dst, b, h) do { _Pragma("unroll") for (int m = 0; m < 4; ++m) _Pragma("unroll") for (int k = 0; k < 2; ++k) dst[m][k] = *(const PG8_LAS bf16x8*)(lds + PG8_SA(b, h) + aoff + m * 2048 + k * 1024); } while (0)
#define PG8_LDB(dst, b, h) do { _Pragma("unroll") for (int n = 0; n < 2; ++n) _Pragma("unroll") for (int k = 0; k < 2; ++k) dst[n][k] = *(const PG8_LAS bf16x8*)(lds + PG8_SB(b, h) + boff + n * 2048 + k * 1024); } while (0)
#define PG8_MMA(ai, bj, At, Bt) do { __builtin_amdgcn_s_setprio(1); _Pragma("unroll") for (int m = 0; m < 4; ++m) _Pragma("unroll") for (int n = 0; n < 2; ++n) _Pragma("unroll") for (int k = 0; k < 2; ++k) \
        acc[ai][bj][m][n] = __builtin_amdgcn_mfma_f32_16x16x32_bf16(Bt[n][k], At[m][k], acc[ai][bj][m][n], 0, 0, 0); __builtin_amdgcn_s_setprio(0); } while (0)
#define PG8_WAIT_V(n) asm volatile("s_waitcnt vmcnt(" #n ")" ::: "memory")
#define PG8_WAIT_L(n) asm volatile("s_waitcnt lgkmcnt(" #n ")" ::: "memory")
#define PG8_BAR __builtin_amdgcn_s_barrier()
#define PG8_SCHED __builtin_amdgcn_sched_barrier(0)
    Unit cur, nxt; int ui = 0;
    if (!S.next(0, cur)) return;
    f32x4 acc[2][2][4][2];
#pragma unroll
    for (int a = 0; a < 2; ++a)
#pragma unroll
        for (int b = 0; b < 2; ++b)
#pragma unroll
            for (int m = 0; m < 4; ++m)
#pragma unroll
                for (int n = 0; n < 2; ++n) acc[a][b][m][n] = (f32x4){0.f, 0.f, 0.f, 0.f};
    bf16x8 At[4][2], B0[2][2], B1[2][2];
    const char* cA = (const char*)g.A + (size_t)cur.pm * tstepA; const char* cB = (const char*)g.Bt + (size_t)cur.pn * tstepB;
    S.a_ready(cur);
    if constexpr (SP2) {
        PG8_STAGE(PG8_SB(0, 0), cB, voffB); PG8_STAGE(PG8_SB(0, 1), cB + hstepB, voffB); PG8_STAGE(PG8_SA(0, 0), cA, voffA); PG8_STAGE(PG8_SA(0, 1), cA + hstepA, voffA);
        if (wr == 1) PG8_BAR;
        PG8_WAIT_V(2); PG8_BAR;
        PG8_STAGE(PG8_SB(1, 0), cB + kstep, voffB); PG8_STAGE(PG8_SA(1, 0), cA + kstep, voffA); PG8_STAGE(PG8_SB(1, 1), cB + hstepB + kstep, voffB);
        PG8_WAIT_V(6); PG8_BAR;
    } else {
        PG8_STAGE(PG8_SB(0, 0), cB, voffB); PG8_STAGE(PG8_SA(0, 0), cA, voffA); PG8_STAGE(PG8_SB(0, 1), cB + hstepB, voffB); PG8_STAGE(PG8_SA(0, 1), cA + hstepA, voffA);
        if (wr == 1) PG8_BAR;
        PG8_WAIT_V(4); PG8_BAR;
        PG8_STAGE(PG8_SB(1, 0), cB + kstep, voffB); PG8_STAGE(PG8_SA(1, 0), cA + kstep, voffA); PG8_STAGE(PG8_SB(1, 1), cB + hstepB + kstep, voffB);
        PG8_WAIT_V(6); PG8_BAR;
    }
    for (;;) {
        const bool has_next = S.next(ui + 1, nxt);
        const char* nA = has_next ? (const char*)g.A + (size_t)nxt.pm * tstepA : cA; const char* nB = has_next ? (const char*)g.Bt + (size_t)nxt.pn * tstepB : cB;
        for (int t = 0; t < nt; t += 2) {
            const bool last = (t == nt - 2);
            const char* a1 = cA + (size_t)(t + 1) * kstep;
            const char* a2 = last ? nA : cA + (size_t)(t + 2) * kstep; const char* b2 = last ? nB : cB + (size_t)(t + 2) * kstep;
            const char* a3 = a2 + kstep; const char* b3 = b2 + kstep;
            if (last && has_next) S.a_ready(nxt);
            if constexpr (Epi::MIDK) { if (t == (nt >> 1)) E.mid(acc, cur, wr, fr); }
            if constexpr (SP2) {
            PG8_LDB(B0, 0, 0); PG8_LDB(B1, 0, 1); PG8_SCHED; PG8_LDA(At, 0, 0); PG8_STAGE(PG8_SA(1, 1), a1 + hstepA, voffA);
            PG8_WAIT_V(8); PG8_WAIT_L(0); PG8_BAR; PG8_MMA(0, 0, At, B0); PG8_MMA(0, 1, At, B1); PG8_BAR; PG8_SCHED;
            PG8_LDA(At, 0, 1); PG8_STAGE(PG8_SB(0, 0), b2, voffB); PG8_STAGE(PG8_SB(0, 1), b2 + hstepB, voffB); PG8_STAGE(PG8_SA(0, 0), a2, voffA);
            PG8_WAIT_V(8); PG8_WAIT_L(0); PG8_BAR; PG8_MMA(1, 0, At, B0); PG8_MMA(1, 1, At, B1); PG8_BAR; PG8_SCHED;
            PG8_LDB(B0, 1, 0); PG8_LDB(B1, 1, 1); PG8_SCHED; PG8_LDA(At, 1, 0); PG8_STAGE(PG8_SA(0, 1), a2 + hstepA, voffA);
            PG8_WAIT_V(8); PG8_WAIT_L(0); PG8_BAR; PG8_MMA(0, 0, At, B0); PG8_MMA(0, 1, At, B1); PG8_BAR; PG8_SCHED;
            PG8_LDA(At, 1, 1); PG8_STAGE(PG8_SB(1, 0), b3, voffB); PG8_STAGE(PG8_SB(1, 1), b3 + hstepB, voffB); PG8_STAGE(PG8_SA(1, 0), a3, voffA);
            PG8_WAIT_V(8); PG8_WAIT_L(0); PG8_BAR; PG8_MMA(1, 0, At, B0); PG8_MMA(1, 1, At, B1); PG8_BAR; PG8_SCHED;
            } else {
            PG8_LDB(B0, 0, 0); PG8_SCHED; PG8_LDA(At, 0, 0); PG8_STAGE(PG8_SA(1, 1), a1 + hstepA, voffA);
            PG8_WAIT_L(8); PG8_BAR; PG8_WAIT_L(0); PG8_MMA(0, 0, At, B0); PG8_BAR; PG8_SCHED;
            PG8_LDB(B1, 0, 1); PG8_STAGE(PG8_SB(0, 0), b2, voffB);
            PG8_BAR; PG8_WAIT_L(0); PG8_MMA(0, 1, At, B1); PG8_BAR;
            PG8_LDA(At, 0, 1); PG8_STAGE(PG8_SA(0, 0), a2, voffA);
            PG8_BAR; PG8_WAIT_L(0); PG8_MMA(1, 0, At, B0); PG8_BAR; PG8_SCHED;
            PG8_STAGE(PG8_SB(0, 1), b2 + hstepB, voffB);
            PG8_WAIT_V(6); PG8_BAR; PG8_MMA(1, 1, At, B1); PG8_BAR;
            PG8_LDB(B0, 1, 0); PG8_SCHED; PG8_LDA(At, 1, 0); PG8_STAGE(PG8_SA(0, 1), a2 + hstepA, voffA);
            PG8_WAIT_L(8); PG8_BAR; PG8_WAIT_L(0); PG8_MMA(0, 0, At, B0); PG8_BAR; PG8_SCHED;
            PG8_LDB(B1, 1, 1); PG8_STAGE(PG8_SB(1, 0), b3, voffB);
            PG8_BAR; PG8_WAIT_L(0); PG8_MMA(0, 1, At, B1); PG8_BAR;
            PG8_LDA(At, 1, 1); PG8_STAGE(PG8_SA(1, 0), a3, voffA);
            PG8_BAR; PG8_WAIT_L(0); PG8_MMA(1, 0, At, B0); PG8_BAR; PG8_SCHED;
            PG8_STAGE(PG8_SB(1, 1), b3 + hstepB, voffB);
            PG8_WAIT_V(6); PG8_BAR; PG8_MMA(1, 1, At, B1); PG8_BAR;
            }
        }
        if constexpr (ALIGN_EPI) { if (wr == 0) PG8_BAR; }
        if constexpr (!Epi::AFTER_DRAIN) { E(acc, cur, wr, wc, fr, fq); S.done(cur); }
        if (!has_next) break;
#pragma unroll
        for (int a = 0; a < 2; ++a)
#pragma unroll
            for (int b = 0; b < 2; ++b)
#pragma unroll
                for (int m = 0; m < 4; ++m)
#pragma unroll
                    for (int n = 0; n < 2; ++n) acc[a][b][m][n] = (f32x4){0.f, 0.f, 0.f, 0.f};
        cur = nxt; cA = nA; cB = nB; ++ui;
        if constexpr (ALIGN_EPI) { if (wr == 1) PG8_BAR; }
    }
    PG8_WAIT_V(0);
    if constexpr (!ALIGN_EPI) { if (wr == 0) PG8_BAR; }
    PG8_BAR;
    if constexpr (Epi::AFTER_DRAIN) { E.fused(acc, cur, wr, wc, fr, fq, lds, wid, lane); S.done(cur); }
#undef PG8_SA
#undef PG8_SB
#undef PG8_STAGE
#undef PG8_LDA
#undef PG8_LDB
#undef PG8_MMA
#undef PG8_WAIT_V
#undef PG8_WAIT_L
#undef PG8_BAR
#undef PG8_SCHED
}
__device__ __forceinline__ unsigned cvt_pk_bf16(float lo, float hi) { unsigned r; asm volatile("v_cvt_pk_bf16_f32 %0, %1, %2" : "=v"(r) : "v"(lo), "v"(hi)); return r; }
__device__ __forceinline__ u32x4 pack8(const f32x4 a, const f32x4 b) { u32x4 w; w.x = cvt_pk_bf16(a[0], a[1]); w.y = cvt_pk_bf16(a[2], a[3]); w.z = cvt_pk_bf16(b[0], b[1]); w.w = cvt_pk_bf16(b[2], b[3]); return w; }

struct CarryOrder {
    int G, c;
    __device__ bool next(int i, Unit& u) const { const int L = i * G + c; if (L >= NG) return false; u.pm = L; u.pn = L; return true; }
    __device__ __forceinline__ void a_ready(const Unit&) const {}
    __device__ __forceinline__ void done(const Unit&) const {}
};
struct ChunkOrder {
    int G, c;
    __device__ bool next(int i, Unit& u) const { const int L = i * G + c; if (L >= 2 * NG) return false; u.pm = L >> 1; u.pn = L; return true; }
    __device__ __forceinline__ void a_ready(const Unit&) const {}
    __device__ __forceinline__ void done(const Unit&) const {}
};

struct EpiQKVU {
    static constexpr bool PERM = true, AFTER_DRAIN = false, MIDK = false;
    bf16_t* QKV; bf16_t* AALL;
    __device__ __forceinline__ void mid(f32x4 (&)[2][2][4][2], const Unit&, int, int) const {}
    __device__ __forceinline__ void operator()(const f32x4 (&acc)[2][2][4][2], const Unit& u, int wr, int wc, int fr, int fq) const {
        const int row0 = u.pm * BM + wr * 64 + fr;
#pragma unroll
        for (int bj = 0; bj < 2; ++bj) {
            const int ct = u.pn * BM + bj * HALF, cw = wc * 32 + 8 * fq;
            if (ct < 3072) {
                const int which = ct >> 10, head = (ct & 1023) >> 7;
                bf16_t* base = QKV + (size_t)(which * NH + head) * SEQ * HD + cw;
#pragma unroll
                for (int ai = 0; ai < 2; ++ai)
#pragma unroll
                    for (int m = 0; m < 4; ++m) { const int row = row0 + ai * HALF + m * 16; *(u32x4*)(base + (size_t)row * HD) = pack8(acc[ai][bj][m][0], acc[ai][bj][m][1]); }
            } else {
                const int cu = ct - 3072 + cw, g = cu >> 4, i0 = cu & 15;
#pragma unroll
                for (int ai = 0; ai < 2; ++ai)
#pragma unroll
                    for (int m = 0; m < 4; ++m) { const int row = row0 + ai * HALF + m * 16;
                        *(u32x4*)(AALL + ((size_t)(g * NCH + (row >> 5)) * KA + (row & 31) * GCH + i0)) = pack8(acc[ai][bj][m][0], acc[ai][bj][m][1]); }
            }
        }
    }
};

struct EpiCarry {
    static constexpr bool PERM = false, AFTER_DRAIN = true, MIDK = false;
    bf16_t* AALL; const float* P32;
    __device__ __forceinline__ void mid(f32x4 (&)[2][2][4][2], const Unit&, int, int) const {}
    __device__ __forceinline__ void operator()(const f32x4 (&)[2][2][4][2], const Unit&, int, int, int, int) const {}
    __device__ __forceinline__ void fused(f32x4 (&acc)[2][2][4][2], const Unit& u, int wr, int wc, int fr, int fq, PG8_LAS unsigned char* lds, int wid, int lane) const {
        PG8_LAS float* sS = (PG8_LAS float*)lds;
#pragma unroll
        for (int ai = 0; ai < 2; ++ai)
#pragma unroll
            for (int m = 0; m < 4; ++m) { const int r = ai * HALF + wr * 64 + m * 16 + fr;
#pragma unroll
                for (int n = 0; n < 2; ++n) *(PG8_LAS f32x4*)(sS + r * 128 + wc * 32 + 16 * n + 4 * fq) = acc[ai][0][m][n]; }
        asm volatile("s_waitcnt lgkmcnt(0)" ::: "memory"); __builtin_amdgcn_s_barrier(); asm volatile("" ::: "memory");
        if (wid == 0) {
            const int g = u.pm, p = lane;
            const float pr = P32[(g * NP + p) * 2], pi = P32[(g * NP + p) * 2 + 1];
            float xr = 0.f, xi = 0.f;
            bf16_t* dst = AALL + (size_t)g * NCH * KA + CL * GCH + p;
            for (int c = 0; c < NCH; ++c) {
                const unsigned w = cvt_pk_bf16(xr, xi);
                dst[(size_t)c * KA] = (bf16_t)(w & 0xffffu); dst[(size_t)c * KA + NP] = (bf16_t)(w >> 16);
                const float sr = sS[c * 128 + p], si = sS[c * 128 + NP + p];
                const float nr = pr * xr - pi * xi + sr, ni = pr * xi + pi * xr + si;
                xr = nr; xi = ni;
            }
        }
    }
};

struct EpiY {
    static constexpr bool PERM = true, AFTER_DRAIN = false, MIDK = false;
    bf16_t* YB;
    __device__ __forceinline__ void mid(f32x4 (&)[2][2][4][2], const Unit&, int, int) const {}
    __device__ __forceinline__ void operator()(const f32x4 (&acc)[2][2][4][2], const Unit& u, int wr, int wc, int fr, int fq) const {
        const int g = u.pm, j = u.pn & 1;
#pragma unroll
        for (int bj = 0; bj < 2; ++bj) { const int n0 = j * BM + bj * HALF + wc * 32 + 8 * fq, tl = n0 >> 4, h0 = n0 & 15;
#pragma unroll
            for (int ai = 0; ai < 2; ++ai)
#pragma unroll
                for (int m = 0; m < 4; ++m) { const int c = ai * HALF + wr * 64 + m * 16 + fr; const int t = CL * c + tl;
                    f32x4 a = acc[ai][bj][m][0], b = acc[ai][bj][m][1];
#pragma unroll
                    for (int e = 0; e < 4; ++e) { a[e] = gelu_tanh(a[e]); b[e] = gelu_tanh(b[e]); }
                    *(u32x4*)(YB + (size_t)t * SW + GCH * g + h0) = pack8(a, b); } }
    }
};

struct EpiGlu {
    static constexpr bool PERM = true, AFTER_DRAIN = false, MIDK = false;
    const bf16_t* YB; bf16_t* MIX; const float* bglu; float* SSQ;
    __device__ __forceinline__ void mid(f32x4 (&)[2][2][4][2], const Unit&, int, int) const {}
    __device__ __forceinline__ void operator()(const f32x4 (&acc)[2][2][4][2], const Unit& u, int wr, int wc, int fr, int fq) const {
        const int row0 = u.pm * BM + wr * 64 + fr;
        float ss[2][4];
#pragma unroll
        for (int ai = 0; ai < 2; ++ai)
#pragma unroll
            for (int m = 0; m < 4; ++m) ss[ai][m] = 0.f;
#pragma unroll
        for (int bj = 0; bj < 2; ++bj) { const int col0 = u.pn * BM + bj * HALF + wc * 32 + 8 * fq;
            const f32x4 b0 = *(const f32x4*)(bglu + col0), b1 = *(const f32x4*)(bglu + col0 + 4);
#pragma unroll
            for (int ai = 0; ai < 2; ++ai)
#pragma unroll
                for (int m = 0; m < 4; ++m) { const int row = row0 + ai * HALF + m * 16;
                    const u32x4 yw = *(const u32x4*)(YB + (size_t)row * SW + col0);
                    f32x4 ya = {bf_lo(yw.x), bf_hi(yw.x), bf_lo(yw.y), bf_hi(yw.y)}, yb = {bf_lo(yw.z), bf_hi(yw.z), bf_lo(yw.w), bf_hi(yw.w)};
                    const f32x4 za = acc[ai][bj][m][0] + b0, zb = acc[ai][bj][m][1] + b1;
                    float s = 0.f;
#pragma unroll
                    for (int e = 0; e < 4; ++e) { ya[e] *= fast_sigmoid(za[e]); yb[e] *= fast_sigmoid(zb[e]); s += ya[e] * ya[e] + yb[e] * yb[e]; }
                    ss[ai][m] += s;
                    *(u32x4*)(MIX + (size_t)row * DM + SW + col0) = pack8(ya, yb); } }
#pragma unroll
        for (int ai = 0; ai < 2; ++ai)
#pragma unroll
            for (int m = 0; m < 4; ++m) { float s = ss[ai][m]; s += __shfl_xor(s, 16); s += __shfl_xor(s, 32);
                if (fq == 0) SSQ[(size_t)(row0 + ai * HALF + m * 16) * 32 + 8 + u.pn * 4 + wc] = s; }
    }
};

struct EpiWout {
    static constexpr bool PERM = false, AFTER_DRAIN = false, MIDK = true;
    const PG8_LAS float* rtab;
    const float* X; const float* gt1; float* OUT;
    static __device__ __forceinline__ void rstds(const float* SSQ, int row, float& ra, float& rs) {
        const f32x4* p = (const f32x4*)(SSQ + (size_t)row * 32);
        const f32x4 a0 = p[0], a1 = p[1], s0 = p[2], s1 = p[3], s2 = p[4], s3 = p[5];
        const float sa = (a0[0] + a0[1]) + (a0[2] + a0[3]) + (a1[0] + a1[1]) + (a1[2] + a1[3]);
        const f32x4 st = (s0 + s1) + (s2 + s3); const float ssum = (st[0] + st[1]) + (st[2] + st[3]);
        ra = 1.0f / sqrtf(sa * (1.0f / AW) + EPS); rs = 1.0f / sqrtf(ssum * (1.0f / SW) + EPS);
    }
    __device__ __forceinline__ void mid(f32x4 (&acc)[2][2][4][2], const Unit& u, int wr, int fr) const {
#pragma unroll
        for (int ai = 0; ai < 2; ++ai)
#pragma unroll
            for (int m = 0; m < 4; ++m) { const float f = rtab[2 * (ai * HALF + wr * 64 + m * 16 + fr)];
#pragma unroll
                for (int bj = 0; bj < 2; ++bj)
#pragma unroll
                    for (int n = 0; n < 2; ++n) acc[ai][bj][m][n] *= f; }
    }
    __device__ __forceinline__ void operator()(const f32x4 (&acc)[2][2][4][2], const Unit& u, int wr, int wc, int fr, int fq) const {
        const int col0 = u.pn * BM + wc * 32 + 4 * fq;
        f32x4 gv[2][2];
#pragma unroll
        for (int bj = 0; bj < 2; ++bj)
#pragma unroll
            for (int n = 0; n < 2; ++n) gv[bj][n] = *(const f32x4*)(gt1 + col0 + bj * HALF + n * 16);
#pragma unroll
        for (int ai = 0; ai < 2; ++ai)
#pragma unroll
            for (int m = 0; m < 4; ++m) { const int rl = ai * HALF + wr * 64 + m * 16 + fr, row = u.pm * BM + rl; const float rs = rtab[2 * rl + 1];
                const size_t off = (size_t)row * DM + col0;
#pragma unroll
                for (int bj = 0; bj < 2; ++bj)
#pragma unroll
                    for (int n = 0; n < 2; ++n) { const f32x4 xv = *(const f32x4*)(X + off + bj * HALF + n * 16);
                        *(f32x4*)(OUT + off + bj * HALF + n * 16) = xv + gv[bj][n] * (acc[ai][bj][m][n] * rs); } }
    }
};

struct EpiUp {
    static constexpr bool PERM = true, AFTER_DRAIN = false, MIDK = false;
    bf16_t* ABUF; bf16_t* BBUF;
    __device__ __forceinline__ void mid(f32x4 (&)[2][2][4][2], const Unit&, int, int) const {}
    __device__ __forceinline__ void operator()(const f32x4 (&acc)[2][2][4][2], const Unit& u, int wr, int wc, int fr, int fq) const {
        const int row0 = u.pm * BM + wr * 64 + fr, col0 = u.pn * HALF + wc * 32 + 8 * fq;
#pragma unroll
        for (int bj = 0; bj < 2; ++bj) { bf16_t* base = (bj == 0 ? ABUF : BBUF) + col0;
#pragma unroll
            for (int ai = 0; ai < 2; ++ai)
#pragma unroll
                for (int m = 0; m < 4; ++m) { const int row = row0 + ai * HALF + m * 16; *(u32x4*)(base + (size_t)row * DFF) = pack8(acc[ai][bj][m][0], acc[ai][bj][m][1]); } }
    }
};

struct EpiDown {
    static constexpr bool PERM = false, AFTER_DRAIN = false, MIDK = false;
    const float* gt2; float* OUT; float* SSQ2;
    __device__ __forceinline__ void mid(f32x4 (&)[2][2][4][2], const Unit&, int, int) const {}
    __device__ __forceinline__ void operator()(const f32x4 (&acc)[2][2][4][2], const Unit& u, int wr, int wc, int fr, int fq) const {
        const int col0 = u.pn * BM + wc * 32 + 4 * fq;
        f32x4 gv[2][2];
#pragma unroll
        for (int bj = 0; bj < 2; ++bj)
#pragma unroll
            for (int n = 0; n < 2; ++n) gv[bj][n] = *(const f32x4*)(gt2 + col0 + bj * HALF + n * 16);
#pragma unroll
        for (int ai = 0; ai < 2; ++ai)
#pragma unroll
            for (int m = 0; m < 4; ++m) { const int row = u.pm * BM + ai * HALF + wr * 64 + m * 16 + fr; const size_t off = (size_t)row * DM + col0; float s = 0.f;
#pragma unroll
                for (int bj = 0; bj < 2; ++bj)
#pragma unroll
                    for (int n = 0; n < 2; ++n) { const f32x4 hv = *(const f32x4*)(OUT + off + bj * HALF + n * 16);
                        const f32x4 o = hv + gv[bj][n] * acc[ai][bj][m][n]; s += (o[0] * o[0] + o[1] * o[1]) + (o[2] * o[2] + o[3] * o[3]);
                        *(f32x4*)(OUT + off + bj * HALF + n * 16) = o; }
                s += __shfl_xor(s, 16); s += __shfl_xor(s, 32);
                if (fq == 0) SSQ2[(size_t)row * 32 + u.pn * 4 + wc] = s; }
    }
};
}
#include <hip/hip_bf16.h>
namespace att {
#define BIAS_LAS __attribute__((address_space(3)))
using bf16 = __hip_bfloat16;
typedef short bf16x8 __attribute__((ext_vector_type(8)));
typedef short s16x4 __attribute__((ext_vector_type(4)));
typedef float f32x16 __attribute__((ext_vector_type(16)));
typedef float f32x4 __attribute__((ext_vector_type(4)));
typedef unsigned u32x4 __attribute__((ext_vector_type(4)));
template <class A, class Bt> struct same_t { static constexpr bool v = false; };
template <class A> struct same_t<A, A> { static constexpr bool v = true; };
constexpr int D = 128, LDO = 2048;
constexpr float SCALE = 0.08838834764831845f;
constexpr float THR = 8.f;
constexpr bool WSKIP = false;
constexpr int NW = 8, QBLK = 32, KVBLK = 64, QB = NW * QBLK;
constexpr int SHM_V = KVBLK * D * 2, SHM_K = KVBLK * D * 2;
constexpr int ATT_LDS = 2 * SHM_V + 2 * SHM_K + NW * 64 * 4;
constexpr int BIAS_OFF = 69632;
#define KSWZ(row, colB) ((row) * 256 + ((colB) ^ (((row) & 7) << 4)))
#define SBAR() __builtin_amdgcn_sched_barrier(0)
__device__ __forceinline__ int v_st(int k, int c) { const int kk = (k & ~0xC) | ((k & 4) << 1) | ((k & 8) >> 1); return ((kk >> 3) * 4 + (c >> 5)) * 512 + ((kk & 7) * 32 + (c & 31)) * 2; }
__device__ __forceinline__ int v_rd_base(int lane) { return ((lane & 3) << 3) | (((lane >> 2) & 3) << 6) | (((lane >> 4) & 1) << 5) | (((lane >> 5) & 1) << 8); }
constexpr int v_rd_off(int d0, int ks, int half) { return d0 * 512 + ks * 4096 + half * 2048; }
__device__ __forceinline__ int crow(int r, int hi) { return (r & 3) + 8 * (r >> 2) + 4 * hi; }
__device__ __forceinline__ unsigned cvtpk(float lo, float hi) {
    unsigned r; asm volatile("v_cvt_pk_bf16_f32 %0, %1, %2" : "=v"(r) : "v"(lo), "v"(hi)); return r;
}
__device__ __forceinline__ bf16x8 pack8(f32x4 a, f32x4 b) {
    u32x4 w = {cvtpk(a[0], a[1]), cvtpk(a[2], a[3]), cvtpk(b[0], b[1]), cvtpk(b[2], b[3])};
    return *reinterpret_cast<bf16x8*>(&w);
}
template <class T> __device__ __forceinline__ bf16x8 load8(const T* p) {
    if constexpr (same_t<T, float>::v) { return pack8(*(const f32x4*)p, *(const f32x4*)(p + 4)); }
    else { return *reinterpret_cast<const bf16x8*>(p); }
}
__device__ __forceinline__ void mask_tile(f32x16& p0, f32x16& p1, int dq, unsigned W) {
    const float NEG = -__builtin_inff();
#pragma unroll
    for (int r = 0; r < 16; ++r) {
        const int c = (r & 3) + 8 * (r >> 2);
        if ((unsigned)(dq - c) >= W) p0[r] = NEG;
        if ((unsigned)(dq - c - 32) >= W) p1[r] = NEG;
    }
}
__device__ __forceinline__ void partialSM(f32x16& p0, f32x16& p1, float& m_reg, float& mn, float& alpha) {
    float pmax = p0[0]; for (int r = 1; r < 16; ++r) pmax = fmaxf(pmax, p0[r]); for (int r = 0; r < 16; ++r) pmax = fmaxf(pmax, p1[r]);
    { auto rr = __builtin_amdgcn_permlane32_swap(__float_as_uint(pmax), __float_as_uint(pmax), false, false);
      pmax = fmaxf(__uint_as_float(rr[0]), __uint_as_float(rr[1])); }
    constexpr float C2 = 1.4426950408889634f * SCALE;
    if (__builtin_expect(__all((pmax - m_reg) * SCALE <= THR), 1)) { mn = m_reg; alpha = 1.f; }
    else { mn = fmaxf(m_reg, pmax); alpha = __builtin_amdgcn_exp2f((m_reg - mn) * C2); m_reg = mn; }
    const float mnL = -mn * C2;
    for (int r = 0; r < 16; ++r) p0[r] = fmaf(p0[r], C2, mnL); for (int r = 0; r < 16; ++r) p1[r] = fmaf(p1[r], C2, mnL);
    for (int r = 0; r < 16; ++r) p0[r] = __builtin_amdgcn_exp2f(p0[r]);
}
__device__ __forceinline__ void finishSM(f32x16& p0, f32x16& p1, float alpha, float& l_reg, bf16x8& pa0, bf16x8& pa1, bf16x8& pa2, bf16x8& pa3) {
    for (int r = 0; r < 16; ++r) p1[r] = __builtin_amdgcn_exp2f(p1[r]);
    float ps = 0; for (int r = 0; r < 16; ++r) ps += p0[r]; for (int r = 0; r < 16; ++r) ps += p1[r];
    { auto rr = __builtin_amdgcn_permlane32_swap(__float_as_uint(ps), __float_as_uint(ps), false, false);
      ps = __uint_as_float(rr[0]) + __uint_as_float(rr[1]); }
    l_reg = l_reg * alpha + ps;
#define PK4(P, B_, OUT) do { unsigned a0 = cvtpk(P[B_+0], P[B_+1]), a1 = cvtpk(P[B_+2], P[B_+3]);                          \
        unsigned b0 = cvtpk(P[B_+4], P[B_+5]), b1 = cvtpk(P[B_+6], P[B_+7]);                                             \
        auto r0 = __builtin_amdgcn_permlane32_swap(a0, b0, false, false); auto r1 = __builtin_amdgcn_permlane32_swap(a1, b1, false, false); \
        u32x4 w = {r0[0], r1[0], r0[1], r1[1]}; OUT = *reinterpret_cast<bf16x8*>(&w); } while (0)
    PK4(p0, 0, pa0); PK4(p0, 8, pa1); PK4(p1, 0, pa2); PK4(p1, 8, pa3);
#undef PK4
}
template <int KB, bool SK>
__device__ __forceinline__ void qkt(f32x16& p0, f32x16& p1, const char* K_lds, int r32, int hi, const bf16x8* qr, bool act, const BIAS_LAS float* bp) {
    if (SK && !act) { const float NEG = -__builtin_inff();
#pragma unroll
        for (int r = 0; r < 16; ++r) { p0[r] = NEG; p1[r] = NEG; } return; }
#ifdef NOBIAS
    p0 = f32x16{}; p1 = f32x16{};
#else
    { const BIAS_LAS f32x4* b4 = (const BIAS_LAS f32x4*)bp;
      const f32x4 t0 = b4[0], t1 = b4[2], t2 = b4[4], t3 = b4[6], t4 = b4[8], t5 = b4[10], t6 = b4[12], t7 = b4[14];
      p0 = f32x16{t0[0], t0[1], t0[2], t0[3], t1[0], t1[1], t1[2], t1[3], t2[0], t2[1], t2[2], t2[3], t3[0], t3[1], t3[2], t3[3]};
      p1 = f32x16{t4[0], t4[1], t4[2], t4[3], t5[0], t5[1], t5[2], t5[3], t6[0], t6[1], t6[2], t6[3], t7[0], t7[1], t7[2], t7[3]}; }
#endif
    const char* kb[4];
#pragma unroll
    for (int dd = 0; dd < 4; ++dd) kb[dd] = K_lds + KB * SHM_K + KSWZ(r32, (dd * 16 + hi * 8) * 2);
#pragma unroll
    for (int d0 = 0; d0 < 8; ++d0) { const char* a = kb[d0 & 3] + (d0 >> 2) * 128;
        bf16x8 b0 = *reinterpret_cast<const bf16x8*>(a);
        bf16x8 b1 = *reinterpret_cast<const bf16x8*>(a + 32 * 256);
        p0 = __builtin_amdgcn_mfma_f32_32x32x16_bf16(b0, qr[d0], p0, 0, 0, 0);
        p1 = __builtin_amdgcn_mfma_f32_32x32x16_bf16(b1, qr[d0], p1, 0, 0, 0); }
}
template <int VB, bool SK>
__device__ __forceinline__ void pv_tile(f32x16* o, int vb0, bf16x8 pa0, bf16x8 pa1, bf16x8 pa2, bf16x8 pa3, bool act) {
    if (SK && !act) return;
#define TRRD(dst, off) asm volatile("ds_read_b64_tr_b16 %0, %1 offset:%2" : "=&v"(dst) : "v"(vb0), "i"(off) : "memory")
#define PV_D0(d0) do { s16x4 l0, l1, l2, l3, h0, h1, h2, h3; constexpr int b_ = VB * SHM_V + v_rd_off(d0, 0, 0);     \
        TRRD(l0, b_); TRRD(h0, b_ + 2048); TRRD(l1, b_ + 4096); TRRD(h1, b_ + 6144); TRRD(l2, b_ + 8192); TRRD(h2, b_ + 10240); TRRD(l3, b_ + 12288); TRRD(h3, b_ + 14336); \
        asm volatile("s_waitcnt lgkmcnt(0)" ::: "memory"); SBAR();                 \
        o[d0] = __builtin_amdgcn_mfma_f32_32x32x16_bf16(pa0, (bf16x8){l0[0], l0[1], l0[2], l0[3], h0[0], h0[1], h0[2], h0[3]}, o[d0], 0, 0, 0);   \
        o[d0] = __builtin_amdgcn_mfma_f32_32x32x16_bf16(pa1, (bf16x8){l1[0], l1[1], l1[2], l1[3], h1[0], h1[1], h1[2], h1[3]}, o[d0], 0, 0, 0);   \
        o[d0] = __builtin_amdgcn_mfma_f32_32x32x16_bf16(pa2, (bf16x8){l2[0], l2[1], l2[2], l2[3], h2[0], h2[1], h2[2], h2[3]}, o[d0], 0, 0, 0);   \
        o[d0] = __builtin_amdgcn_mfma_f32_32x32x16_bf16(pa3, (bf16x8){l3[0], l3[1], l3[2], l3[3], h3[0], h3[1], h3[2], h3[3]}, o[d0], 0, 0, 0); } while (0)
    PV_D0(0); PV_D0(1); PV_D0(2); PV_D0(3);
#undef PV_D0
#undef TRRD
}
template <class TIn, class TOut> struct BlockRef { const TIn* Q; const TIn* K; const TIn* V; TOut* O; int P0; int JLO; float* SSQ; };
template <class TIn> struct Seam {
    bf16x8 qr[8];
    bf16x8 st_v0, st_v1, st_k0, st_k1; f32x4 sf0, sf1, sf2, sf3;
    f32x4 tq[16];
};
#define ROW(p, k0, rr) ((p) + (size_t)((k0) + (rr)) * D + sc)
#define VMW() asm volatile("s_waitcnt vmcnt(0)" ::: "memory")
#define VMWN(n) asm volatile("s_waitcnt vmcnt(%0)" :: "i"(n) : "memory")
#define SLOAD_H(Kp, Vp, k0) do { S.st_v0 = load8<TIn>(ROW(Vp, k0, sr)); S.st_v1 = load8<TIn>(ROW(Vp, k0, 32 + sr));              \
                         S.st_k0 = load8<TIn>(ROW(Kp, k0, sr)); S.st_k1 = load8<TIn>(ROW(Kp, k0, 32 + sr)); } while (0)
#define SWRITE_HK(bf) do { *(bf16x8*)(K_lds + (bf) * SHM_K + kws) = S.st_k0; *(bf16x8*)(K_lds + (bf) * SHM_K + kws + 32 * 256) = S.st_k1; } while (0)
#define SWRITE_HV(bf) do { *(bf16x8*)(V_lds + (bf) * SHM_V + vst0) = S.st_v0; *(bf16x8*)(V_lds + (bf) * SHM_V + vst1) = S.st_v1; } while (0)
#define SWRITE_H(bf) do { SWRITE_HV(bf); SWRITE_HK(bf); } while (0)
#define SLOAD_F(p, k0) do { S.sf0 = *(const f32x4*)ROW(p, k0, sr); S.sf1 = *(const f32x4*)(ROW(p, k0, sr) + 4);                \
                            S.sf2 = *(const f32x4*)ROW(p, k0, 32 + sr); S.sf3 = *(const f32x4*)(ROW(p, k0, 32 + sr) + 4); } while (0)
#define SWRITE_KF(bf) do { *(bf16x8*)(K_lds + (bf) * SHM_K + kws) = pack8(S.sf0, S.sf1); *(bf16x8*)(K_lds + (bf) * SHM_K + kws + 32 * 256) = pack8(S.sf2, S.sf3); } while (0)
#define SWRITE_VF(bf) do { *(bf16x8*)(V_lds + (bf) * SHM_V + vst0) = pack8(S.sf0, S.sf1); *(bf16x8*)(V_lds + (bf) * SHM_V + vst1) = pack8(S.sf2, S.sf3); } while (0)
template <class TIn, class TOut>
__device__ __forceinline__ void causal_swa_prime(const BlockRef<TIn, TOut>& cur, int W, char* lds, Seam<TIn>& S) {
    constexpr bool F32 = same_t<TIn, float>::v;
    int tid_ = threadIdx.x; asm volatile("" : "+v"(tid_));
    const int tid = tid_, wid = __builtin_amdgcn_readfirstlane(tid >> 6), lane = tid & 63, r32 = lane & 31, hi = lane >> 5;
    const int sr = tid >> 4, sc = (tid & 15) * 8, kws = KSWZ(sr, sc * 2); char* K_lds = lds + 2 * SHM_V;
    const int kb0 = cur.JLO * KVBLK;
    for (int d0 = 0; d0 < 8; ++d0) S.qr[d0] = load8<TIn>(cur.Q + (size_t)(wid * QBLK + r32) * D + d0 * 16 + hi * 8);
    if constexpr (F32) { SLOAD_F((const float*)cur.K, kb0); VMW(); SWRITE_KF(0); SBAR(); SLOAD_F((const float*)cur.V, kb0); }
    else { SLOAD_H(cur.K, cur.V, kb0); VMW(); SWRITE_HK(0); }
    __syncthreads();
}
template <class TIn, class TOut>
__device__ __forceinline__ void causal_swa_block(const BlockRef<TIn, TOut>& cur, const BlockRef<TIn, TOut>& nxt, int skv, int W, char* lds, Seam<TIn>& S, const BIAS_LAS float* bias, int bias_k0) {
    constexpr bool F32 = same_t<TIn, float>::v;
    int tid_ = threadIdx.x; asm volatile("" : "+v"(tid_));
    const int tid = tid_, wid = __builtin_amdgcn_readfirstlane(tid >> 6), lane = tid & 63, r32 = lane & 31, hi = lane >> 5;
    const int j_lo = cur.JLO;
    int j_hi = (cur.P0 + QB - 1) / KVBLK + 1; if (j_hi > skv / KVBLK) j_hi = skv / KVBLK;
    const int NT = j_hi - j_lo;
    const int kbn = nxt.JLO * KVBLK;
    const int qlo = cur.P0 + wid * QBLK, qm = qlo + r32 - 4 * hi;
    char* V_lds = lds; char* K_lds = lds + 2 * SHM_V;
    float* ws = (float*)(lds + 2 * SHM_V + 2 * SHM_K) + wid * 64; float* li_l = ws, * al_l = ws + 32;
    float m_reg = -1e30f, l_reg = 0; f32x16 o[4] = {};
    const int sr = tid >> 4, sc = (tid & 15) * 8, vst0 = v_st(sr, sc), vst1 = v_st(32 + sr, sc), kws = KSWZ(sr, sc * 2);
    const int vb0 = (int)(uintptr_t)V_lds + v_rd_base(lane);
    const TIn* Kh = cur.K; const TIn* Vh = cur.V;
#define RESC(a) do { if (__any((a) < 1.f)) { if (hi == 0) al_l[r32] = (a); asm volatile("s_waitcnt lgkmcnt(0)" ::: "memory");              \
                     for (int d_ = 0; d_ < 4; ++d_) for (int r = 0; r < 16; ++r) o[d_][r] *= al_l[crow(r, hi)]; } } while (0)
#define KBASE(t) ((j_lo + (t)) * KVBLK)
#define BP(t) (bias + (KBASE(t) - bias_k0) + 4 * hi)
#define ACT(t) (KBASE(t) <= qlo + QBLK - 1 && KBASE(t) + KVBLK - 1 >= qlo - W + 1)
#define MASKT(P0_, P1_, t) do { const int kb_ = KBASE(t); if ((!SK || ACT(t)) && (kb_ + KVBLK - 1 > qlo || kb_ <= qlo + QBLK - 1 - W)) mask_tile(P0_, P1_, qm - kb_, (unsigned)W); } while (0)
    constexpr int NQL = F32 ? 16 : 8;
    constexpr bool SK = WSKIP && !F32;
#define SEAM_K0() do { VMWN(NQL); if constexpr (F32) { SWRITE_KF(0); SBAR(); SLOAD_F((const float*)nxt.V, kbn); } else { SWRITE_HK(0); } SBAR(); } while (0)
    f32x16 pA0, pA1, pB0, pB1; float mnA, mnB, alA, alB; bf16x8 pa0, pa1, pa2, pa3;
    if constexpr (F32) { VMW(); SWRITE_VF(0); SBAR(); } else { SWRITE_HV(0); SBAR(); }
    if (NT > 1) { if constexpr (F32) SLOAD_F((const float*)Kh, KBASE(1)); else SLOAD_H(Kh, Vh, KBASE(1)); }
    SBAR(); qkt<0, SK>(pA0, pA1, K_lds, r32, hi, S.qr, ACT(0), BP(0));
    if constexpr (F32) { if (NT > 1) { VMW(); SWRITE_KF(1); SBAR(); SLOAD_F((const float*)Vh, KBASE(1)); } }
    MASKT(pA0, pA1, 0); partialSM(pA0, pA1, m_reg, mnA, alA);
    if (NT > 1) { VMW(); if constexpr (F32) { SWRITE_VF(1); SBAR(); if (NT > 2) SLOAD_F((const float*)Kh, KBASE(2)); } else SWRITE_H(1); }
    __syncthreads();
#define HALF_STEP(PX0, PX1, mnX, alX, PY0, PY1, alY, t, KB, VB, SB) do {                                                      \
        SBAR(); qkt<KB, SK>(PX0, PX1, K_lds, r32, hi, S.qr, ACT(t), BP(t));                                             \
        finishSM(PY0, PY1, alY, l_reg, pa0, pa1, pa2, pa3); SBAR();                                                           \
        if ((t) + 1 < NT) { if constexpr (F32) { VMW(); SWRITE_KF(SB); SBAR(); SLOAD_F((const float*)Vh, KBASE((t) + 1)); }  \
                            else { SLOAD_H(Kh, Vh, KBASE((t) + 1)); } SBAR(); }                                               \
        pv_tile<VB, SK>(o, vb0, pa0, pa1, pa2, pa3, ACT((t) - 1)); MASKT(PX0, PX1, (t)); partialSM(PX0, PX1, m_reg, mnX, alX);                                        \
        __syncthreads();                                                                                                      \
        if ((t) + 1 < NT) { VMW(); if constexpr (F32) { SWRITE_VF(SB); SBAR(); if ((t) + 2 < NT) SLOAD_F((const float*)Kh, KBASE((t) + 2)); } \
                            else { SWRITE_H(SB); } }                                                                          \
        RESC(alX); __syncthreads(); } while (0)
    for (int t = 1; t + 1 < NT; t += 2) {
        HALF_STEP(pB0, pB1, mnB, alB, pA0, pA1, alA, t, 1, 0, 0);
        HALF_STEP(pA0, pA1, mnA, alA, pB0, pB1, alB, t + 1, 0, 1, 1);
    }
    const bool even = (NT & 1) == 0;
    if (even) { SBAR(); qkt<1, SK>(pB0, pB1, K_lds, r32, hi, S.qr, ACT(NT - 1), BP(NT - 1)); SBAR(); }
#define QROW(e) (nxt.Q + (size_t)(wid * QBLK + r32) * D + ((e) >> 1) * 16 + hi * 8 + ((e) & 1) * 4)
    if constexpr (F32) { SLOAD_F((const float*)nxt.K, kbn); SBAR();
#pragma unroll
        for (int e = 0; e < 8; ++e) S.tq[e] = *(const f32x4*)QROW(e); }
    else { SLOAD_H(nxt.K, nxt.V, kbn); SBAR();
#pragma unroll
        for (int d0 = 0; d0 < 8; ++d0) S.qr[d0] = load8<TIn>(nxt.Q + (size_t)(wid * QBLK + r32) * D + d0 * 16 + hi * 8); }
    SBAR();
    finishSM(pA0, pA1, alA, l_reg, pa0, pa1, pa2, pa3); SBAR();
    if constexpr (F32) {
#pragma unroll
        for (int e = 8; e < 16; ++e) S.tq[e] = *(const f32x4*)QROW(e); SBAR(); }
#undef QROW
    pv_tile<0, SK>(o, vb0, pa0, pa1, pa2, pa3, ACT(even ? NT - 2 : NT - 1));
    if (even) { MASKT(pB0, pB1, NT - 1); partialSM(pB0, pB1, m_reg, mnB, alB); __syncthreads(); RESC(alB);
        finishSM(pB0, pB1, alB, l_reg, pa0, pa1, pa2, pa3); SBAR(); pv_tile<1, SK>(o, vb0, pa0, pa1, pa2, pa3, ACT(NT - 1)); }
    SBAR(); SEAM_K0();
    if (hi == 0) li_l[r32] = l_reg; asm volatile("s_waitcnt lgkmcnt(0)" ::: "memory");
    float rli[16];
#pragma unroll
    for (int r = 0; r < 16; ++r) rli[r] = __builtin_amdgcn_rcpf(li_l[crow(r, hi)]);
    TOut* Ow = cur.O + (size_t)(wid * QBLK) * LDO;
#pragma unroll
    for (int r = 0; r < 16; ++r) { int orow = crow(r, hi); asm volatile("" : "+v"(orow)); float sq = 0.f;
#pragma unroll
        for (int d0 = 0; d0 < 4; ++d0) { const float v = o[d0][r] * rli[r]; sq += v * v;
            { const float vn = __shfl_xor(v, 1);
                   if ((r32 & 1) == 0) *(unsigned*)(Ow + (size_t)orow * LDO + d0 * 32 + r32) = cvtpk(v, vn); } }
        sq += __shfl_xor(sq, 1); sq += __shfl_xor(sq, 2); sq += __shfl_xor(sq, 4); sq += __shfl_xor(sq, 8); sq += __shfl_xor(sq, 16);
        if (r32 == 0) cur.SSQ[(size_t)(wid * QBLK + orow) * 32] = sq; }
    if constexpr (F32) {
#pragma unroll
        for (int d0 = 0; d0 < 8; ++d0) S.qr[d0] = pack8(S.tq[2 * d0], S.tq[2 * d0 + 1]); }
    __syncthreads();
#undef RESC
#undef KBASE
#undef BP
#undef ACT
#undef MASKT
#undef SEAM_K0
#undef HALF_STEP
}
#undef ROW
#undef VMW
#undef VMWN
#undef SLOAD_H
#undef SWRITE_HK
#undef SWRITE_HV
#undef SWRITE_H
#undef SLOAD_F
#undef SWRITE_KF
#undef SWRITE_VF
}
#define LAS __attribute__((address_space(3)))
typedef unsigned short bf16_t;
struct Args { const float* in[26]; float* out; unsigned char* ws; };

__device__ __forceinline__ float wave_sum(float v) {
#pragma unroll
    for (int o = 1; o < 64; o <<= 1) v += __shfl_xor(v, o);
    return v;
}
__device__ __forceinline__ unsigned pk2(float lo, float hi) { return pg8::cvt_pk_bf16(lo, hi); }

__device__ __forceinline__ void tr_item(const float* __restrict__ W, int ldw, int srccol0, int k0, bf16_t* __restrict__ WT, int K, int dstrow0,
                                        const float* rs0, const float* rs1, LAS float* scr, int lane) {
#pragma unroll 8
    for (int i = 0; i < 32; ++i) { const int kk = 2 * i + (lane >> 5); float v = W[(size_t)(k0 + kk) * ldw + srccol0 + (lane & 31)];
        if (rs0) { const int k = k0 + kk; v *= (k < 1024 ? rs0[k] : rs1[k - 1024]); }
        scr[kk * 33 + (lane & 31)] = v; }
    asm volatile("s_waitcnt lgkmcnt(0)" ::: "memory");
    const int c = lane & 7;
#pragma unroll
    for (int j = 0; j < 4; ++j) { const int n = (lane >> 3) + 8 * j; const LAS float* s = scr + (8 * c) * 33 + n;
        u32x4_t o; o.x = pk2(s[0 * 33], s[1 * 33]); o.y = pk2(s[2 * 33], s[3 * 33]); o.z = pk2(s[4 * 33], s[5 * 33]); o.w = pk2(s[6 * 33], s[7 * 33]);
        *(u32x4_t*)(WT + (size_t)(dstrow0 + n) * K + k0 + 8 * c) = o; }
    asm volatile("s_waitcnt lgkmcnt(0)" ::: "memory");
}

__device__ __forceinline__ void ssm_setup_item(const Args& a, unsigned char* ws, LAS unsigned char* lds, int g, int qtr, int tid) {
    LAS float* Bre = (LAS float*)lds; LAS float* Bim = Bre + 1024; LAS float* Cre = Bre + 2048; LAS float* Cim = Bre + 3072;
    LAS float* Pr = Bre + 4096; LAS float* Pi = Pr + 33 * 64; LAS float* MZr = Pi + 33 * 64; LAS float* MZi = MZr + 32 * 64; LAS float* KT = MZi + 32 * 64;
    const float* b_re = a.in[10] + (size_t)g * 1024; const float* b_im = a.in[11] + (size_t)g * 1024;
    const float* c_re = a.in[12] + (size_t)g * 1024; const float* c_im = a.in[13] + (size_t)g * 1024;
    for (int i = tid; i < 1024; i += 512) { Bre[i] = b_re[i]; Bim[i] = b_im[i]; Cre[i] = c_re[i]; Cim[i] = c_im[i]; }
    if (tid < 64) {
        const int p = tid; const float dt = expf(a.in[9][g]); const float ar = a.in[7][g * NP + p], ai = a.in[8][g * NP + p];
        const float mag = expf(dt * ar); const float abr = mag * cosf(dt * ai), abi = mag * sinf(dt * ai);
        const float nre = abr - 1.f, nim = abi, den = ar * ar + ai * ai;
        const float zr = (nre * ar + nim * ai) / den, zi = (nim * ar - nre * ai) / den;
        float pr = 1.f, pi = 0.f;
        for (int j = 0; j <= 32; ++j) {
            Pr[j * 64 + p] = pr; Pi[j * 64 + p] = pi;
            if (j < 32) { MZr[j * 64 + p] = pr * zr - pi * zi; MZi[j * 64 + p] = pr * zi + pi * zr; }
            const float nr = pr * abr - pi * abi, ni = pr * abi + pi * abr; pr = nr; pi = ni;
        }
        if (qtr == 0) { float* P32 = (float*)(ws + WS_P32); P32[(g * NP + p) * 2] = Pr[32 * 64 + p]; P32[(g * NP + p) * 2 + 1] = Pi[32 * 64 + p]; }
    }
    __syncthreads();
    const float* dsk = a.in[14] + g * GCH;
    for (int idx = tid; idx < 8192; idx += 512) {
        const int j = idx >> 8, h = (idx >> 4) & 15, i = idx & 15; float sum = 0.f;
        for (int p = 0; p < 64; ++p) { const float mr = MZr[j * 64 + p], mi = MZi[j * 64 + p], br = Bre[p * 16 + i], bi = Bim[p * 16 + i];
            const float bzr = mr * br - mi * bi, bzi = mr * bi + mi * br; sum += Cre[h * 64 + p] * bzr - Cim[h * 64 + p] * bzi; }
        if (j == 0 && h == i) sum += dsk[h];
        KT[idx] = sum;
    }
    __syncthreads();
    bf16_t* GC = (bf16_t*)(ws + WS_GC) + (size_t)g * 512 * KA;
    for (int ci = tid; ci < 128 * 80; ci += 512) {
        const int nl = ci / 80, ch = ci - nl * 80, n = qtr * 128 + nl, t = n >> 4, h = n & 15; float v[8];
        if (ch < 64) { const int s = ch >> 1, i0 = (ch & 1) * 8;
#pragma unroll
            for (int e = 0; e < 8; ++e) v[e] = (s <= t) ? KT[((t - s) << 8) + (h << 4) + i0 + e] : 0.f;
        } else { const int pp = (ch - 64) * 8;
#pragma unroll
            for (int e = 0; e < 8; ++e) { const int p = (pp + e) & 63; const float cr = Cre[h * 64 + p], cim = Cim[h * 64 + p], pr = Pr[(t + 1) * 64 + p], pi = Pi[(t + 1) * 64 + p];
                v[e] = (pp < 64) ? (cr * pr - cim * pi) : -(cr * pi + cim * pr); }
        }
        u32x4_t o; o.x = pk2(v[0], v[1]); o.y = pk2(v[2], v[3]); o.z = pk2(v[4], v[5]); o.w = pk2(v[6], v[7]);
        *(u32x4_t*)(GC + (size_t)n * KA + ch * 8) = o;
    }
    bf16_t* WE = (bf16_t*)(ws + WS_WEND) + (size_t)g * 256 * 512;
    for (int ci = tid; ci < 64 * 64; ci += 512) {
        const int rl = ci >> 6, ch = ci & 63, pr_ = qtr * 64 + rl, s = ch >> 1, i0 = (ch & 1) * 8, p = pr_ & 63; float v[8];
#pragma unroll
        for (int e = 0; e < 8; ++e) { const float mr = MZr[(31 - s) * 64 + p], mi = MZi[(31 - s) * 64 + p], br = Bre[p * 16 + i0 + e], bi = Bim[p * 16 + i0 + e];
            v[e] = (pr_ < 64) ? (mr * br - mi * bi) : ((pr_ < 128) ? (mr * bi + mi * br) : 0.f); }
        u32x4_t o; o.x = pk2(v[0], v[1]); o.y = pk2(v[2], v[3]); o.z = pk2(v[4], v[5]); o.w = pk2(v[6], v[7]);
        *(u32x4_t*)(WE + (size_t)pr_ * 512 + ch * 8) = o;
    }
    __syncthreads();
}

__device__ __forceinline__ void norm_mod_row(const float* xrow, bf16_t* orow, const LAS float* gs, const LAS float* shv, int lane, f32x4_t (&v)[8]) {
    const f32x4_t* xr = (const f32x4_t*)xrow + lane; float s = 0.f;
#pragma unroll
    for (int j = 0; j < 8; ++j) { v[j] = xr[64 * j]; s += (v[j][0] * v[j][0] + v[j][1] * v[j][1]) + (v[j][2] * v[j][2] + v[j][3] * v[j][3]); }
    const float rstd = 1.0f / sqrtf(wave_sum(s) * (1.0f / DM) + EPS);
#pragma unroll
    for (int j = 0; j < 8; ++j) { const int k = 4 * lane + 256 * j; const f32x4_t g4 = *(const LAS f32x4_t*)(gs + k), s4 = *(const LAS f32x4_t*)(shv + k);
        v[j] = v[j] * rstd * g4 + s4;
        u32x2_t o; o.x = pk2(v[j][0], v[j][1]); o.y = pk2(v[j][2], v[j][3]); *(u32x2_t*)(orow + k) = o; }
}

__global__ void __launch_bounds__(512, 2) fwd_kernel(Args a) {
    extern __shared__ __attribute__((aligned(16))) unsigned char lds_raw[];
    cg::grid_group grid = cg::this_grid();
    LAS unsigned char* lds = (LAS unsigned char*)lds_raw;
    const int tid = threadIdx.x, lane = tid & 63, wave = __builtin_amdgcn_readfirstlane(tid >> 6), G = gridDim.x, bid = blockIdx.x;
    const int gw = bid * 8 + wave, NGW = G * 8;
    unsigned char* ws = a.ws;
    float* MODP = (float*)(ws + WS_MODP); float* MOD = (float*)(ws + WS_MOD); float* LF = (float*)(ws + WS_LF); float* CBR = (float*)(ws + WS_CBR);
    float* SSQ = (float*)(ws + WS_SSQ); float* SSQ2 = (float*)(ws + WS_SSQ2);
    bf16_t* WDT = (bf16_t*)(ws + WS_WDT); bf16_t* W1T = (bf16_t*)(ws + WS_W1T); bf16_t* WGT = (bf16_t*)(ws + WS_WGT); bf16_t* WOT = (bf16_t*)(ws + WS_WOT); bf16_t* WUT = (bf16_t*)(ws + WS_WUT);
    bf16_t* GC = (bf16_t*)(ws + WS_GC); bf16_t* WEND = (bf16_t*)(ws + WS_WEND); bf16_t* AALL = (bf16_t*)(ws + WS_AALL); bf16_t* QKV = (bf16_t*)(ws + WS_QKV);
    bf16_t* YB = (bf16_t*)(ws + WS_YB); bf16_t* MIX = (bf16_t*)(ws + WS_MIX); bf16_t* HN = (bf16_t*)(ws + WS_HN); bf16_t* ABUF = (bf16_t*)(ws + WS_ABUF); bf16_t* BBUF = (bf16_t*)(ws + WS_BBUF);
    const float* x = a.in[0]; float* OUT = a.out;

    {
        LAS f32x4_t* red = (LAS f32x4_t*)lds; const float* cvec = a.in[1]; const float* w_ada = a.in[2];
        for (int it = bid; it < 768; it += G) {
            const int nc = it % 48, ks = it / 48, n0 = nc * 256, k0 = ks * 128 + wave * 16;
            f32x4_t acc = {0.f, 0.f, 0.f, 0.f};
#pragma unroll
            for (int r = 0; r < 16; ++r) { const int k = k0 + r; const float cv = cvec[k]; const float sv = cv / (1.0f + expf(-cv));
                const f32x4_t w = *(const f32x4_t*)(w_ada + (size_t)k * (6 * DM) + n0 + 4 * lane); acc += sv * w; }
            red[wave * 64 + lane] = acc;
            __syncthreads();
            if (tid < 256) { float s = 0.f;
#pragma unroll
                for (int w = 0; w < 8; ++w) s += ((LAS float*)red)[w * 256 + tid];
                MODP[ks * (6 * DM) + n0 + tid] = s; }
            __syncthreads();
        }
    }
    for (int it = bid; it < 4 * NG; it += G) ssm_setup_item(a, ws, lds, it >> 2, it & 3, tid);
    __syncthreads();
    {
        LAS float* scr = (LAS float*)(lds + wave * 16384);
        constexpr int I_IN = 32 * 128, I_GLU = 16 * 32, I_OUT = 32 * 64, I_UP = 32 * 352, I_DN = 88 * 64, I_ALL = I_IN + I_GLU + I_OUT + I_UP + I_DN;
        for (int it = gw; it < I_ALL; it += NGW) {
            int r = it;
            if (r < I_IN) { const int kb = r / 128, n0 = 32 * (r % 128); tr_item(a.in[5], INW, n0 < 3072 ? n0 : n0 + 8, 64 * kb, W1T, DM, n0, nullptr, nullptr, scr, lane); continue; } r -= I_IN;
            if (r < I_GLU) { const int kb = r / 32, n0 = 32 * (r % 32); tr_item(a.in[15], SW, n0, 64 * kb, WGT, SW, n0, nullptr, nullptr, scr, lane); continue; } r -= I_GLU;
            if (r < I_OUT) { const int kb = r / 64, n0 = 32 * (r % 64); tr_item(a.in[19], DM, n0, 64 * kb, WOT, DM, n0, a.in[17], a.in[18], scr, lane); continue; } r -= I_OUT;
            if (r < I_UP) { const int kb = r / 352, n0 = 32 * (r % 352); const int pn = n0 >> 8, bj = (n0 >> 7) & 1, w = n0 & 127;
                tr_item(a.in[21], 2 * DFF, bj * DFF + 128 * pn + w, 64 * kb, WUT, DM, n0, nullptr, nullptr, scr, lane); continue; } r -= I_UP;
            { const int kb = r / 64, n0 = 32 * (r % 64); tr_item(a.in[24], DM, n0, 64 * kb, WDT, DFF, n0, nullptr, nullptr, scr, lane); }
        }
    }
    grid.sync();

    {
        LAS float* gs = (LAS float*)lds; LAS float* shv = gs + DM; LAS float* wf = shv + DM;
        const float* b_ada = a.in[3]; const float* g_mix = a.in[4]; const float* w_in = a.in[5];
        for (int k = tid; k < DM; k += 512) { float sh = b_ada[k], sc = b_ada[DM + k];
            for (int j = 0; j < 16; ++j) { sh += MODP[j * (6 * DM) + k]; sc += MODP[j * (6 * DM) + DM + k]; }
            gs[k] = g_mix[k] * (1.0f + sc); shv[k] = sh; }
        for (int i = tid; i < DM * 8; i += 512) wf[i] = w_in[(size_t)(i >> 3) * INW + 3072 + (i & 7)];
        for (int n = bid * 512 + tid; n < 6 * DM; n += G * 512) { float m = b_ada[n]; for (int j = 0; j < 16; ++j) m += MODP[j * (6 * DM) + n]; MOD[n] = m; }
        __syncthreads();
        const float* b_f = a.in[6];
        for (int row = gw; row < SEQ; row += NGW) {
            f32x4_t v[8]; norm_mod_row(x + (size_t)row * DM, HN + (size_t)row * DM, gs, shv, lane, v);
            f32x4_t f0 = {0.f, 0.f, 0.f, 0.f}, f1 = {0.f, 0.f, 0.f, 0.f};
#pragma unroll
            for (int j = 0; j < 8; ++j)
#pragma unroll
                for (int e = 0; e < 4; ++e) { const int k = 4 * lane + 256 * j + e; const f32x4_t w0 = *(const LAS f32x4_t*)(wf + k * 8), w1 = *(const LAS f32x4_t*)(wf + k * 8 + 4);
                    f0 += v[j][e] * w0; f1 += v[j][e] * w1; }
            float fd = 0.f;
#pragma unroll
            for (int h = 0; h < 8; ++h) { const float t = wave_sum(h < 4 ? f0[h & 3] : f1[h & 3]); if (lane == h) fd = t; }
            if (lane < 8) { const float z = fd + b_f[lane]; LF[lane * SEQ + row] = fminf(z, 0.f) - log1pf(expf(-fabsf(z))); }
        }
    }
    grid.sync();

    if (bid < NH) {
        LAS double* tot = (LAS double*)lds; const int h = bid; const float* src = LF + h * SEQ + tid * 16;
        float vals[16];
#pragma unroll
        for (int q = 0; q < 4; ++q) { const f32x4_t t = *(const f32x4_t*)(src + 4 * q); vals[4 * q] = t[0]; vals[4 * q + 1] = t[1]; vals[4 * q + 2] = t[2]; vals[4 * q + 3] = t[3]; }
        double run = 0.0;
#pragma unroll
        for (int e = 0; e < 16; ++e) run += (double)vals[e];
        tot[tid] = run;
        __syncthreads();
        double c = 0.0; for (int i = 0; i < tid; ++i) c += tot[i];
        float* dst = CBR + h * SEQ + tid * 16;
#pragma unroll
        for (int e = 0; e < 16; ++e) { c += (double)vals[e]; dst[e] = -(float)(c * 11.313708498984761); }
        __syncthreads();
    }
    {
        pg8::Gemm g{HN, W1T, SEQ, 4096, DM, DM, DM}; pg8::StaticOrder S; S.init(SEQ, 4096, G, bid);
        pg8::EpiQKVU E{QKV, AALL};
#ifndef NO_G1
        pg8::gemm_phase<pg8::EpiQKVU, pg8::StaticOrder, true, true>(lds, g, S, E);
#endif
    }
    grid.sync();

    {
        pg8::Gemm g{AALL, WEND, NG * NCH, NG * 256, CL * GCH, KA, CL * GCH}; pg8::CarryOrder S{G, bid};
        pg8::EpiCarry E{AALL, (const float*)(ws + WS_P32)};
#ifndef NO_G2
        pg8::gemm_phase<pg8::EpiCarry, pg8::CarryOrder, false, true>(lds, g, S, E);
#endif
    }
    grid.sync();

    {
        using abf = att::bf16;
        char* ldsg = (char*)lds_raw;
        BIAS_LAS float* bias = (BIAS_LAS float*)(lds + att::BIAS_OFF);
        att::Seam<abf> Sm;
        if (bid < NH * (SEQ / att::QB)) { const int it = bid;
            const int head = it & 7, qb = (SEQ / att::QB - 1) - (it >> 3), P0 = qb * att::QB;
            for (int k = tid * 4; k < P0 + att::QB; k += 2048) *(BIAS_LAS f32x4_t*)(bias + k) = *(const f32x4_t*)(CBR + head * SEQ + k);
            __syncthreads();
            att::BlockRef<abf, abf> cur;
            cur.Q = (const abf*)QKV + ((size_t)(0 * NH + head) * SEQ + P0) * HD; cur.K = (const abf*)QKV + (size_t)(1 * NH + head) * SEQ * HD; cur.V = (const abf*)QKV + (size_t)(2 * NH + head) * SEQ * HD;
            cur.O = (abf*)MIX + (size_t)P0 * DM + head * HD; cur.P0 = P0; cur.JLO = 0; cur.SSQ = SSQ + (size_t)P0 * 32 + head;
#ifndef NO_ATT
            att::causal_swa_prime<abf, abf>(cur, 1 << 30, ldsg, Sm);
            att::causal_swa_block<abf, abf>(cur, cur, SEQ, 1 << 30, ldsg, Sm, bias, 0);
#endif
        }
        asm volatile("s_waitcnt vmcnt(0)" ::: "memory");
        __syncthreads();
        pg8::Gemm g{AALL, GC, NG * NCH, NG * 512, KA, KA, KA}; pg8::ChunkOrder S{G, G - 1 - bid};
        pg8::EpiY E{YB};
#ifndef NO_G3
        pg8::gemm_phase<pg8::EpiY, pg8::ChunkOrder, true, true>(lds, g, S, E);
#endif
    }
    grid.sync();

    {
        pg8::Gemm g{YB, WGT, SEQ, SW, SW, SW, SW}; pg8::StaticOrder S; S.init(SEQ, SW, G, bid);
        pg8::EpiGlu E{YB, MIX, a.in[16], SSQ};
#ifndef NO_G4
        pg8::gemm_phase<pg8::EpiGlu, pg8::StaticOrder, true, true>(lds, g, S, E);
#endif
    }
    grid.sync();

    {
        pg8::Gemm g{MIX, WOT, SEQ, DM, DM, DM, DM}; pg8::StaticOrder S; S.init(SEQ, DM, G, bid);
        LAS float* rtab = (LAS float*)(lds + RING_BYTES);
        { pg8::Unit u0; if (S.next(0, u0) && tid < 256) { float ra, rs; pg8::EpiWout::rstds(SSQ, u0.pm * 256 + tid, ra, rs); rtab[2 * tid] = ra / rs; rtab[2 * tid + 1] = rs; } }
        __syncthreads();
        pg8::EpiWout E{rtab, x, MOD + 2 * DM, OUT};
#ifndef NO_G5
        pg8::gemm_phase<pg8::EpiWout, pg8::StaticOrder, true, true>(lds, g, S, E);
#endif
    }
    grid.sync();

    {
        LAS float* gs = (LAS float*)lds; LAS float* shv = gs + DM; const float* g_ffn = a.in[20];
        for (int k = tid; k < DM; k += 512) { gs[k] = g_ffn[k] * (1.0f + MOD[4 * DM + k]); shv[k] = MOD[3 * DM + k]; }
        __syncthreads();
        for (int row = gw; row < SEQ; row += NGW) { f32x4_t v[8]; norm_mod_row(OUT + (size_t)row * DM, HN + (size_t)row * DM, gs, shv, lane, v); }
    }
    grid.sync();

    {
        pg8::Gemm g{HN, WUT, SEQ, 2 * DFF, DM, DM, DM}; pg8::StaticOrder S; S.init(SEQ, 2 * DFF, G, bid);
        pg8::EpiUp E{ABUF, BBUF};
#ifndef NO_G6
        pg8::gemm_phase<pg8::EpiUp, pg8::StaticOrder, true, true>(lds, g, S, E);
#endif
    }
    grid.sync();

    {
        const float* cw = a.in[22]; const float* cbias = a.in[23];
        constexpr int NCC = DFF / 8, NRB = SEQ / 16;
        for (int id = bid * 512 + tid; id < NRB * NCC; id += G * 512) {
            const int rb = id / NCC, cc = id - rb * NCC, col = cc * 8, t0 = rb * 16;
            float w0[8], w1[8], w2[8], cb[8], am2[8], am1[8];
#pragma unroll
            for (int q = 0; q < 2; ++q) { const f32x4_t u0 = *(const f32x4_t*)(cw + col + 4 * q), u1 = *(const f32x4_t*)(cw + DFF + col + 4 * q), u2 = *(const f32x4_t*)(cw + 2 * DFF + col + 4 * q), u3 = *(const f32x4_t*)(cbias + col + 4 * q);
#pragma unroll
                for (int e = 0; e < 4; ++e) { w0[4 * q + e] = u0[e]; w1[4 * q + e] = u1[e]; w2[4 * q + e] = u2[e]; cb[4 * q + e] = u3[e]; } }
#pragma unroll
            for (int e = 0; e < 8; ++e) { am2[e] = 0.f; am1[e] = 0.f; }
            if (t0 > 0) { const u32x4_t p2 = *(const u32x4_t*)(ABUF + (size_t)(t0 - 2) * DFF + col), p1 = *(const u32x4_t*)(ABUF + (size_t)(t0 - 1) * DFF + col);
                am2[0] = bf_lo(p2.x); am2[1] = bf_hi(p2.x); am2[2] = bf_lo(p2.y); am2[3] = bf_hi(p2.y); am2[4] = bf_lo(p2.z); am2[5] = bf_hi(p2.z); am2[6] = bf_lo(p2.w); am2[7] = bf_hi(p2.w);
                am1[0] = bf_lo(p1.x); am1[1] = bf_hi(p1.x); am1[2] = bf_lo(p1.y); am1[3] = bf_hi(p1.y); am1[4] = bf_lo(p1.z); am1[5] = bf_hi(p1.z); am1[6] = bf_lo(p1.w); am1[7] = bf_hi(p1.w); }
            for (int r = 0; r < 16; ++r) {
                const size_t off = (size_t)(t0 + r) * DFF + col;
                const u32x4_t pa = *(const u32x4_t*)(ABUF + off), pb = *(const u32x4_t*)(BBUF + off);
                float av[8], bv[8], gv[8];
                av[0] = bf_lo(pa.x); av[1] = bf_hi(pa.x); av[2] = bf_lo(pa.y); av[3] = bf_hi(pa.y); av[4] = bf_lo(pa.z); av[5] = bf_hi(pa.z); av[6] = bf_lo(pa.w); av[7] = bf_hi(pa.w);
                bv[0] = bf_lo(pb.x); bv[1] = bf_hi(pb.x); bv[2] = bf_lo(pb.y); bv[3] = bf_hi(pb.y); bv[4] = bf_lo(pb.z); bv[5] = bf_hi(pb.z); bv[6] = bf_lo(pb.w); bv[7] = bf_hi(pb.w);
#pragma unroll
                for (int e = 0; e < 8; ++e) { const float cv = cb[e] + w0[e] * am2[e] + w1[e] * am1[e] + w2[e] * av[e]; gv[e] = cv * fast_sigmoid(cv) * bv[e]; am2[e] = am1[e]; am1[e] = av[e]; }
                u32x4_t o; o.x = pk2(gv[0], gv[1]); o.y = pk2(gv[2], gv[3]); o.z = pk2(gv[4], gv[5]); o.w = pk2(gv[6], gv[7]);
                *(u32x4_t*)(BBUF + off) = o;
            }
        }
    }
    grid.sync();

    {
        pg8::Gemm g{BBUF, WDT, SEQ, DM, DFF, DFF, DFF}; pg8::StaticOrder S; S.init(SEQ, DM, G, bid);
        pg8::EpiDown E{MOD + 5 * DM, OUT, SSQ2};
#ifndef NO_G7
        pg8::gemm_phase<pg8::EpiDown, pg8::StaticOrder, true, true>(lds, g, S, E);
#endif
    }
    grid.sync();

    {
        const float* gf = a.in[25];
        for (int row = gw; row < SEQ; row += NGW) {
            const float part = lane < 32 ? SSQ2[(size_t)row * 32 + lane] : 0.f;
            const float rstd = 1.0f / sqrtf(wave_sum(part) * (1.0f / DM) + EPS);
            f32x4_t* orow = (f32x4_t*)(OUT + (size_t)row * DM) + lane; const f32x4_t* g4 = (const f32x4_t*)gf + lane;
#pragma unroll
            for (int j = 0; j < 8; ++j) orow[64 * j] = orow[64 * j] * rstd * g4[64 * j];
        }
    }
}

extern "C" void kernel_launch(void* const* d_in, const int* in_sizes, int n_in, void* d_out, int out_size, void* d_ws, size_t ws_size, hipStream_t stream) {
    static int grid = 0;
    if (grid == 0) {
        if (n_in != 26 || out_size != SEQ * DM || ws_size < WS_END) { fprintf(stderr, "kernel_launch: unexpected shapes (n_in %d out %d ws %zu)\n", n_in, out_size, ws_size); grid = -1; return; }
        int dev = 0, cus = 0, per_cu = 0;
        (void)hipGetDevice(&dev); (void)hipDeviceGetAttribute(&cus, hipDeviceAttributeMultiprocessorCount, dev);
        if (hipFuncSetAttribute((const void*)fwd_kernel, hipFuncAttributeMaxDynamicSharedMemorySize, LDS_BYTES) != hipSuccess) { fprintf(stderr, "kernel_launch: hipFuncSetAttribute failed\n"); grid = -1; return; }
        if (hipOccupancyMaxActiveBlocksPerMultiprocessor(&per_cu, (const void*)fwd_kernel, 512, LDS_BYTES) != hipSuccess || per_cu < 1) { fprintf(stderr, "kernel_launch: occupancy query gave %d\n", per_cu); per_cu = 1; }
        (void)hipGetLastError();
        grid = cus;
        if (grid > 256) grid = 256;
    }
    if (grid < 0) return;
    (void)hipMemsetAsync((char*)d_ws + WS_CTL, 0, CTL_ZERO_BYTES, stream);
    Args a{};
    for (int i = 0; i < 26; ++i) a.in[i] = (const float*)d_in[i];
    a.out = (float*)d_out; a.ws = (unsigned char*)d_ws;
    void* args[] = {&a};
    hipError_t e = hipLaunchCooperativeKernel((const void*)fwd_kernel, dim3(grid), dim3(512), args, LDS_BYTES, stream);
    if (e != hipSuccess) fprintf(stderr, "cooperative launch failed: %s (grid %d)\n", hipGetErrorString(e), grid);
}
```

```cpp
#include <hip/hip_runtime.h>
#include <hip/hip_cooperative_groups.h>
#include <cstdio>
#include <cstdint>
namespace cg = cooperative_groups;

constexpr int SEQ = 8192, DM = 2048, AW = 1024, HD = 128, NH = 8, SW = 1024, NG = 64, GCH = 16, NP = 64, INW = 4104, DFF = 5632;
constexpr int CL = 32, NCH = SEQ / CL;
constexpr int KA = CL * GCH + 2 * NP;
constexpr float EPS = 1e-6f;
constexpr size_t MiB = 1u << 20, KiB = 1024;
constexpr size_t WS_CTL = 0, CTL_ZERO_BYTES = 1 * MiB;
constexpr size_t WS_MODP = 1 * MiB;
constexpr size_t WS_MOD = 2 * MiB;
constexpr size_t WS_LF = 2 * MiB + 64 * KiB;
constexpr size_t WS_CBR = 2 * MiB + 320 * KiB;
constexpr size_t WS_P32 = 2 * MiB + 576 * KiB;
constexpr size_t WS_SSQ = 3 * MiB;
constexpr size_t WS_SSQ2 = 4 * MiB;
constexpr size_t WS_WDT = 8 * MiB;
constexpr size_t WS_W1T = 30 * MiB;
constexpr size_t WS_WGT = 46 * MiB;
constexpr size_t WS_WOT = 48 * MiB;
constexpr size_t WS_WUT = 56 * MiB;
constexpr size_t WS_GC = 100 * MiB;
constexpr size_t WS_WEND = 140 * MiB;
constexpr size_t WS_AALL = 156 * MiB;
constexpr size_t WS_QKV = 176 * MiB;
constexpr size_t WS_YB = 224 * MiB;
constexpr size_t WS_MIX = 240 * MiB;
constexpr size_t WS_HN = 280 * MiB;
constexpr size_t WS_ABUF = 100 * MiB;
constexpr size_t WS_BBUF = 188 * MiB;
constexpr size_t WS_END = 312 * MiB;
static_assert(WS_ABUF + (size_t)SEQ * DFF * 2 <= WS_BBUF && WS_BBUF + (size_t)SEQ * DFF * 2 <= WS_HN && WS_HN + (size_t)SEQ * DM * 2 <= WS_END, "ws map");
static_assert(WS_WUT + (size_t)2 * DFF * DM * 2 <= WS_GC && WS_GC + (size_t)NG * 512 * KA * 2 <= WS_WEND && WS_WEND + (size_t)NG * 256 * 512 * 2 <= WS_AALL && WS_AALL + (size_t)NG * 256 * KA * 2 <= WS_QKV, "ws map 2");
static_assert(WS_QKV + (size_t)3 * SEQ * AW * 2 <= WS_YB && WS_YB + (size_t)SEQ * SW * 2 <= WS_MIX && WS_MIX + (size_t)SEQ * DM * 2 <= WS_HN, "ws map 3");
static_assert(WS_WDT + (size_t)DM * DFF * 2 <= WS_W1T && WS_W1T + (size_t)4096 * DM * 2 <= WS_WGT && WS_WOT + (size_t)DM * DM * 2 <= WS_WUT, "ws map 4");
constexpr int LDS_BYTES = 147456;
constexpr int RING_BYTES = 131072;

typedef float f32x4_t __attribute__((ext_vector_type(4)));
typedef unsigned u32x4_t __attribute__((ext_vector_type(4)));
typedef unsigned u32x2_t __attribute__((ext_vector_type(2)));
__device__ __forceinline__ float bf_lo(unsigned w) { return __uint_as_float(w << 16); }
__device__ __forceinline__ float bf_hi(unsigned w) { return __uint_as_float(w & 0xffff0000u); }
__device__ __forceinline__ float fast_sigmoid(float z) { return __builtin_amdgcn_rcpf(1.0f + __builtin_amdgcn_exp2f(-1.4426950408889634f * z)); }
__device__ __forceinline__ float gelu_tanh(float v) { const float z = 1.5957691216057308f * (v + 0.044715f * v * v * v); return v * fast_sigmoid(z); }

namespace pg8 {
#define PG8_LAS __attribute__((address_space(3)))
typedef unsigned short bf16_t;
typedef short bf16x8 __attribute__((ext_vector_type(8)));
typedef float f32x4 __attribute__((ext_vector_type(4)));
typedef unsigned u32x4 __attribute__((ext_vector_type(4)));
constexpr int BM = 256, BK = 64, HALF = 128, HTB = HALF * BK * 2  , STAGE_BYTES = 8 * HTB, NXCD = 8, WGM = 8;

__host__ __device__ __forceinline__ int lds_byte(int r, int c) { const int st = (r >> 4) * 2 + (c >> 5), rr = r & 15, cc = c & 31, ob = rr * 64 + cc * 2; return st * 1024 + (ob ^ (((ob >> 9) & 1) << 5)); }
__host__ __device__ __forceinline__ void stage_rc(int b, int& R, int& C) { const int st = b / 1024, sb = b % 1024, swz = sb ^ (((sb >> 9) & 1) << 5); R = (st >> 1) * 16 + swz / 64; C = (st & 1) * 32 + (swz % 64) / 2; }
__host__ __device__ __forceinline__ int perm32(int rho) { const int n = rho >> 4, i = rho & 15; return 8 * (i >> 2) + 4 * n + (i & 3); }

struct Unit { int pm, pn; };
struct Gemm { const bf16_t* A; const bf16_t* Bt; int M, N, K, lda, ldb; };

struct StaticOrder {
    int nM, nN, nwg, G, c;
    __host__ __device__ void init(int M, int N, int G_, int c_) { nM = M / BM; nN = N / BM; nwg = nM * nN; G = G_; c = c_; }
    __host__ __device__ bool next(int i, Unit& u) const {
        const long L = (long)i * G + c; if (L >= nwg) return false;
        int wgid = (int)L; { const int q = nwg / NXCD, r = nwg % NXCD, xcd = wgid % NXCD, off = wgid / NXCD; wgid = (xcd < r ? xcd * (q + 1) : r * (q + 1) + (xcd - r) * q) + off; }
        const int nig = WGM * nN, gid = wgid / nig, fm = gid * WGM, gsz = (nM - fm) < WGM ? (nM - fm) : WGM;
        u.pm = fm + ((wgid % nig) % gsz); u.pn = (wgid % nig) / gsz; return true;
    }
    __device__ __forceinline__ void a_ready(const Unit&) const {}
    __device__ __forceinline__ void done(const Unit&) const {}
};


template <class Epi, class Sched, bool ALIGN_EPI = false, bool SP2 = false>
__device__ __forceinline__ void gemm_phase(PG8_LAS unsigned char* lds, const Gemm g, const Sched& S, const Epi& E) {
    int tid_ = threadIdx.x; asm volatile("" : "+v"(tid_));
    const int tid = tid_, wid = __builtin_amdgcn_readfirstlane(tid >> 6), lane = tid & 63, wr = wid >> 2, wc = wid & 3, fr = lane & 15, fq = lane >> 4;
    const int K = g.K, nt = K / BK;
    unsigned voffA[2], voffB[2];
#pragma unroll
    for (int i = 0; i < 2; ++i) { int R, C; stage_rc(tid * 16 + i * 8192, R, C); const int Rb = Epi::PERM ? ((R & ~31) + perm32(R & 31)) : R;
        voffA[i] = (unsigned)(R * g.lda + C) * 2u; voffB[i] = (unsigned)(Rb * g.ldb + C) * 2u; }
    const size_t kstep = (size_t)(BK * 2);
    const size_t hstepA = (size_t)HALF * g.lda * 2, hstepB = (size_t)HALF * g.ldb * 2;
    const size_t tstepA = 2 * hstepA, tstepB = 2 * hstepB;
    const unsigned ldsw = (unsigned)wid * 1024u;
    const int aoff = lds_byte(wr * 64 + fr, fq * 8), boff = lds_byte(wc * 32 + fr, fq * 8);
#define PG8_SA(b, h) (((b) * 2 + (h)) * HTB)
#define PG8_SB(b, h) ((4 + (b) * 2 + (h)) * HTB)
#define PG8_STAGE(bufoff, gbase, voff) do { _Pragma("unroll") for (int _i = 0; _i < 2; ++_i) \
        __builtin_amdgcn_global_load_lds((const unsigned*)((const char*)(gbase) + (voff)[_i]), (PG8_LAS unsigned*)(lds + (bufoff) + ldsw + _i * 8192), 16, 0, 0); } while (0)
#define PG8_LDA(dst, b, h) do { _Pragma("unroll") for (int m = 0; m < 4; ++m) _Pragma("unroll") for (int k = 0; k < 2; ++k) dst[m][k] = *(const PG8_LAS bf16x8*)(lds + PG8_SA(b, h) + aoff + m * 2048 + k * 1024); } while (0)
#define PG8_LDB(dst, b, h) do { _Pragma("unroll") for (int n = 0; n < 2; ++n) _Pragma("unroll") for (int k = 0; k < 2; ++k) dst[n][k] = *(const PG8_LAS bf16x8*)(lds + PG8_SB(b, h) + boff + n * 2048 + k * 1024); } while (0)
#define PG8_MMA(ai, bj, At, Bt) do { __builtin_amdgcn_s_setprio(1); _Pragma("unroll") for (int m = 0; m < 4; ++m) _Pragma("unroll") for (int n = 0; n < 2; ++n) _Pragma("unroll") for (int k = 0; k < 2; ++k) \
        acc[ai][bj][m][n] = __builtin_amdgcn_mfma_f32_16x16x32_bf16(Bt[n][k], At[m][k], acc[ai][bj][m][n], 0, 0, 0); __builtin_amdgcn_s_setprio(0); } while (0)
#define PG8_WAIT_V(n) asm volatile("s_waitcnt vmcnt(" #n ")" ::: "memory")
#define PG8_WAIT_L(n) asm volatile("s_waitcnt lgkmcnt(" #n ")" ::: "memory")
#define PG8_BAR __builtin_amdgcn_s_barrier()
#define PG8_SCHED __builtin_amdgcn_sched_barrier(0)
    Unit cur, nxt; int ui = 0;
    if (!S.next(0, cur)) return;
    f32x4 acc[2][2][4][2];
#pragma unroll
    for (int a = 0; a < 2; ++a)
#pragma unroll
        for (int b = 0; b < 2; ++b)
#pragma unroll
            for (int m = 0; m < 4; ++m)
#pragma unroll
                for (int n = 0; n < 2; ++n) acc[a][b][m][n] = (f32x4){0.f, 0.f, 0.f, 0.f};
    bf16x8 At[4][2], B0[2][2], B1[2][2];
    const char* cA = (const char*)g.A + (size_t)cur.pm * tstepA; const char* cB = (const char*)g.Bt + (size_t)cur.pn * tstepB;
    S.a_ready(cur);
    if constexpr (SP2) {
        PG8_STAGE(PG8_SB(0, 0), cB, voffB); PG8_STAGE(PG8_SB(0, 1), cB + hstepB, voffB); PG8_STAGE(PG8_SA(0, 0), cA, voffA); PG8_STAGE(PG8_SA(0, 1), cA + hstepA, voffA);
        if (wr == 1) PG8_BAR;
        PG8_WAIT_V(2); PG8_BAR;
        PG8_STAGE(PG8_SB(1, 0), cB + kstep, voffB); PG8_STAGE(PG8_SA(1, 0), cA + kstep, voffA); PG8_STAGE(PG8_SB(1, 1), cB + hstepB + kstep, voffB);
        PG8_WAIT_V(6); PG8_BAR;
    } else {
        PG8_STAGE(PG8_SB(0, 0), cB, voffB); PG8_STAGE(PG8_SA(0, 0), cA, voffA); PG8_STAGE(PG8_SB(0, 1), cB + hstepB, voffB); PG8_STAGE(PG8_SA(0, 1), cA + hstepA, voffA);
        if (wr == 1) PG8_BAR;
        PG8_WAIT_V(4); PG8_BAR;
        PG8_STAGE(PG8_SB(1, 0), cB + kstep, voffB); PG8_STAGE(PG8_SA(1, 0), cA + kstep, voffA); PG8_STAGE(PG8_SB(1, 1), cB + hstepB + kstep, voffB);
        PG8_WAIT_V(6); PG8_BAR;
    }
    for (;;) {
        const bool has_next = S.next(ui + 1, nxt);
        const char* nA = has_next ? (const char*)g.A + (size_t)nxt.pm * tstepA : cA; const char* nB = has_next ? (const char*)g.Bt + (size_t)nxt.pn * tstepB : cB;
        for (int t = 0; t < nt; t += 2) {
            const bool last = (t == nt - 2);
            const char* a1 = cA + (size_t)(t + 1) * kstep;
            const char* a2 = last ? nA : cA + (size_t)(t + 2) * kstep; const char* b2 = last ? nB : cB + (size_t)(t + 2) * kstep;
            const char* a3 = a2 + kstep; const char* b3 = b2 + kstep;
            if (last && has_next) S.a_ready(nxt);
            if constexpr (Epi::MIDK) { if (t == (nt >> 1)) E.mid(acc, cur, wr, fr); }
            if constexpr (SP2) {
            PG8_LDB(B0, 0, 0); PG8_LDB(B1, 0, 1); PG8_SCHED; PG8_LDA(At, 0, 0); PG8_STAGE(PG8_SA(1, 1), a1 + hstepA, voffA);
            PG8_WAIT_V(8); PG8_WAIT_L(0); PG8_BAR; PG8_MMA(0, 0, At, B0); PG8_MMA(0, 1, At, B1); PG8_BAR; PG8_SCHED;
            PG8_LDA(At, 0, 1); PG8_STAGE(PG8_SB(0, 0), b2, voffB); PG8_STAGE(PG8_SB(0, 1), b2 + hstepB, voffB); PG8_STAGE(PG8_SA(0, 0), a2, voffA);
            PG8_WAIT_V(8); PG8_WAIT_L(0); PG8_BAR; PG8_MMA(1, 0, At, B0); PG8_MMA(1, 1, At, B1); PG8_BAR; PG8_SCHED;
            PG8_LDB(B0, 1, 0); PG8_LDB(B1, 1, 1); PG8_SCHED; PG8_LDA(At, 1, 0); PG8_STAGE(PG8_SA(0, 1), a2 + hstepA, voffA);
            PG8_WAIT_V(8); PG8_WAIT_L(0); PG8_BAR; PG8_MMA(0, 0, At, B0); PG8_MMA(0, 1, At, B1); PG8_BAR; PG8_SCHED;
            PG8_LDA(At, 1, 1); PG8_STAGE(PG8_SB(1, 0), b3, voffB); PG8_STAGE(PG8_SB(1, 1), b3 + hstepB, voffB); PG8_STAGE(PG8_SA(1, 0), a3, voffA);
            PG8_WAIT_V(8); PG8_WAIT_L(0); PG8_BAR; PG8_MMA(1, 0, At, B0); PG8_MMA(1, 1, At, B1); PG8_BAR; PG8_SCHED;
            } else {
            PG8_LDB(B0, 0, 0); PG8_SCHED; PG8_LDA(At, 0, 0); PG8_STAGE(PG8_SA(1, 1), a1 + hstepA, voffA);
            PG8_WAIT_L(8); PG8_BAR; PG8_WAIT_L(0); PG8_MMA(0, 0, At, B0); PG8_BAR; PG8_SCHED;
            PG8_LDB(B1, 0, 1); PG8_STAGE(PG8_SB(0, 0), b2, voffB);
            PG8_BAR; PG8_WAIT_L(0); PG8_MMA(0, 1, At, B1); PG8_BAR;
            PG8_LDA(At, 0, 1); PG8_STAGE(PG8_SA(0, 0), a2, voffA);
            PG8_BAR; PG8_WAIT_L(0); PG8_MMA(1, 0, At, B0); PG8_BAR; PG8_SCHED;
            PG8_STAGE(PG8_SB(0, 1), b2 + hstepB, voffB);
            PG8_WAIT_V(6); PG8_BAR; PG8_MMA(1, 1, At, B1); PG8_BAR;
            PG8_LDB(B0, 1, 0); PG8_SCHED; PG8_LDA(At, 1, 0); PG8_STAGE(PG8_SA(0, 1), a2 + hstepA, voffA);
            PG8_WAIT_L(8); PG8_BAR; PG8_WAIT_L(0); PG8_MMA(0, 0, At, B0); PG8_BAR; PG8_SCHED;
            PG8_LDB(B1, 1, 1); PG8_STAGE(PG8_SB(1, 0), b3, voffB);
            PG8_BAR; PG8_WAIT_L(0); PG8_MMA(0, 1, At, B1); PG8_BAR;
            PG8_LDA(At, 1, 1); PG8_STAGE(PG8_SA(1, 0), a3, voffA);
            PG8_BAR; PG8_WAIT_L(0); PG8_MMA(1, 0, At, B0); PG8_BAR; PG8_SCHED;
            PG8_STAGE(PG8_SB(1, 1), b3 + hstepB, voffB);
            PG8_WAIT_V(6); PG8_BAR; PG8_MMA(1, 1, At, B1); PG8_BAR;
            }
        }
        if constexpr (ALIGN_EPI) { if (wr == 0) PG8_BAR; }
        if constexpr (!Epi::AFTER_DRAIN) { E(acc, cur, wr, wc, fr, fq); S.done(cur); }
        if (!has_next) break;
#pragma unroll
        for (int a = 0; a < 2; ++a)
#pragma unroll
            for (int b = 0; b < 2; ++b)
#pragma unroll
                for (int m = 0; m < 4; ++m)
#pragma unroll
                    for (int n = 0; n < 2; ++n) acc[a][b][m][n] = (f32x4){0.f, 0.f, 0.f, 0.f};
        cur = nxt; cA = nA; cB = nB; ++ui;
        if constexpr (ALIGN_EPI) { if (wr == 1) PG8_BAR; }
    }
    PG8_WAIT_V(0);
    if constexpr (!ALIGN_EPI) { if (wr == 0) PG8_BAR; }
    PG8_BAR;
    if constexpr (Epi::AFTER_DRAIN) { E.fused(acc, cur, wr, wc, fr, fq, lds, wid, lane); S.done(cur); }
#undef PG8_SA
#undef PG8_SB
#undef PG8_STAGE
#undef PG8_LDA
#undef PG8_LDB
#undef PG8_MMA
#undef PG8_WAIT_V
#undef PG8_WAIT_L
#undef PG8_BAR
#undef PG8_SCHED
}
__device__ __forceinline__ unsigned cvt_pk_bf16(float lo, float hi) { unsigned r; asm volatile("v_cvt_pk_bf16_f32 %0, %1, %2" : "=v"(r) : "v"(lo), "v"(hi)); return r; }
__device__ __forceinline__ u32x4 pack8(const f32x4 a, const f32x4 b) { u32x4 w; w.x = cvt_pk_bf16(a[0], a[1]); w.y = cvt_pk_bf16(a[2], a[3]); w.z = cvt_pk_bf16(b[0], b[1]); w.w = cvt_pk_bf16(b[2], b[3]); return w; }

struct CarryOrder {
    int G, c;
    __device__ bool next(int i, Unit& u) const { const int L = i * G + c; if (L >= NG) return false; u.pm = L; u.pn = L; return true; }
    __device__ __forceinline__ void a_ready(const Unit&) const {}
    __device__ __forceinline__ void done(const Unit&) const {}
};
struct ChunkOrder {
    int G, c;
    __device__ bool next(int i, Unit& u) const { const int L = i * G + c; if (L >= 2 * NG) return false; u.pm = L >> 1; u.pn = L; return true; }
    __device__ __forceinline__ void a_ready(const Unit&) const {}
    __device__ __forceinline__ void done(const Unit&) const {}
};

struct EpiQKVU {
    static constexpr bool PERM = true, AFTER_DRAIN = false, MIDK = false;
    bf16_t* QKV; bf16_t* AALL;
    __device__ __forceinline__ void mid(f32x4 (&)[2][2][4][2], const Unit&, int, int) const {}
    __device__ __forceinline__ void operator()(const f32x4 (&acc)[2][2][4][2], const Unit& u, int wr, int wc, int fr, int fq) const {
        const int row0 = u.pm * BM + wr * 64 + fr;
#pragma unroll
        for (int bj = 0; bj < 2; ++bj) {
            const int ct = u.pn * BM + bj * HALF, cw = wc * 32 + 8 * fq;
            if (ct < 3072) {
                const int which = ct >> 10, head = (ct & 1023) >> 7;
                bf16_t* base = QKV + (size_t)(which * NH + head) * SEQ * HD + cw;
#pragma unroll
                for (int ai = 0; ai < 2; ++ai)
#pragma unroll
                    for (int m = 0; m < 4; ++m) { const int row = row0 + ai * HALF + m * 16; *(u32x4*)(base + (size_t)row * HD) = pack8(acc[ai][bj][m][0], acc[ai][bj][m][1]); }
            } else {
                const int cu = ct - 3072 + cw, g = cu >> 4, i0 = cu & 15;
#pragma unroll
                for (int ai = 0; ai < 2; ++ai)
#pragma unroll
                    for (int m = 0; m < 4; ++m) { const int row = row0 + ai * HALF + m * 16;
                        *(u32x4*)(AALL + ((size_t)(g * NCH + (row >> 5)) * KA + (row & 31) * GCH + i0)) = pack8(acc[ai][bj][m][0], acc[ai][bj][m][1]); }
            }
        }
    }
};

struct EpiCarry {
    static constexpr bool PERM = false, AFTER_DRAIN = true, MIDK = false;
    bf16_t* AALL; const float* P32;
    __device__ __forceinline__ void mid(f32x4 (&)[2][2][4][2], const Unit&, int, int) const {}
    __device__ __forceinline__ void operator()(const f32x4 (&)[2][2][4][2], const Unit&, int, int, int, int) const {}
    __device__ __forceinline__ void fused(f32x4 (&acc)[2][2][4][2], const Unit& u, int wr, int wc, int fr, int fq, PG8_LAS unsigned char* lds, int wid, int lane) const {
        PG8_LAS float* sS = (PG8_LAS float*)lds;
#pragma unroll
        for (int ai = 0; ai < 2; ++ai)
#pragma unroll
            for (int m = 0; m < 4; ++m) { const int r = ai * HALF + wr * 64 + m * 16 + fr;
#pragma unroll
                for (int n = 0; n < 2; ++n) *(PG8_LAS f32x4*)(sS + r * 128 + wc * 32 + 16 * n + 4 * fq) = acc[ai][0][m][n]; }
        asm volatile("s_waitcnt lgkmcnt(0)" ::: "memory"); __builtin_amdgcn_s_barrier(); asm volatile("" ::: "memory");
        if (wid == 0) {
            const int g = u.pm, p = lane;
            const float pr = P32[(g * NP + p) * 2], pi = P32[(g * NP + p) * 2 + 1];
            float xr = 0.f, xi = 0.f;
            bf16_t* dst = AALL + (size_t)g * NCH * KA + CL * GCH + p;
            for (int c = 0; c < NCH; ++c) {
                const unsigned w = cvt_pk_bf16(xr, xi);
                dst[(size_t)c * KA] = (bf16_t)(w & 0xffffu); dst[(size_t)c * KA + NP] = (bf16_t)(w >> 16);
                const float sr = sS[c * 128 + p], si = sS[c * 128 + NP + p];
                const float nr = pr * xr - pi * xi + sr, ni = pr * xi + pi * xr + si;
                xr = nr; xi = ni;
            }
        }
    }
};

struct EpiY {
    static constexpr bool PERM = true, AFTER_DRAIN = false, MIDK = false;
    bf16_t* YB;
    __device__ __forceinline__ void mid(f32x4 (&)[2][2][4][2], const Unit&, int, int) const {}
    __device__ __forceinline__ void operator()(const f32x4 (&acc)[2][2][4][2], const Unit& u, int wr, int wc, int fr, int fq) const {
        const int g = u.pm, j = u.pn & 1;
#pragma unroll
        for (int bj = 0; bj < 2; ++bj) { const int n0 = j * BM + bj * HALF + wc * 32 + 8 * fq, tl = n0 >> 4, h0 = n0 & 15;
#pragma unroll
            for (int ai = 0; ai < 2; ++ai)
#pragma unroll
                for (int m = 0; m < 4; ++m) { const int c = ai * HALF + wr * 64 + m * 16 + fr; const int t = CL * c + tl;
                    f32x4 a = acc[ai][bj][m][0], b = acc[ai][bj][m][1];
#pragma unroll
                    for (int e = 0; e < 4; ++e) { a[e] = gelu_tanh(a[e]); b[e] = gelu_tanh(b[e]); }
                    *(u32x4*)(YB + (size_t)t * SW + GCH * g + h0) = pack8(a, b); } }
    }
};

struct EpiGlu {
    static constexpr bool PERM = true, AFTER_DRAIN = false, MIDK = false;
    const bf16_t* YB; bf16_t* MIX; const float* bglu; float* SSQ;
    __device__ __forceinline__ void mid(f32x4 (&)[2][2][4][2], const Unit&, int, int) const {}
    __device__ __forceinline__ void operator()(const f32x4 (&acc)[2][2][4][2], const Unit& u, int wr, int wc, int fr, int fq) const {
        const int row0 = u.pm * BM + wr * 64 + fr;
        float ss[2][4];
#pragma unroll
        for (int ai = 0; ai < 2; ++ai)
#pragma unroll
            for (int m = 0; m < 4; ++m) ss[ai][m] = 0.f;
#pragma unroll
        for (int bj = 0; bj < 2; ++bj) { const int col0 = u.pn * BM + bj * HALF + wc * 32 + 8 * fq;
            const f32x4 b0 = *(const f32x4*)(bglu + col0), b1 = *(const f32x4*)(bglu + col0 + 4);
#pragma unroll
            for (int ai = 0; ai < 2; ++ai)
#pragma unroll
                for (int m = 0; m < 4; ++m) { const int row = row0 + ai * HALF + m * 16;
                    const u32x4 yw = *(const u32x4*)(YB + (size_t)row * SW + col0);
                    f32x4 ya = {bf_lo(yw.x), bf_hi(yw.x), bf_lo(yw.y), bf_hi(yw.y)}, yb = {bf_lo(yw.z), bf_hi(yw.z), bf_lo(yw.w), bf_hi(yw.w)};
                    const f32x4 za = acc[ai][bj][m][0] + b0, zb = acc[ai][bj][m][1] + b1;
                    float s = 0.f;
#pragma unroll
                    for (int e = 0; e < 4; ++e) { ya[e] *= fast_sigmoid(za[e]); yb[e] *= fast_sigmoid(zb[e]); s += ya[e] * ya[e] + yb[e] * yb[e]; }
                    ss[ai][m] += s;
                    *(u32x4*)(MIX + (size_t)row * DM + SW + col0) = pack8(ya, yb); } }
#pragma unroll
        for (int ai = 0; ai < 2; ++ai)
#pragma unroll
            for (int m = 0; m < 4; ++m) { float s = ss[ai][m]; s += __shfl_xor(s, 16); s += __shfl_xor(s, 32);
                if (fq == 0) SSQ[(size_t)(row0 + ai * HALF + m * 16) * 32 + 8 + u.pn * 4 + wc] = s; }
    }
};

struct EpiWout {
    static constexpr bool PERM = false, AFTER_DRAIN = false, MIDK = true;
    const PG8_LAS float* rtab;
    const float* X; const float* gt1; float* OUT;
    static __device__ __forceinline__ void rstds(const float* SSQ, int row, float& ra, float& rs) {
        const f32x4* p = (const f32x4*)(SSQ + (size_t)row * 32);
        const f32x4 a0 = p[0], a1 = p[1], s0 = p[2], s1 = p[3], s2 = p[4], s3 = p[5];
        const float sa = (a0[0] + a0[1]) + (a0[2] + a0[3]) + (a1[0] + a1[1]) + (a1[2] + a1[3]);
        const f32x4 st = (s0 + s1) + (s2 + s3); const float ssum = (st[0] + st[1]) + (st[2] + st[3]);
        ra = 1.0f / sqrtf(sa * (1.0f / AW) + EPS); rs = 1.0f / sqrtf(ssum * (1.0f / SW) + EPS);
    }
    __device__ __forceinline__ void mid(f32x4 (&acc)[2][2][4][2], const Unit& u, int wr, int fr) const {
#pragma unroll
        for (int ai = 0; ai < 2; ++ai)
#pragma unroll
            for (int m = 0; m < 4; ++m) { const float f = rtab[2 * (ai * HALF + wr * 64 + m * 16 + fr)];
#pragma unroll
                for (int bj = 0; bj < 2; ++bj)
#pragma unroll
                    for (int n = 0; n < 2; ++n) acc[ai][bj][m][n] *= f; }
    }
    __device__ __forceinline__ void operator()(const f32x4 (&acc)[2][2][4][2], const Unit& u, int wr, int wc, int fr, int fq) const {
        const int col0 = u.pn * BM + wc * 32 + 4 * fq;
        f32x4 gv[2][2];
#pragma unroll
        for (int bj = 0; bj < 2; ++bj)
#pragma unroll
            for (int n = 0; n < 2; ++n) gv[bj][n] = *(const f32x4*)(gt1 + col0 + bj * HALF + n * 16);
#pragma unroll
        for (int ai = 0; ai < 2; ++ai)
#pragma unroll
            for (int m = 0; m < 4; ++m) { const int rl = ai * HALF + wr * 64 + m * 16 + fr, row = u.pm * BM + rl; const float rs = rtab[2 * rl + 1];
                const size_t off = (size_t)row * DM + col0;
#pragma unroll
                for (int bj = 0; bj < 2; ++bj)
#pragma unroll
                    for (int n = 0; n < 2; ++n) { const f32x4 xv = *(const f32x4*)(X + off + bj * HALF + n * 16);
                        *(f32x4*)(OUT + off + bj * HALF + n * 16) = xv + gv[bj][n] * (acc[ai][bj][m][n] * rs); } }
    }
};

struct EpiUp {
    static constexpr bool PERM = true, AFTER_DRAIN = false, MIDK = false;
    bf16_t* ABUF; bf16_t* BBUF;
    __device__ __forceinline__ void mid(f32x4 (&)[2][2][4][2], const Unit&, int, int) const {}
    __device__ __forceinline__ void operator()(const f32x4 (&acc)[2][2][4][2], const Unit& u, int wr, int wc, int fr, int fq) const {
        const int row0 = u.pm * BM + wr * 64 + fr, col0 = u.pn * HALF + wc * 32 + 8 * fq;
#pragma unroll
        for (int bj = 0; bj < 2; ++bj) { bf16_t* base = (bj == 0 ? ABUF : BBUF) + col0;
#pragma unroll
            for (int ai = 0; ai < 2; ++ai)
#pragma unroll
                for (int m = 0; m < 4; ++m) { const int row = row0 + ai * HALF + m * 16; *(u32x4*)(base + (size_t)row * DFF) = pack8(acc[ai][bj][m][0], acc[ai][bj][m][1]); } }
    }
};

struct EpiDown {
    static constexpr bool PERM = false, AFTER_DRAIN = false, MIDK = false;
    const float* gt2; float* OUT; float* SSQ2;
    __device__ __forceinline__ void mid(f32x4 (&)[2][2][4][2], const Unit&, int, int) const {}
    __device__ __forceinline__ void operator()(const f32x4 (&acc)[2][2][4][2], const Unit& u, int wr, int wc, int fr, int fq) const {
        const int col0 = u.pn * BM + wc * 32 + 4 * fq;
        f32x4 gv[2][2];
#pragma unroll
        for (int bj = 0; bj < 2; ++bj)
#pragma unroll
            for (int n = 0; n < 2; ++n) gv[bj][n] = *(const f32x4*)(gt2 + col0 + bj * HALF + n * 16);
#pragma unroll
        for (int ai = 0; ai < 2; ++ai)
#pragma unroll
            for (int m = 0; m < 4; ++m) { const int row = u.pm * BM + ai * HALF + wr * 64 + m * 16 + fr; const size_t off = (size_t)row * DM + col0; float s = 0.f;
#pragma unroll
                for (int bj = 0; bj < 2; ++bj)
#pragma unroll
                    for (int n = 0; n < 2; ++n) { const f32x4 hv = *(const f32x4*)(OUT + off + bj * HALF + n * 16);
                        const f32x4 o = hv + gv[bj][n] * acc[ai][bj][m][n]; s += (o[0] * o[0] + o[1] * o[1]) + (o[2] * o[2] + o[3] * o[3]);
                        *(f32x4*)(OUT + off + bj * HALF + n * 16) = o; }
                s += __shfl_xor(s, 16); s += __shfl_xor(s, 32);
                if (fq == 0) SSQ2[(size_t)row * 32 + u.pn * 4 + wc] = s; }
    }
};
}
#include <hip/hip_bf16.h>
namespace att {
#define BIAS_LAS __attribute__((address_space(3)))
using bf16 = __hip_bfloat16;
typedef short bf16x8 __attribute__((ext_vector_type(8)));
typedef short s16x4 __attribute__((ext_vector_type(4)));
typedef float f32x16 __attribute__((ext_vector_type(16)));
typedef float f32x4 __attribute__((ext_vector_type(4)));
typedef unsigned u32x4 __attribute__((ext_vector_type(4)));
template <class A, class Bt> struct same_t { static constexpr bool v = false; };
template <class A> struct same_t<A, A> { static constexpr bool v = true; };
constexpr int D = 128, LDO = 2048;
constexpr float SCALE = 0.08838834764831845f;
constexpr float THR = 8.f;
constexpr bool WSKIP = false;
constexpr int NW = 8, QBLK = 32, KVBLK = 64, QB = NW * QBLK;
constexpr int SHM_V = KVBLK * D * 2, SHM_K = KVBLK * D * 2;
constexpr int ATT_LDS = 2 * SHM_V + 2 * SHM_K + NW * 64 * 4;
constexpr int BIAS_OFF = 69632;
#define KSWZ(row, colB) ((row) * 256 + ((colB) ^ (((row) & 7) << 4)))
#define SBAR() __builtin_amdgcn_sched_barrier(0)
__device__ __forceinline__ int v_st(int k, int c) { const int kk = (k & ~0xC) | ((k & 4) << 1) | ((k & 8) >> 1); return ((kk >> 3) * 4 + (c >> 5)) * 512 + ((kk & 7) * 32 + (c & 31)) * 2; }
__device__ __forceinline__ int v_rd_base(int lane) { return ((lane & 3) << 3) | (((lane >> 2) & 3) << 6) | (((lane >> 4) & 1) << 5) | (((lane >> 5) & 1) << 8); }
constexpr int v_rd_off(int d0, int ks, int half) { return d0 * 512 + ks * 4096 + half * 2048; }
__device__ __forceinline__ int crow(int r, int hi) { return (r & 3) + 8 * (r >> 2) + 4 * hi; }
__device__ __forceinline__ unsigned cvtpk(float lo, float hi) {
    unsigned r; asm volatile("v_cvt_pk_bf16_f32 %0, %1, %2" : "=v"(r) : "v"(lo), "v"(hi)); return r;
}
__device__ __forceinline__ bf16x8 pack8(f32x4 a, f32x4 b) {
    u32x4 w = {cvtpk(a[0], a[1]), cvtpk(a[2], a[3]), cvtpk(b[0], b[1]), cvtpk(b[2], b[3])};
    return *reinterpret_cast<bf16x8*>(&w);
}
template <class T> __device__ __forceinline__ bf16x8 load8(const T* p) {
    if constexpr (same_t<T, float>::v) { return pack8(*(const f32x4*)p, *(const f32x4*)(p + 4)); }
    else { return *reinterpret_cast<const bf16x8*>(p); }
}
__device__ __forceinline__ void mask_tile(f32x16& p0, f32x16& p1, int dq, unsigned W) {
    const float NEG = -__builtin_inff();
#pragma unroll
    for (int r = 0; r < 16; ++r) {
        const int c = (r & 3) + 8 * (r >> 2);
        if ((unsigned)(dq - c) >= W) p0[r] = NEG;
        if ((unsigned)(dq - c - 32) >= W) p1[r] = NEG;
    }
}
__device__ __forceinline__ void partialSM(f32x16& p0, f32x16& p1, float& m_reg, float& mn, float& alpha) {
    float pmax = p0[0]; for (int r = 1; r < 16; ++r) pmax = fmaxf(pmax, p0[r]); for (int r = 0; r < 16; ++r) pmax = fmaxf(pmax, p1[r]);
    { auto rr = __builtin_amdgcn_permlane32_swap(__float_as_uint(pmax), __float_as_uint(pmax), false, false);
      pmax = fmaxf(__uint_as_float(rr[0]), __uint_as_float(rr[1])); }
    constexpr float C2 = 1.4426950408889634f * SCALE;
    if (__builtin_expect(__all((pmax - m_reg) * SCALE <= THR), 1)) { mn = m_reg; alpha = 1.f; }
    else { mn = fmaxf(m_reg, pmax); alpha = __builtin_amdgcn_exp2f((m_reg - mn) * C2); m_reg = mn; }
    const float mnL = -mn * C2;
    for (int r = 0; r < 16; ++r) p0[r] = fmaf(p0[r], C2, mnL); for (int r = 0; r < 16; ++r) p1[r] = fmaf(p1[r], C2, mnL);
    for (int r = 0; r < 16; ++r) p0[r] = __builtin_amdgcn_exp2f(p0[r]);
}
__device__ __forceinline__ void finishSM(f32x16& p0, f32x16& p1, float alpha, float& l_reg, bf16x8& pa0, bf16x8& pa1, bf16x8& pa2, bf16x8& pa3) {
    for (int r = 0; r < 16; ++r) p1[r] = __builtin_amdgcn_exp2f(p1[r]);
    float ps = 0; for (int r = 0; r < 16; ++r) ps += p0[r]; for (int r = 0; r < 16; ++r) ps += p1[r];
    { auto rr = __builtin_amdgcn_permlane32_swap(__float_as_uint(ps), __float_as_uint(ps), false, false);
      ps = __uint_as_float(rr[0]) + __uint_as_float(rr[1]); }
    l_reg = l_reg * alpha + ps;
#define PK4(P, B_, OUT) do { unsigned a0 = cvtpk(P[B_+0], P[B_+1]), a1 = cvtpk(P[B_+2], P[B_+3]);                          \
        unsigned b0 = cvtpk(P[B_+4], P[B_+5]), b1 = cvtpk(P[B_+6], P[B_+7]);                                             \
        auto r0 = __builtin_amdgcn_permlane32_swap(a0, b0, false, false); auto r1 = __builtin_amdgcn_permlane32_swap(a1, b1, false, false); \
        u32x4 w = {r0[0], r1[0], r0[1], r1[1]}; OUT = *reinterpret_cast<bf16x8*>(&w); } while (0)
    PK4(p0, 0, pa0); PK4(p0, 8, pa1); PK4(p1, 0, pa2); PK4(p1, 8, pa3);
#undef PK4
}
template <int KB, bool SK>
__device__ __forceinline__ void qkt(f32x16& p0, f32x16& p1, const char* K_lds, int r32, int hi, const bf16x8* qr, bool act, const BIAS_LAS float* bp) {
    if (SK && !act) { const float NEG = -__builtin_inff();
#pragma unroll
        for (int r = 0; r < 16; ++r) { p0[r] = NEG; p1[r] = NEG; } return; }
#ifdef NOBIAS
    p0 = f32x16{}; p1 = f32x16{};
#else
    { const BIAS_LAS f32x4* b4 = (const BIAS_LAS f32x4*)bp;
      const f32x4 t0 = b4[0], t1 = b4[2], t2 = b4[4], t3 = b4[6], t4 = b4[8], t5 = b4[10], t6 = b4[12], t7 = b4[14];
      p0 = f32x16{t0[0], t0[1], t0[2], t0[3], t1[0], t1[1], t1[2], t1[3], t2[0], t2[1], t2[2], t2[3], t3[0], t3[1], t3[2], t3[3]};
      p1 = f32x16{t4[0], t4[1], t4[2], t4[3], t5[0], t5[1], t5[2], t5[3], t6[0], t6[1], t6[2], t6[3], t7[0], t7[1], t7[2], t7[3]}; }
#endif
    const char* kb[4];
#pragma unroll
    for (int dd = 0; dd < 4; ++dd) kb[dd] = K_lds + KB * SHM_K + KSWZ(r32, (dd * 16 + hi * 8) * 2);
#pragma unroll
    for (int d0 = 0; d0 < 8; ++d0) { const char* a = kb[d0 & 3] + (d0 >> 2) * 128;
        bf16x8 b0 = *reinterpret_cast<const bf16x8*>(a);
        bf16x8 b1 = *reinterpret_cast<const bf16x8*>(a + 32 * 256);
        p0 = __builtin_amdgcn_mfma_f32_32x32x16_bf16(b0, qr[d0], p0, 0, 0, 0);
        p1 = __builtin_amdgcn_mfma_f32_32x32x16_bf16(b1, qr[d0], p1, 0, 0, 0); }
}
template <int VB, bool SK>
__device__ __forceinline__ void pv_tile(f32x16* o, int vb0, bf16x8 pa0, bf16x8 pa1, bf16x8 pa2, bf16x8 pa3, bool act) {
    if (SK && !act) return;
#define TRRD(dst, off) asm volatile("ds_read_b64_tr_b16 %0, %1 offset:%2" : "=&v"(dst) : "v"(vb0), "i"(off) : "memory")
#define PV_D0(d0) do { s16x4 l0, l1, l2, l3, h0, h1, h2, h3; constexpr int b_ = VB * SHM_V + v_rd_off(d0, 0, 0);     \
        TRRD(l0, b_); TRRD(h0, b_ + 2048); TRRD(l1, b_ + 4096); TRRD(h1, b_ + 6144); TRRD(l2, b_ + 8192); TRRD(h2, b_ + 10240); TRRD(l3, b_ + 12288); TRRD(h3, b_ + 14336); \
        asm volatile("s_waitcnt lgkmcnt(0)" ::: "memory"); SBAR();                 \
        o[d0] = __builtin_amdgcn_mfma_f32_32x32x16_bf16(pa0, (bf16x8){l0[0], l0[1], l0[2], l0[3], h0[0], h0[1], h0[2], h0[3]}, o[d0], 0, 0, 0);   \
        o[d0] = __builtin_amdgcn_mfma_f32_32x32x16_bf16(pa1, (bf16x8){l1[0], l1[1], l1[2], l1[3], h1[0], h1[1], h1[2], h1[3]}, o[d0], 0, 0, 0);   \
        o[d0] = __builtin_amdgcn_mfma_f32_32x32x16_bf16(pa2, (bf16x8){l2[0], l2[1], l2[2], l2[3], h2[0], h2[1], h2[2], h2[3]}, o[d0], 0, 0, 0);   \
        o[d0] = __builtin_amdgcn_mfma_f32_32x32x16_bf16(pa3, (bf16x8){l3[0], l3[1], l3[2], l3[3], h3[0], h3[1], h3[2], h3[3]}, o[d0], 0, 0, 0); } while (0)
    PV_D0(0); PV_D0(1); PV_D0(2); PV_D0(3);
#undef PV_D0
#undef TRRD
}
template <class TIn, class TOut> struct BlockRef { const TIn* Q; const TIn* K; const TIn* V; TOut* O; int P0; int JLO; float* SSQ; };
template <class TIn> struct Seam {
    bf16x8 qr[8];
    bf16x8 st_v0, st_v1, st_k0, st_k1; f32x4 sf0, sf1, sf2, sf3;
    f32x4 tq[16];
};
#define ROW(p, k0, rr) ((p) + (size_t)((k0) + (rr)) * D + sc)
#define VMW() asm volatile("s_waitcnt vmcnt(0)" ::: "memory")
#define VMWN(n) asm volatile("s_waitcnt vmcnt(%0)" :: "i"(n) : "memory")
#define SLOAD_H(Kp, Vp, k0) do { S.st_v0 = load8<TIn>(ROW(Vp, k0, sr)); S.st_v1 = load8<TIn>(ROW(Vp, k0, 32 + sr));              \
                         S.st_k0 = load8<TIn>(ROW(Kp, k0, sr)); S.st_k1 = load8<TIn>(ROW(Kp, k0, 32 + sr)); } while (0)
#define SWRITE_HK(bf) do { *(bf16x8*)(K_lds + (bf) * SHM_K + kws) = S.st_k0; *(bf16x8*)(K_lds + (bf) * SHM_K + kws + 32 * 256) = S.st_k1; } while (0)
#define SWRITE_HV(bf) do { *(bf16x8*)(V_lds + (bf) * SHM_V + vst0) = S.st_v0; *(bf16x8*)(V_lds + (bf) * SHM_V + vst1) = S.st_v1; } while (0)
#define SWRITE_H(bf) do { SWRITE_HV(bf); SWRITE_HK(bf); } while (0)
#define SLOAD_F(p, k0) do { S.sf0 = *(const f32x4*)ROW(p, k0, sr); S.sf1 = *(const f32x4*)(ROW(p, k0, sr) + 4);                \
                            S.sf2 = *(const f32x4*)ROW(p, k0, 32 + sr); S.sf3 = *(const f32x4*)(ROW(p, k0, 32 + sr) + 4); } while (0)
#define SWRITE_KF(bf) do { *(bf16x8*)(K_lds + (bf) * SHM_K + kws) = pack8(S.sf0, S.sf1); *(bf16x8*)(K_lds + (bf) * SHM_K + kws + 32 * 256) = pack8(S.sf2, S.sf3); } while (0)
#define SWRITE_VF(bf) do { *(bf16x8*)(V_lds + (bf) * SHM_V + vst0) = pack8(S.sf0, S.sf1); *(bf16x8*)(V_lds + (bf) * SHM_V + vst1) = pack8(S.sf2, S.sf3); } while (0)
template <class TIn, class TOut>
__device__ __forceinline__ void causal_swa_prime(const BlockRef<TIn, TOut>& cur, int W, char* lds, Seam<TIn>& S) {
    constexpr bool F32 = same_t<TIn, float>::v;
    int tid_ = threadIdx.x; asm volatile("" : "+v"(tid_));
    const int tid = tid_, wid = __builtin_amdgcn_readfirstlane(tid >> 6), lane = tid & 63, r32 = lane & 31, hi = lane >> 5;
    const int sr = tid >> 4, sc = (tid & 15) * 8, kws = KSWZ(sr, sc * 2); char* K_lds = lds + 2 * SHM_V;
    const int kb0 = cur.JLO * KVBLK;
    for (int d0 = 0; d0 < 8; ++d0) S.qr[d0] = load8<TIn>(cur.Q + (size_t)(wid * QBLK + r32) * D + d0 * 16 + hi * 8);
    if constexpr (F32) { SLOAD_F((const float*)cur.K, kb0); VMW(); SWRITE_KF(0); SBAR(); SLOAD_F((const float*)cur.V, kb0); }
    else { SLOAD_H(cur.K, cur.V, kb0); VMW(); SWRITE_HK(0); }
    __syncthreads();
}
template <class TIn, class TOut>
__device__ __forceinline__ void causal_swa_block(const BlockRef<TIn, TOut>& cur, const BlockRef<TIn, TOut>& nxt, int skv, int W, char* lds, Seam<TIn>& S, const BIAS_LAS float* bias, int bias_k0) {
    constexpr bool F32 = same_t<TIn, float>::v;
    int tid_ = threadIdx.x; asm volatile("" : "+v"(tid_));
    const int tid = tid_, wid = __builtin_amdgcn_readfirstlane(tid >> 6), lane = tid & 63, r32 = lane & 31, hi = lane >> 5;
    const int j_lo = cur.JLO;
    int j_hi = (cur.P0 + QB - 1) / KVBLK + 1; if (j_hi > skv / KVBLK) j_hi = skv / KVBLK;
    const int NT = j_hi - j_lo;
    const int kbn = nxt.JLO * KVBLK;
    const int qlo = cur.P0 + wid * QBLK, qm = qlo + r32 - 4 * hi;
    char* V_lds = lds; char* K_lds = lds + 2 * SHM_V;
    float* ws = (float*)(lds + 2 * SHM_V + 2 * SHM_K) + wid * 64; float* li_l = ws, * al_l = ws + 32;
    float m_reg = -1e30f, l_reg = 0; f32x16 o[4] = {};
    const int sr = tid >> 4, sc = (tid & 15) * 8, vst0 = v_st(sr, sc), vst1 = v_st(32 + sr, sc), kws = KSWZ(sr, sc * 2);
    const int vb0 = (int)(uintptr_t)V_lds + v_rd_base(lane);
    const TIn* Kh = cur.K; const TIn* Vh = cur.V;
#define RESC(a) do { if (__any((a) < 1.f)) { if (hi == 0) al_l[r32] = (a); asm volatile("s_waitcnt lgkmcnt(0)" ::: "memory");              \
                     for (int d_ = 0; d_ < 4; ++d_) for (int r = 0; r < 16; ++r) o[d_][r] *= al_l[crow(r, hi)]; } } while (0)
#define KBASE(t) ((j_lo + (t)) * KVBLK)
#define BP(t) (bias + (KBASE(t) - bias_k0) + 4 * hi)
#define ACT(t) (KBASE(t) <= qlo + QBLK - 1 && KBASE(t) + KVBLK - 1 >= qlo - W + 1)
#define MASKT(P0_, P1_, t) do { const int kb_ = KBASE(t); if ((!SK || ACT(t)) && (kb_ + KVBLK - 1 > qlo || kb_ <= qlo + QBLK - 1 - W)) mask_tile(P0_, P1_, qm - kb_, (unsigned)W); } while (0)
    constexpr int NQL = F32 ? 16 : 8;
    constexpr bool SK = WSKIP && !F32;
#define SEAM_K0() do { VMWN(NQL); if constexpr (F32) { SWRITE_KF(0); SBAR(); SLOAD_F((const float*)nxt.V, kbn); } else { SWRITE_HK(0); } SBAR(); } while (0)
    f32x16 pA0, pA1, pB0, pB1; float mnA, mnB, alA, alB; bf16x8 pa0, pa1, pa2, pa3;
    if constexpr (F32) { VMW(); SWRITE_VF(0); SBAR(); } else { SWRITE_HV(0); SBAR(); }
    if (NT > 1) { if constexpr (F32) SLOAD_F((const float*)Kh, KBASE(1)); else SLOAD_H(Kh, Vh, KBASE(1)); }
    SBAR(); qkt<0, SK>(pA0, pA1, K_lds, r32, hi, S.qr, ACT(0), BP(0));
    if constexpr (F32) { if (NT > 1) { VMW(); SWRITE_KF(1); SBAR(); SLOAD_F((const float*)Vh, KBASE(1)); } }
    MASKT(pA0, pA1, 0); partialSM(pA0, pA1, m_reg, mnA, alA);
    if (NT > 1) { VMW(); if constexpr (F32) { SWRITE_VF(1); SBAR(); if (NT > 2) SLOAD_F((const float*)Kh, KBASE(2)); } else SWRITE_H(1); }
    __syncthreads();
#define HALF_STEP(PX0, PX1, mnX, alX, PY0, PY1, alY, t, KB, VB, SB) do {                                                      \
        SBAR(); qkt<KB, SK>(PX0, PX1, K_lds, r32, hi, S.qr, ACT(t), BP(t));                                             \
        finishSM(PY0, PY1, alY, l_reg, pa0, pa1, pa2, pa3); SBAR();                                                           \
        if ((t) + 1 < NT) { if constexpr (F32) { VMW(); SWRITE_KF(SB); SBAR(); SLOAD_F((const float*)Vh, KBASE((t) + 1)); }  \
                            else { SLOAD_H(Kh, Vh, KBASE((t) + 1)); } SBAR(); }                                               \
        pv_tile<VB, SK>(o, vb0, pa0, pa1, pa2, pa3, ACT((t) - 1)); MASKT(PX0, PX1, (t)); partialSM(PX0, PX1, m_reg, mnX, alX);                                        \
        __syncthreads();                                                                                                      \
        if ((t) + 1 < NT) { VMW(); if constexpr (F32) { SWRITE_VF(SB); SBAR(); if ((t) + 2 < NT) SLOAD_F((const float*)Kh, KBASE((t) + 2)); } \
                            else { SWRITE_H(SB); } }                                                                          \
        RESC(alX); __syncthreads(); } while (0)
    for (int t = 1; t + 1 < NT; t += 2) {
        HALF_STEP(pB0, pB1, mnB, alB, pA0, pA1, alA, t, 1, 0, 0);
        HALF_STEP(pA0, pA1, mnA, alA, pB0, pB1, alB, t + 1, 0, 1, 1);
    }
    const bool even = (NT & 1) == 0;
    if (even) { SBAR(); qkt<1, SK>(pB0, pB1, K_lds, r32, hi, S.qr, ACT(NT - 1), BP(NT - 1)); SBAR(); }
#define QROW(e) (nxt.Q + (size_t)(wid * QBLK + r32) * D + ((e) >> 1) * 16 + hi * 8 + ((e) & 1) * 4)
    if constexpr (F32) { SLOAD_F((const float*)nxt.K, kbn); SBAR();
#pragma unroll
        for (int e = 0; e < 8; ++e) S.tq[e] = *(const f32x4*)QROW(e); }
    else { SLOAD_H(nxt.K, nxt.V, kbn); SBAR();
#pragma unroll
        for (int d0 = 0; d0 < 8; ++d0) S.qr[d0] = load8<TIn>(nxt.Q + (size_t)(wid * QBLK + r32) * D + d0 * 16 + hi * 8); }
    SBAR();
    finishSM(pA0, pA1, alA, l_reg, pa0, pa1, pa2, pa3); SBAR();
    if constexpr (F32) {
#pragma unroll
        for (int e = 8; e < 16; ++e) S.tq[e] = *(const f32x4*)QROW(e); SBAR(); }
#undef QROW
    pv_tile<0, SK>(o, vb0, pa0, pa1, pa2, pa3, ACT(even ? NT - 2 : NT - 1));
    if (even) { MASKT(pB0, pB1, NT - 1); partialSM(pB0, pB1, m_reg, mnB, alB); __syncthreads(); RESC(alB);
        finishSM(pB0, pB1, alB, l_reg, pa0, pa1, pa2, pa3); SBAR(); pv_tile<1, SK>(o, vb0, pa0, pa1, pa2, pa3, ACT(NT - 1)); }
    SBAR(); SEAM_K0();
    if (hi == 0) li_l[r32] = l_reg; asm volatile("s_waitcnt lgkmcnt(0)" ::: "memory");
    float rli[16];
#pragma unroll
    for (int r = 0; r < 16; ++r) rli[r] = __builtin_amdgcn_rcpf(li_l[crow(r, hi)]);
    TOut* Ow = cur.O + (size_t)(wid * QBLK) * LDO;
#pragma unroll
    for (int r = 0; r < 16; ++r) { int orow = crow(r, hi); asm volatile("" : "+v"(orow)); float sq = 0.f;
#pragma unroll
        for (int d0 = 0; d0 < 4; ++d0) { const float v = o[d0][r] * rli[r]; sq += v * v;
            { const float vn = __shfl_xor(v, 1);
                   if ((r32 & 1) == 0) *(unsigned*)(Ow + (size_t)orow * LDO + d0 * 32 + r32) = cvtpk(v, vn); } }
        sq += __shfl_xor(sq, 1); sq += __shfl_xor(sq, 2); sq += __shfl_xor(sq, 4); sq += __shfl_xor(sq, 8); sq += __shfl_xor(sq, 16);
        if (r32 == 0) cur.SSQ[(size_t)(wid * QBLK + orow) * 32] = sq; }
    if constexpr (F32) {
#pragma unroll
        for (int d0 = 0; d0 < 8; ++d0) S.qr[d0] = pack8(S.tq[2 * d0], S.tq[2 * d0 + 1]); }
    __syncthreads();
#undef RESC
#undef KBASE
#undef BP
#undef ACT
#undef MASKT
#undef SEAM_K0
#undef HALF_STEP
}
#undef ROW
#undef VMW
#undef VMWN
#undef SLOAD_H
#undef SWRITE_HK
#undef SWRITE_HV
#undef SWRITE_H
#undef SLOAD_F
#undef SWRITE_KF
#undef SWRITE_VF
}
#define LAS __attribute__((address_space(3)))
typedef unsigned short bf16_t;
struct Args { const float* in[26]; float* out; unsigned char* ws; };

#define XB_TMO      128
#define XB_XCNT(j)  (256  + 64 * (j))
#define XB_XSUB(j)  (1280 + 64 * (j))
#define XB_XGEN(j)  (2304 + 64 * (j))
#define XB_TOP      3328
#define XB_TOPGEN   3392
#define XCD_BAR_WORDS 3456
#define XB_SPIN_CAP (1u << 18)

__device__ __forceinline__ unsigned xb_ld(unsigned* p)              { return __hip_atomic_load(p, __ATOMIC_RELAXED, __HIP_MEMORY_SCOPE_AGENT); }
__device__ __forceinline__ unsigned xb_add(unsigned* p, unsigned v) { return __hip_atomic_fetch_add(p, v, __ATOMIC_RELAXED, __HIP_MEMORY_SCOPE_AGENT); }
__device__ __forceinline__ unsigned xb_xcc_id() { return (unsigned)__builtin_amdgcn_s_getreg((3 << 11) | 20) & 0xFu; }
#define XB_SPIN(cond, bar) do { unsigned _sp = 0; while (cond) { __builtin_amdgcn_s_sleep(1); \
    if ((++_sp & 255u) == 0u) { if (xb_ld(&(bar)[XB_TMO])) break; if (_sp > XB_SPIN_CAP) { atomicAdd(&(bar)[XB_TMO], 1u); break; } } } } while (0)

struct XcdBarrier {
    unsigned* bar; unsigned x;
    volatile LAS unsigned* st;
};

__device__ __forceinline__ XcdBarrier xcd_barrier_post(unsigned* bar, volatile LAS unsigned* st) {
    XcdBarrier b; b.bar = bar; b.x = xb_xcc_id(); b.st = st;
    if (threadIdx.x == 0) (void)xb_add(&bar[XB_XCNT(b.x)], 1u);
    return b;
}
__device__ __forceinline__ void xcd_barrier_complete(unsigned* bar, unsigned x, unsigned& nloc, unsigned& nx) {
    const unsigned G = gridDim.x * gridDim.y * gridDim.z;
    unsigned sum, cnt, mine, sp = 0u;
    for (;;) {
        sum = 0u; cnt = 0u; mine = 0u;
#pragma unroll
        for (unsigned j = 0; j < 16; ++j) { const unsigned c = xb_ld(&bar[XB_XCNT(j)]); sum += c; cnt += (c > 0u) ? 1u : 0u; mine = (j == x) ? c : mine; }
        if (sum == G) break;
        __builtin_amdgcn_s_sleep(1);
        if ((++sp & 255u) == 0u) { if (xb_ld(&bar[XB_TMO])) break; if (sp > XB_SPIN_CAP) { atomicAdd(&bar[XB_TMO], 1u); break; } }
    }
    nloc = mine > 0u ? mine : 1u; nx = cnt > 0u ? cnt : 1u;
}

__device__ __forceinline__ void xcd_barrier(const XcdBarrier& b) {
    asm volatile("s_waitcnt vmcnt(0)" ::: "memory");
    __syncthreads();
    if (threadIdx.x == 0) {
        unsigned* bar = b.bar;
        __builtin_amdgcn_s_waitcnt(0);
        unsigned nloc = b.st[0], nx = b.st[1];
        if (nloc == 0u) { xcd_barrier_complete(bar, b.x, nloc, nx); b.st[0] = nloc; b.st[1] = nx; }
        const unsigned old = xb_add(&bar[XB_XSUB(b.x)], 1u);
        const unsigned gen = old / nloc;
        if (old + 1u == (gen + 1u) * nloc) {
            __builtin_amdgcn_fence(__ATOMIC_RELEASE, "agent");
            asm volatile("s_waitcnt vmcnt(0)" ::: "memory");
            const unsigned og = xb_add(&bar[XB_TOP], 1u);
            const unsigned tg = og / nx;
            if (og + 1u == (tg + 1u) * nx) xb_add(&bar[XB_TOPGEN], 1u);
            else XB_SPIN(xb_ld(&bar[XB_TOPGEN]) == tg, bar);
            __builtin_amdgcn_fence(__ATOMIC_ACQUIRE, "agent");
            xb_add(&bar[XB_XGEN(b.x)], 1u);
            asm volatile("s_waitcnt vmcnt(0)" ::: "memory");
        } else {
            XB_SPIN(xb_ld(&bar[XB_XGEN(b.x)]) == gen, bar);
            __builtin_amdgcn_fence(__ATOMIC_ACQUIRE, "agent");
            asm volatile("s_waitcnt vmcnt(0)" ::: "memory");
        }
    }
    __syncthreads();
}

__device__ __forceinline__ float wave_sum(float v) {
#pragma unroll
    for (int o = 1; o < 64; o <<= 1) v += __shfl_xor(v, o);
    return v;
}
__device__ __forceinline__ unsigned pk2(float lo, float hi) { return pg8::cvt_pk_bf16(lo, hi); }

__device__ __forceinline__ void tr_item(const float* __restrict__ W, int ldw, int srccol0, int k0, bf16_t* __restrict__ WT, int K, int dstrow0,
                                        const float* rs0, const float* rs1, LAS float* scr, int lane) {
#pragma unroll 8
    for (int i = 0; i < 32; ++i) { const int kk = 2 * i + (lane >> 5); float v = W[(size_t)(k0 + kk) * ldw + srccol0 + (lane & 31)];
        if (rs0) { const int k = k0 + kk; v *= (k < 1024 ? rs0[k] : rs1[k - 1024]); }
        scr[kk * 33 + (lane & 31)] = v; }
    asm volatile("s_waitcnt lgkmcnt(0)" ::: "memory");
    const int c = lane & 7;
#pragma unroll
    for (int j = 0; j < 4; ++j) { const int n = (lane >> 3) + 8 * j; const LAS float* s = scr + (8 * c) * 33 + n;
        u32x4_t o; o.x = pk2(s[0 * 33], s[1 * 33]); o.y = pk2(s[2 * 33], s[3 * 33]); o.z = pk2(s[4 * 33], s[5 * 33]); o.w = pk2(s[6 * 33], s[7 * 33]);
        *(u32x4_t*)(WT + (size_t)(dstrow0 + n) * K + k0 + 8 * c) = o; }
    asm volatile("s_waitcnt lgkmcnt(0)" ::: "memory");
}

__device__ __forceinline__ void ssm_setup_item(const Args& a, unsigned char* ws, LAS unsigned char* lds, int g, int qtr, int tid) {
    LAS float* Bre = (LAS float*)lds; LAS float* Bim = Bre + 1024; LAS float* Cre = Bre + 2048; LAS float* Cim = Bre + 3072;
    LAS float* Pr = Bre + 4096; LAS float* Pi = Pr + 33 * 64; LAS float* MZr = Pi + 33 * 64; LAS float* MZi = MZr + 32 * 64; LAS float* KT = MZi + 32 * 64;
    const float* b_re = a.in[10] + (size_t)g * 1024; const float* b_im = a.in[11] + (size_t)g * 1024;
    const float* c_re = a.in[12] + (size_t)g * 1024; const float* c_im = a.in[13] + (size_t)g * 1024;
    for (int i = tid; i < 1024; i += 512) { Bre[i] = b_re[i]; Bim[i] = b_im[i]; Cre[i] = c_re[i]; Cim[i] = c_im[i]; }
    if (tid < 64) {
        const int p = tid; const float dt = expf(a.in[9][g]); const float ar = a.in[7][g * NP + p], ai = a.in[8][g * NP + p];
        const float mag = expf(dt * ar); const float abr = mag * cosf(dt * ai), abi = mag * sinf(dt * ai);
        const float nre = abr - 1.f, nim = abi, den = ar * ar + ai * ai;
        const float zr = (nre * ar + nim * ai) / den, zi = (nim * ar - nre * ai) / den;
        float pr = 1.f, pi = 0.f;
        for (int j = 0; j <= 32; ++j) {
            Pr[j * 64 + p] = pr; Pi[j * 64 + p] = pi;
            if (j < 32) { MZr[j * 64 + p] = pr * zr - pi * zi; MZi[j * 64 + p] = pr * zi + pi * zr; }
            const float nr = pr * abr - pi * abi, ni = pr * abi + pi * abr; pr = nr; pi = ni;
        }
        if (qtr == 0) { float* P32 = (float*)(ws + WS_P32); P32[(g * NP + p) * 2] = Pr[32 * 64 + p]; P32[(g * NP + p) * 2 + 1] = Pi[32 * 64 + p]; }
    }
    __syncthreads();
    const float* dsk = a.in[14] + g * GCH;
    for (int idx = tid; idx < 8192; idx += 512) {
        const int j = idx >> 8, h = (idx >> 4) & 15, i = idx & 15; float sum = 0.f;
        for (int p = 0; p < 64; ++p) { const float mr = MZr[j * 64 + p], mi = MZi[j * 64 + p], br = Bre[p * 16 + i], bi = Bim[p * 16 + i];
            const float bzr = mr * br - mi * bi, bzi = mr * bi + mi * br; sum += Cre[h * 64 + p] * bzr - Cim[h * 64 + p] * bzi; }
        if (j == 0 && h == i) sum += dsk[h];
        KT[idx] = sum;
    }
    __syncthreads();
    bf16_t* GC = (bf16_t*)(ws + WS_GC) + (size_t)g * 512 * KA;
    for (int ci = tid; ci < 128 * 80; ci += 512) {
        const int nl = ci / 80, ch = ci - nl * 80, n = qtr * 128 + nl, t = n >> 4, h = n & 15; float v[8];
        if (ch < 64) { const int s = ch >> 1, i0 = (ch & 1) * 8;
#pragma unroll
            for (int e = 0; e < 8; ++e) v[e] = (s <= t) ? KT[((t - s) << 8) + (h << 4) + i0 + e] : 0.f;
        } else { const int pp = (ch - 64) * 8;
#pragma unroll
            for (int e = 0; e < 8; ++e) { const int p = (pp + e) & 63; const float cr = Cre[h * 64 + p], cim = Cim[h * 64 + p], pr = Pr[(t + 1) * 64 + p], pi = Pi[(t + 1) * 64 + p];
                v[e] = (pp < 64) ? (cr * pr - cim * pi) : -(cr * pi + cim * pr); }
        }
        u32x4_t o; o.x = pk2(v[0], v[1]); o.y = pk2(v[2], v[3]); o.z = pk2(v[4], v[5]); o.w = pk2(v[6], v[7]);
        *(u32x4_t*)(GC + (size_t)n * KA + ch * 8) = o;
    }
    bf16_t* WE = (bf16_t*)(ws + WS_WEND) + (size_t)g * 256 * 512;
    for (int ci = tid; ci < 64 * 64; ci += 512) {
        const int rl = ci >> 6, ch = ci & 63, pr_ = qtr * 64 + rl, s = ch >> 1, i0 = (ch & 1) * 8, p = pr_ & 63; float v[8];
#pragma unroll
        for (int e = 0; e < 8; ++e) { const float mr = MZr[(31 - s) * 64 + p], mi = MZi[(31 - s) * 64 + p], br = Bre[p * 16 + i0 + e], bi = Bim[p * 16 + i0 + e];
            v[e] = (pr_ < 64) ? (mr * br - mi * bi) : ((pr_ < 128) ? (mr * bi + mi * br) : 0.f); }
        u32x4_t o; o.x = pk2(v[0], v[1]); o.y = pk2(v[2], v[3]); o.z = pk2(v[4], v[5]); o.w = pk2(v[6], v[7]);
        *(u32x4_t*)(WE + (size_t)pr_ * 512 + ch * 8) = o;
    }
    __syncthreads();
}

__device__ __forceinline__ void norm_mod_row(const float* xrow, bf16_t* orow, const LAS float* gs, const LAS float* shv, int lane, f32x4_t (&v)[8]) {
    const f32x4_t* xr = (const f32x4_t*)xrow + lane; float s = 0.f;
#pragma unroll
    for (int j = 0; j < 8; ++j) { v[j] = xr[64 * j]; s += (v[j][0] * v[j][0] + v[j][1] * v[j][1]) + (v[j][2] * v[j][2] + v[j][3] * v[j][3]); }
    const float rstd = 1.0f / sqrtf(wave_sum(s) * (1.0f / DM) + EPS);
#pragma unroll
    for (int j = 0; j < 8; ++j) { const int k = 4 * lane + 256 * j; const f32x4_t g4 = *(const LAS f32x4_t*)(gs + k), s4 = *(const LAS f32x4_t*)(shv + k);
        v[j] = v[j] * rstd * g4 + s4;
        u32x2_t o; o.x = pk2(v[j][0], v[j][1]); o.y = pk2(v[j][2], v[j][3]); *(u32x2_t*)(orow + k) = o; }
}

__global__ void __launch_bounds__(512, 2) fwd_kernel(Args a) {
    extern __shared__ __attribute__((aligned(16))) unsigned char lds_raw[];
    cg::grid_group grid = cg::this_grid();
    LAS unsigned char* lds = (LAS unsigned char*)lds_raw;
    const int tid = threadIdx.x, lane = tid & 63, wave = __builtin_amdgcn_readfirstlane(tid >> 6), G = gridDim.x, bid = blockIdx.x;
    const int gw = bid * 8 + wave, NGW = G * 8;
    unsigned char* ws = a.ws;
    volatile LAS unsigned* xst = (volatile LAS unsigned*)(lds + LDS_BYTES - 64);
    if (tid < 2) xst[tid] = 0u;
    __syncthreads();
    XcdBarrier xbar = xcd_barrier_post((unsigned*)(ws + WS_CTL) + 4096, xst);
#define GRID_BAR() xcd_barrier(xbar)
#define MODP ((float*)(ws + WS_MODP))
#define MOD ((float*)(ws + WS_MOD))
#define LF ((float*)(ws + WS_LF))
#define CBR ((float*)(ws + WS_CBR))
#define SSQB ((float*)(ws + WS_SSQ))
#define SSQ2B ((float*)(ws + WS_SSQ2))
#define WDT ((bf16_t*)(ws + WS_WDT))
#define W1T ((bf16_t*)(ws + WS_W1T))
#define WGT ((bf16_t*)(ws + WS_WGT))
#define WOT ((bf16_t*)(ws + WS_WOT))
#define WUT ((bf16_t*)(ws + WS_WUT))
#define GC ((bf16_t*)(ws + WS_GC))
#define WEND ((bf16_t*)(ws + WS_WEND))
#define AALL ((bf16_t*)(ws + WS_AALL))
#define QKV ((bf16_t*)(ws + WS_QKV))
#define YB ((bf16_t*)(ws + WS_YB))
#define MIX ((bf16_t*)(ws + WS_MIX))
#define HN ((bf16_t*)(ws + WS_HN))
#define ABUF ((bf16_t*)(ws + WS_ABUF))
#define BBUF ((bf16_t*)(ws + WS_BBUF))
#define XIN (a.in[0])
#define OUT (a.out)


    {
        LAS f32x4_t* red = (LAS f32x4_t*)lds; const float* cvec = a.in[1]; const float* w_ada = a.in[2];
        for (int it = bid; it < 768; it += G) {
            const int nc = it % 48, ks = it / 48, n0 = nc * 256, k0 = ks * 128 + wave * 16;
            f32x4_t acc = {0.f, 0.f, 0.f, 0.f};
#pragma unroll
            for (int r = 0; r < 16; ++r) { const int k = k0 + r; const float cv = cvec[k]; const float sv = cv / (1.0f + expf(-cv));
                const f32x4_t w = *(const f32x4_t*)(w_ada + (size_t)k * (6 * DM) + n0 + 4 * lane); acc += sv * w; }
            red[wave * 64 + lane] = acc;
            __syncthreads();
            if (tid < 256) { float s = 0.f;
#pragma unroll
                for (int w = 0; w < 8; ++w) s += ((LAS float*)red)[w * 256 + tid];
                MODP[ks * (6 * DM) + n0 + tid] = s; }
            __syncthreads();
        }
    }
    for (int it = bid; it < 4 * NG; it += G) ssm_setup_item(a, ws, lds, it >> 2, it & 3, tid);
    __syncthreads();
    {
        LAS float* scr = (LAS float*)(lds + wave * 16384);
        constexpr int I_IN = 32 * 128, I_GLU = 16 * 32, I_OUT = 32 * 64, I_UP = 32 * 352, I_DN = 88 * 64, I_ALL = I_IN + I_GLU + I_OUT + I_UP + I_DN;
        for (int it = gw; it < I_ALL; it += NGW) {
            int r = it;
            if (r < I_IN) { const int kb = r / 128, n0 = 32 * (r % 128); tr_item(a.in[5], INW, n0 < 3072 ? n0 : n0 + 8, 64 * kb, W1T, DM, n0, nullptr, nullptr, scr, lane); continue; } r -= I_IN;
            if (r < I_GLU) { const int kb = r / 32, n0 = 32 * (r % 32); tr_item(a.in[15], SW, n0, 64 * kb, WGT, SW, n0, nullptr, nullptr, scr, lane); continue; } r -= I_GLU;
            if (r < I_OUT) { const int kb = r / 64, n0 = 32 * (r % 64); tr_item(a.in[19], DM, n0, 64 * kb, WOT, DM, n0, a.in[17], a.in[18], scr, lane); continue; } r -= I_OUT;
            if (r < I_UP) { const int kb = r / 352, n0 = 32 * (r % 352); const int pn = n0 >> 8, bj = (n0 >> 7) & 1, w = n0 & 127;
                tr_item(a.in[21], 2 * DFF, bj * DFF + 128 * pn + w, 64 * kb, WUT, DM, n0, nullptr, nullptr, scr, lane); continue; } r -= I_UP;
            { const int kb = r / 64, n0 = 32 * (r % 64); tr_item(a.in[24], DM, n0, 64 * kb, WDT, DFF, n0, nullptr, nullptr, scr, lane); }
        }
    }
    grid.sync();

    {
        LAS float* gs = (LAS float*)lds; LAS float* shv = gs + DM; LAS float* wf = shv + DM;
        const float* b_ada = a.in[3]; const float* g_mix = a.in[4]; const float* w_in = a.in[5];
        for (int k = tid; k < DM; k += 512) { float sh = b_ada[k], sc = b_ada[DM + k];
            for (int j = 0; j < 16; ++j) { sh += MODP[j * (6 * DM) + k]; sc += MODP[j * (6 * DM) + DM + k]; }
            gs[k] = g_mix[k] * (1.0f + sc); shv[k] = sh; }
        for (int i = tid; i < DM * 8; i += 512) wf[i] = w_in[(size_t)(i >> 3) * INW + 3072 + (i & 7)];
        for (int n = bid * 512 + tid; n < 6 * DM; n += G * 512) { float m = b_ada[n]; for (int j = 0; j < 16; ++j) m += MODP[j * (6 * DM) + n]; MOD[n] = m; }
        __syncthreads();
        const float* b_f = a.in[6];
        for (int row = gw; row < SEQ; row += NGW) {
            f32x4_t v[8]; norm_mod_row(XIN + (size_t)row * DM, HN + (size_t)row * DM, gs, shv, lane, v);
            f32x4_t f0 = {0.f, 0.f, 0.f, 0.f}, f1 = {0.f, 0.f, 0.f, 0.f};
#pragma unroll
            for (int j = 0; j < 8; ++j)
#pragma unroll
                for (int e = 0; e < 4; ++e) { const int k = 4 * lane + 256 * j + e; const f32x4_t w0 = *(const LAS f32x4_t*)(wf + k * 8), w1 = *(const LAS f32x4_t*)(wf + k * 8 + 4);
                    f0 += v[j][e] * w0; f1 += v[j][e] * w1; }
            float fd = 0.f;
#pragma unroll
            for (int h = 0; h < 8; ++h) { const float t = wave_sum(h < 4 ? f0[h & 3] : f1[h & 3]); if (lane == h) fd = t; }
            if (lane < 8) { const float z = fd + b_f[lane]; LF[lane * SEQ + row] = fminf(z, 0.f) - log1pf(expf(-fabsf(z))); }
        }
    }
    GRID_BAR();

    if (bid < NH) {
        LAS double* tot = (LAS double*)lds; const int h = bid; const float* src = LF + h * SEQ + tid * 16;
        float vals[16];
#pragma unroll
        for (int q = 0; q < 4; ++q) { const f32x4_t t = *(const f32x4_t*)(src + 4 * q); vals[4 * q] = t[0]; vals[4 * q + 1] = t[1]; vals[4 * q + 2] = t[2]; vals[4 * q + 3] = t[3]; }
        double run = 0.0;
#pragma unroll
        for (int e = 0; e < 16; ++e) run += (double)vals[e];
        tot[tid] = run;
        __syncthreads();
        double c = 0.0; for (int i = 0; i < tid; ++i) c += tot[i];
        float* dst = CBR + h * SEQ + tid * 16;
#pragma unroll
        for (int e = 0; e < 16; ++e) { c += (double)vals[e]; dst[e] = -(float)(c * 11.313708498984761); }
        __syncthreads();
    }
    {
        pg8::Gemm g{HN, W1T, SEQ, 4096, DM, DM, DM}; pg8::StaticOrder S; S.init(SEQ, 4096, G, bid);
        pg8::EpiQKVU E{QKV, AALL};
#ifndef NO_G1
        pg8::gemm_phase<pg8::EpiQKVU, pg8::StaticOrder, true, true>(lds, g, S, E);
#endif
    }
    GRID_BAR();

    {
        pg8::Gemm g{AALL, WEND, NG * NCH, NG * 256, CL * GCH, KA, CL * GCH}; pg8::CarryOrder S{G, bid};
        pg8::EpiCarry E{AALL, (const float*)(ws + WS_P32)};
#ifndef NO_G2
        pg8::gemm_phase<pg8::EpiCarry, pg8::CarryOrder, false, true>(lds, g, S, E);
#endif
    }
    GRID_BAR();

    {
        using abf = att::bf16;
        char* ldsg = (char*)lds_raw;
        BIAS_LAS float* bias = (BIAS_LAS float*)(lds + att::BIAS_OFF);
        att::Seam<abf> Sm;
        if (bid < NH * (SEQ / att::QB)) { const int it = bid;
            const int head = it & 7, qb = (SEQ / att::QB - 1) - (it >> 3), P0 = qb * att::QB;
            for (int k = tid * 4; k < P0 + att::QB; k += 2048) *(BIAS_LAS f32x4_t*)(bias + k) = *(const f32x4_t*)(CBR + head * SEQ + k);
            __syncthreads();
            att::BlockRef<abf, abf> cur;
            cur.Q = (const abf*)QKV + ((size_t)(0 * NH + head) * SEQ + P0) * HD; cur.K = (const abf*)QKV + (size_t)(1 * NH + head) * SEQ * HD; cur.V = (const abf*)QKV + (size_t)(2 * NH + head) * SEQ * HD;
            cur.O = (abf*)MIX + (size_t)P0 * DM + head * HD; cur.P0 = P0; cur.JLO = 0; cur.SSQ = SSQB + (size_t)P0 * 32 + head;
#ifndef NO_ATT
            att::causal_swa_prime<abf, abf>(cur, 1 << 30, ldsg, Sm);
            att::causal_swa_block<abf, abf>(cur, cur, SEQ, 1 << 30, ldsg, Sm, bias, 0);
#endif
        }
        asm volatile("s_waitcnt vmcnt(0)" ::: "memory");
        __syncthreads();
        pg8::Gemm g{AALL, GC, NG * NCH, NG * 512, KA, KA, KA}; pg8::ChunkOrder S{G, G - 1 - bid};
        pg8::EpiY E{YB};
#ifndef NO_G3
        pg8::gemm_phase<pg8::EpiY, pg8::ChunkOrder, true, true>(lds, g, S, E);
#endif
    }
    GRID_BAR();

    {
        pg8::Gemm g{YB, WGT, SEQ, SW, SW, SW, SW}; pg8::StaticOrder S; S.init(SEQ, SW, G, bid);
        pg8::EpiGlu E{YB, MIX, a.in[16], SSQB};
#ifndef NO_G4
        pg8::gemm_phase<pg8::EpiGlu, pg8::StaticOrder, true, true>(lds, g, S, E);
#endif
    }
    GRID_BAR();

    {
        pg8::Gemm g{MIX, WOT, SEQ, DM, DM, DM, DM}; pg8::StaticOrder S; S.init(SEQ, DM, G, bid);
        LAS float* rtab = (LAS float*)(lds + RING_BYTES);
        { pg8::Unit u0; if (S.next(0, u0) && tid < 256) { float ra, rs; pg8::EpiWout::rstds(SSQB, u0.pm * 256 + tid, ra, rs); rtab[2 * tid] = ra / rs; rtab[2 * tid + 1] = rs; } }
        __syncthreads();
        pg8::EpiWout E{rtab, XIN, MOD + 2 * DM, OUT};
#ifndef NO_G5
        pg8::gemm_phase<pg8::EpiWout, pg8::StaticOrder, true, true>(lds, g, S, E);
#endif
    }
    GRID_BAR();

    {
        LAS float* gs = (LAS float*)lds; LAS float* shv = gs + DM; const float* g_ffn = a.in[20];
        for (int k = tid; k < DM; k += 512) { gs[k] = g_ffn[k] * (1.0f + MOD[4 * DM + k]); shv[k] = MOD[3 * DM + k]; }
        __syncthreads();
        for (int row = gw; row < SEQ; row += NGW) { f32x4_t v[8]; norm_mod_row(OUT + (size_t)row * DM, HN + (size_t)row * DM, gs, shv, lane, v); }
    }
    GRID_BAR();

    {
        pg8::Gemm g{HN, WUT, SEQ, 2 * DFF, DM, DM, DM}; pg8::StaticOrder S; S.init(SEQ, 2 * DFF, G, bid);
        pg8::EpiUp E{ABUF, BBUF};
#ifndef NO_G6
        pg8::gemm_phase<pg8::EpiUp, pg8::StaticOrder, true, true>(lds, g, S, E);
#endif
    }
    GRID_BAR();

    {
        const float* cw = a.in[22]; const float* cbias = a.in[23];
        constexpr int NCC = DFF / 8, NRB = SEQ / 16;
        for (int id = bid * 512 + tid; id < NRB * NCC; id += G * 512) {
            const int rb = id / NCC, cc = id - rb * NCC, col = cc * 8, t0 = rb * 16;
            float w0[8], w1[8], w2[8], cb[8], am2[8], am1[8];
#pragma unroll
            for (int q = 0; q < 2; ++q) { const f32x4_t u0 = *(const f32x4_t*)(cw + col + 4 * q), u1 = *(const f32x4_t*)(cw + DFF + col + 4 * q), u2 = *(const f32x4_t*)(cw + 2 * DFF + col + 4 * q), u3 = *(const f32x4_t*)(cbias + col + 4 * q);
#pragma unroll
                for (int e = 0; e < 4; ++e) { w0[4 * q + e] = u0[e]; w1[4 * q + e] = u1[e]; w2[4 * q + e] = u2[e]; cb[4 * q + e] = u3[e]; } }
#pragma unroll
            for (int e = 0; e < 8; ++e) { am2[e] = 0.f; am1[e] = 0.f; }
            if (t0 > 0) { const u32x4_t p2 = *(const u32x4_t*)(ABUF + (size_t)(t0 - 2) * DFF + col), p1 = *(const u32x4_t*)(ABUF + (size_t)(t0 - 1) * DFF + col);
                am2[0] = bf_lo(p2.x); am2[1] = bf_hi(p2.x); am2[2] = bf_lo(p2.y); am2[3] = bf_hi(p2.y); am2[4] = bf_lo(p2.z); am2[5] = bf_hi(p2.z); am2[6] = bf_lo(p2.w); am2[7] = bf_hi(p2.w);
                am1[0] = bf_lo(p1.x); am1[1] = bf_hi(p1.x); am1[2] = bf_lo(p1.y); am1[3] = bf_hi(p1.y); am1[4] = bf_lo(p1.z); am1[5] = bf_hi(p1.z); am1[6] = bf_lo(p1.w); am1[7] = bf_hi(p1.w); }
            for (int r = 0; r < 16; ++r) {
                const size_t off = (size_t)(t0 + r) * DFF + col;
                const u32x4_t pa = *(const u32x4_t*)(ABUF + off), pb = *(const u32x4_t*)(BBUF + off);
                float av[8], bv[8], gv[8];
                av[0] = bf_lo(pa.x); av[1] = bf_hi(pa.x); av[2] = bf_lo(pa.y); av[3] = bf_hi(pa.y); av[4] = bf_lo(pa.z); av[5] = bf_hi(pa.z); av[6] = bf_lo(pa.w); av[7] = bf_hi(pa.w);
                bv[0] = bf_lo(pb.x); bv[1] = bf_hi(pb.x); bv[2] = bf_lo(pb.y); bv[3] = bf_hi(pb.y); bv[4] = bf_lo(pb.z); bv[5] = bf_hi(pb.z); bv[6] = bf_lo(pb.w); bv[7] = bf_hi(pb.w);
#pragma unroll
                for (int e = 0; e < 8; ++e) { const float cv = cb[e] + w0[e] * am2[e] + w1[e] * am1[e] + w2[e] * av[e]; gv[e] = cv * fast_sigmoid(cv) * bv[e]; am2[e] = am1[e]; am1[e] = av[e]; }
                u32x4_t o; o.x = pk2(gv[0], gv[1]); o.y = pk2(gv[2], gv[3]); o.z = pk2(gv[4], gv[5]); o.w = pk2(gv[6], gv[7]);
                *(u32x4_t*)(BBUF + off) = o;
            }
        }
    }
    GRID_BAR();

    {
        pg8::Gemm g{BBUF, WDT, SEQ, DM, DFF, DFF, DFF}; pg8::StaticOrder S; S.init(SEQ, DM, G, bid);
        pg8::EpiDown E{MOD + 5 * DM, OUT, SSQ2B};
#ifndef NO_G7
        pg8::gemm_phase<pg8::EpiDown, pg8::StaticOrder, true, true>(lds, g, S, E);
#endif
    }
    GRID_BAR();

    {
        const float* gf = a.in[25];
        for (int row = gw; row < SEQ; row += NGW) {
            const float part = lane < 32 ? SSQ2B[(size_t)row * 32 + lane] : 0.f;
            const float rstd = 1.0f / sqrtf(wave_sum(part) * (1.0f / DM) + EPS);
            f32x4_t* orow = (f32x4_t*)(OUT + (size_t)row * DM) + lane; const f32x4_t* g4 = (const f32x4_t*)gf + lane;
#pragma unroll
            for (int j = 0; j < 8; ++j) orow[64 * j] = orow[64 * j] * rstd * g4[64 * j];
        }
    }
}

extern "C" void kernel_launch(void* const* d_in, const int* in_sizes, int n_in, void* d_out, int out_size, void* d_ws, size_t ws_size, hipStream_t stream) {
    static int grid = 0;
    if (grid == 0) {
        if (n_in != 26 || out_size != SEQ * DM || ws_size < WS_END) { fprintf(stderr, "kernel_launch: unexpected shapes (n_in %d out %d ws %zu)\n", n_in, out_size, ws_size); grid = -1; return; }
        int dev = 0, cus = 0, per_cu = 0;
        (void)hipGetDevice(&dev); (void)hipDeviceGetAttribute(&cus, hipDeviceAttributeMultiprocessorCount, dev);
        if (hipFuncSetAttribute((const void*)fwd_kernel, hipFuncAttributeMaxDynamicSharedMemorySize, LDS_BYTES) != hipSuccess) { fprintf(stderr, "kernel_launch: hipFuncSetAttribute failed\n"); grid = -1; return; }
        if (hipOccupancyMaxActiveBlocksPerMultiprocessor(&per_cu, (const void*)fwd_kernel, 512, LDS_BYTES) != hipSuccess || per_cu < 1) { fprintf(stderr, "kernel_launch: occupancy query gave %d\n", per_cu); per_cu = 1; }
        (void)hipGetLastError();
        grid = cus;
        if (grid > 256) grid = 256;
    }
    if (grid < 0) return;
    (void)hipMemsetAsync((char*)d_ws + WS_CTL, 0, CTL_ZERO_BYTES, stream);
    Args a{};
    for (int i = 0; i < 26; ++i) a.in[i] = (const float*)d_in[i];
    a.out = (float*)d_out; a.ws = (unsigned char*)d_ws;
    void* args[] = {&a};
    hipError_t e = hipLaunchCooperativeKernel((const void*)fwd_kernel, dim3(grid), dim3(512), args, LDS_BYTES, stream);
    if (e != hipSuccess) fprintf(stderr, "cooperative launch failed: %s (grid %d)\n", hipGetErrorString(e), grid);
}
```

```cpp
#include <hip/hip_runtime.h>
#include <hip/hip_cooperative_groups.h>
#include <cstdio>
#include <cstdint>
namespace cg = cooperative_groups;

constexpr int SEQ = 8192, DM = 2048, AW = 1024, HD = 128, NH = 8, SW = 1024, NG = 64, GCH = 16, NP = 64, INW = 4104, DFF = 5632;
constexpr int CL = 32, NCH = SEQ / CL;
constexpr int KA = CL * GCH + 2 * NP;
constexpr float EPS = 1e-6f;
constexpr size_t MiB = 1u << 20, KiB = 1024;
constexpr size_t WS_CTL = 0, CTL_ZERO_BYTES = 1 * MiB;
constexpr size_t WS_NRM = 512 * KiB;
constexpr size_t WS_MODP = 1 * MiB;
constexpr size_t WS_MOD = 2 * MiB;
constexpr size_t WS_LF = 2 * MiB + 64 * KiB;
constexpr size_t WS_CBR = 2 * MiB + 320 * KiB;
constexpr size_t WS_P32 = 2 * MiB + 576 * KiB;
constexpr size_t WS_SSQ = 3 * MiB;
constexpr size_t WS_SSQ2 = 4 * MiB;
constexpr size_t WS_WDT = 8 * MiB;
constexpr size_t WS_W1T = 30 * MiB;
constexpr size_t WS_WGT = 46 * MiB;
constexpr size_t WS_WOT = 48 * MiB;
constexpr size_t WS_WUT = 56 * MiB;
constexpr size_t WS_GC = 100 * MiB;
constexpr size_t WS_WEND = 140 * MiB;
constexpr size_t WS_AALL = 156 * MiB;
constexpr size_t WS_QKV = 176 * MiB;
constexpr size_t WS_YB = 224 * MiB;
constexpr size_t WS_MIX = 240 * MiB;
constexpr size_t WS_HN = 280 * MiB;
constexpr size_t WS_ABUF = 100 * MiB;
constexpr size_t WS_BBUF = 188 * MiB;
constexpr size_t WS_END = 312 * MiB;
static_assert(WS_ABUF + (size_t)SEQ * DFF * 2 <= WS_BBUF && WS_BBUF + (size_t)SEQ * DFF * 2 <= WS_HN && WS_HN + (size_t)SEQ * DM * 2 <= WS_END, "ws map");
static_assert(WS_WUT + (size_t)2 * DFF * DM * 2 <= WS_GC && WS_GC + (size_t)NG * 512 * KA * 2 <= WS_WEND && WS_WEND + (size_t)NG * 256 * 512 * 2 <= WS_AALL && WS_AALL + (size_t)NG * 256 * KA * 2 <= WS_QKV, "ws map 2");
static_assert(WS_QKV + (size_t)3 * SEQ * AW * 2 <= WS_YB && WS_YB + (size_t)SEQ * SW * 2 <= WS_MIX && WS_MIX + (size_t)SEQ * DM * 2 <= WS_HN, "ws map 3");
static_assert(WS_WDT + (size_t)DM * DFF * 2 <= WS_W1T && WS_W1T + (size_t)4096 * DM * 2 <= WS_WGT && WS_WOT + (size_t)DM * DM * 2 <= WS_WUT, "ws map 4");
constexpr int LDS_BYTES = 147456;
constexpr int RING_BYTES = 131072;

typedef float f32x4_t __attribute__((ext_vector_type(4)));
typedef unsigned u32x4_t __attribute__((ext_vector_type(4)));
typedef unsigned u32x2_t __attribute__((ext_vector_type(2)));
__device__ __forceinline__ float bf_lo(unsigned w) { return __uint_as_float(w << 16); }
__device__ __forceinline__ float bf_hi(unsigned w) { return __uint_as_float(w & 0xffff0000u); }
__device__ __forceinline__ float fast_sigmoid(float z) { return __builtin_amdgcn_rcpf(1.0f + __builtin_amdgcn_exp2f(-1.4426950408889634f * z)); }
__device__ __forceinline__ float gelu_tanh(float v) { const float z = 1.5957691216057308f * (v + 0.044715f * v * v * v); return v * fast_sigmoid(z); }

namespace pg8 {
#define PG8_LAS __attribute__((address_space(3)))
typedef unsigned short bf16_t;
typedef short bf16x8 __attribute__((ext_vector_type(8)));
typedef float f32x4 __attribute__((ext_vector_type(4)));
typedef unsigned u32x4 __attribute__((ext_vector_type(4)));
constexpr int BM = 256, BK = 64, HALF = 128, HTB = HALF * BK * 2  , STAGE_BYTES = 8 * HTB, NXCD = 8, WGM = 8;

__host__ __device__ __forceinline__ int lds_byte(int r, int c) { const int st = (r >> 4) * 2 + (c >> 5), rr = r & 15, cc = c & 31, ob = rr * 64 + cc * 2; return st * 1024 + (ob ^ (((ob >> 9) & 1) << 5)); }
__host__ __device__ __forceinline__ void stage_rc(int b, int& R, int& C) { const int st = b / 1024, sb = b % 1024, swz = sb ^ (((sb >> 9) & 1) << 5); R = (st >> 1) * 16 + swz / 64; C = (st & 1) * 32 + (swz % 64) / 2; }
__host__ __device__ __forceinline__ int perm32(int rho) { const int n = rho >> 4, i = rho & 15; return 8 * (i >> 2) + 4 * n + (i & 3); }

struct Unit { int pm, pn; };
struct Gemm { const bf16_t* A; const bf16_t* Bt; int M, N, K, lda, ldb; };

struct StaticOrder {
    int nM, nN, nwg, G, c;
    __host__ __device__ void init(int M, int N, int G_, int c_) { nM = M / BM; nN = N / BM; nwg = nM * nN; G = G_; c = c_; }
    __host__ __device__ bool next(int i, Unit& u) const {
        const long L = (long)i * G + c; if (L >= nwg) return false;
        int wgid = (int)L; { const int q = nwg / NXCD, r = nwg % NXCD, xcd = wgid % NXCD, off = wgid / NXCD; wgid = (xcd < r ? xcd * (q + 1) : r * (q + 1) + (xcd - r) * q) + off; }
        const int nig = WGM * nN, gid = wgid / nig, fm = gid * WGM, gsz = (nM - fm) < WGM ? (nM - fm) : WGM;
        u.pm = fm + ((wgid % nig) % gsz); u.pn = (wgid % nig) / gsz; return true;
    }
    __device__ __forceinline__ void a_ready(const Unit&) const {}
    __device__ __forceinline__ void done(const Unit&) const {}
};


template <class Epi, class Sched, bool ALIGN_EPI = false, bool SP2 = false>
__device__ __forceinline__ void gemm_phase(PG8_LAS unsigned char* lds, const Gemm g, const Sched& S, const Epi& E, const int wv  ) {
    int tid_ = wv * 64 + ((int)__builtin_amdgcn_mbcnt_hi(~0u, __builtin_amdgcn_mbcnt_lo(~0u, 0u))); asm volatile("" : "+v"(tid_));
    const int tid = tid_, wid = __builtin_amdgcn_readfirstlane(tid >> 6), lane = tid & 63, wr = wid >> 2, wc = wid & 3, fr = lane & 15, fq = lane >> 4;
    const int K = g.K, nt = K / BK;
    unsigned voffA[2], voffB[2];
#pragma unroll
    for (int i = 0; i < 2; ++i) { int R, C; stage_rc(tid * 16 + i * 8192, R, C); const int Rb = Epi::PERM ? ((R & ~31) + perm32(R & 31)) : R;
        voffA[i] = (unsigned)(R * g.lda + C) * 2u; voffB[i] = (unsigned)(Rb * g.ldb + C) * 2u; }
    const size_t kstep = (size_t)(BK * 2);
    const size_t hstepA = (size_t)HALF * g.lda * 2, hstepB = (size_t)HALF * g.ldb * 2;
    const size_t tstepA = 2 * hstepA, tstepB = 2 * hstepB;
    const unsigned ldsw = (unsigned)wid * 1024u;
    const int aoff = lds_byte(wr * 64 + fr, fq * 8), boff = lds_byte(wc * 32 + fr, fq * 8);
#define PG8_SA(b, h) (((b) * 2 + (h)) * HTB)
#define PG8_SB(b, h) ((4 + (b) * 2 + (h)) * HTB)
#define PG8_STAGE(bufoff, gbase, voff) do { _Pragma("unroll") for (int _i = 0; _i < 2; ++_i) \
        __builtin_amdgcn_global_load_lds((const unsigned*)((const char*)(gbase) + (voff)[_i]), (PG8_LAS unsigned*)(lds + (bufoff) + ldsw + _i * 8192), 16, 0, 0); } while (0)
#define PG8_LDA(dst, b, h) do { _Pragma("unroll") for (int m = 0; m < 4; ++m) _Pragma("unroll") for (int k = 0; k < 2; ++k) dst[m][k] = *(const PG8_LAS bf16x8*)(lds + PG8_SA(b, h) + aoff + m * 2048 + k * 1024); } while (0)
#define PG8_LDB(dst, b, h) do { _Pragma("unroll") for (int n = 0; n < 2; ++n) _Pragma("unroll") for (int k = 0; k < 2; ++k) dst[n][k] = *(const PG8_LAS bf16x8*)(lds + PG8_SB(b, h) + boff + n * 2048 + k * 1024); } while (0)
#define PG8_MMA(ai, bj, At, Bt) do { __builtin_amdgcn_s_setprio(1); _Pragma("unroll") for (int m = 0; m < 4; ++m) _Pragma("unroll") for (int n = 0; n < 2; ++n) _Pragma("unroll") for (int k = 0; k < 2; ++k) \
        acc[ai][bj][m][n] = __builtin_amdgcn_mfma_f32_16x16x32_bf16(Bt[n][k], At[m][k], acc[ai][bj][m][n], 0, 0, 0); __builtin_amdgcn_s_setprio(0); } while (0)
#define PG8_WAIT_V(n) asm volatile("s_waitcnt vmcnt(" #n ")" ::: "memory")
#define PG8_WAIT_L(n) asm volatile("s_waitcnt lgkmcnt(" #n ")" ::: "memory")
#define PG8_BAR __builtin_amdgcn_s_barrier()
#define PG8_SCHED __builtin_amdgcn_sched_barrier(0)
    Unit cur, nxt; int ui = 0;
    if (!S.next(0, cur)) return;
    f32x4 acc[2][2][4][2];
#pragma unroll
    for (int a = 0; a < 2; ++a)
#pragma unroll
        for (int b = 0; b < 2; ++b)
#pragma unroll
            for (int m = 0; m < 4; ++m)
#pragma unroll
                for (int n = 0; n < 2; ++n) acc[a][b][m][n] = (f32x4){0.f, 0.f, 0.f, 0.f};
    bf16x8 At[4][2], B0[2][2], B1[2][2];
    const char* cA = (const char*)g.A + (size_t)cur.pm * tstepA; const char* cB = (const char*)g.Bt + (size_t)cur.pn * tstepB;
    S.a_ready(cur);
    if constexpr (SP2) {
        PG8_STAGE(PG8_SB(0, 0), cB, voffB); PG8_STAGE(PG8_SB(0, 1), cB + hstepB, voffB); PG8_STAGE(PG8_SA(0, 0), cA, voffA); PG8_STAGE(PG8_SA(0, 1), cA + hstepA, voffA);
        if (wr == 1) PG8_BAR;
        PG8_WAIT_V(2); PG8_BAR;
        PG8_STAGE(PG8_SB(1, 0), cB + kstep, voffB); PG8_STAGE(PG8_SA(1, 0), cA + kstep, voffA); PG8_STAGE(PG8_SB(1, 1), cB + hstepB + kstep, voffB);
        PG8_WAIT_V(6); PG8_BAR;
    } else {
        PG8_STAGE(PG8_SB(0, 0), cB, voffB); PG8_STAGE(PG8_SA(0, 0), cA, voffA); PG8_STAGE(PG8_SB(0, 1), cB + hstepB, voffB); PG8_STAGE(PG8_SA(0, 1), cA + hstepA, voffA);
        if (wr == 1) PG8_BAR;
        PG8_WAIT_V(4); PG8_BAR;
        PG8_STAGE(PG8_SB(1, 0), cB + kstep, voffB); PG8_STAGE(PG8_SA(1, 0), cA + kstep, voffA); PG8_STAGE(PG8_SB(1, 1), cB + hstepB + kstep, voffB);
        PG8_WAIT_V(6); PG8_BAR;
    }
    for (;;) {
        const bool has_next = S.next(ui + 1, nxt);
        const char* nA = has_next ? (const char*)g.A + (size_t)nxt.pm * tstepA : cA; const char* nB = has_next ? (const char*)g.Bt + (size_t)nxt.pn * tstepB : cB;
        for (int t = 0; t < nt; t += 2) {
            const bool last = (t == nt - 2);
            const char* a1 = cA + (size_t)(t + 1) * kstep;
            const char* a2 = last ? nA : cA + (size_t)(t + 2) * kstep; const char* b2 = last ? nB : cB + (size_t)(t + 2) * kstep;
            const char* a3 = a2 + kstep; const char* b3 = b2 + kstep;
            if (last && has_next) S.a_ready(nxt);
            if constexpr (Epi::MIDK) { if (t == (nt >> 1)) E.mid(acc, cur, wr, fr); }
            if constexpr (SP2) {
            PG8_LDB(B0, 0, 0); PG8_LDB(B1, 0, 1); PG8_SCHED; PG8_LDA(At, 0, 0); PG8_STAGE(PG8_SA(1, 1), a1 + hstepA, voffA);
            PG8_WAIT_V(8); PG8_WAIT_L(0); PG8_BAR; PG8_MMA(0, 0, At, B0); PG8_MMA(0, 1, At, B1); PG8_BAR; PG8_SCHED;
            PG8_LDA(At, 0, 1); PG8_STAGE(PG8_SB(0, 0), b2, voffB); PG8_STAGE(PG8_SB(0, 1), b2 + hstepB, voffB); PG8_STAGE(PG8_SA(0, 0), a2, voffA);
            PG8_WAIT_V(8); PG8_WAIT_L(0); PG8_BAR; PG8_MMA(1, 0, At, B0); PG8_MMA(1, 1, At, B1); PG8_BAR; PG8_SCHED;
            PG8_LDB(B0, 1, 0); PG8_LDB(B1, 1, 1); PG8_SCHED; PG8_LDA(At, 1, 0); PG8_STAGE(PG8_SA(0, 1), a2 + hstepA, voffA);
            PG8_WAIT_V(8); PG8_WAIT_L(0); PG8_BAR; PG8_MMA(0, 0, At, B0); PG8_MMA(0, 1, At, B1); PG8_BAR; PG8_SCHED;
            PG8_LDA(At, 1, 1); PG8_STAGE(PG8_SB(1, 0), b3, voffB); PG8_STAGE(PG8_SB(1, 1), b3 + hstepB, voffB); PG8_STAGE(PG8_SA(1, 0), a3, voffA);
            PG8_WAIT_V(8); PG8_WAIT_L(0); PG8_BAR; PG8_MMA(1, 0, At, B0); PG8_MMA(1, 1, At, B1); PG8_BAR; PG8_SCHED;
            } else {
            PG8_LDB(B0, 0, 0); PG8_SCHED; PG8_LDA(At, 0, 0); PG8_STAGE(PG8_SA(1, 1), a1 + hstepA, voffA);
            PG8_WAIT_L(8); PG8_BAR; PG8_WAIT_L(0); PG8_MMA(0, 0, At, B0); PG8_BAR; PG8_SCHED;
            PG8_LDB(B1, 0, 1); PG8_STAGE(PG8_SB(0, 0), b2, voffB);
            PG8_BAR; PG8_WAIT_L(0); PG8_MMA(0, 1, At, B1); PG8_BAR;
            PG8_LDA(At, 0, 1); PG8_STAGE(PG8_SA(0, 0), a2, voffA);
            PG8_BAR; PG8_WAIT_L(0); PG8_MMA(1, 0, At, B0); PG8_BAR; PG8_SCHED;
            PG8_STAGE(PG8_SB(0, 1), b2 + hstepB, voffB);
            PG8_WAIT_V(6); PG8_BAR; PG8_MMA(1, 1, At, B1); PG8_BAR;
            PG8_LDB(B0, 1, 0); PG8_SCHED; PG8_LDA(At, 1, 0); PG8_STAGE(PG8_SA(0, 1), a2 + hstepA, voffA);
            PG8_WAIT_L(8); PG8_BAR; PG8_WAIT_L(0); PG8_MMA(0, 0, At, B0); PG8_BAR; PG8_SCHED;
            PG8_LDB(B1, 1, 1); PG8_STAGE(PG8_SB(1, 0), b3, voffB);
            PG8_BAR; PG8_WAIT_L(0); PG8_MMA(0, 1, At, B1); PG8_BAR;
            PG8_LDA(At, 1, 1); PG8_STAGE(PG8_SA(1, 0), a3, voffA);
            PG8_BAR; PG8_WAIT_L(0); PG8_MMA(1, 0, At, B0); PG8_BAR; PG8_SCHED;
            PG8_STAGE(PG8_SB(1, 1), b3 + hstepB, voffB);
            PG8_WAIT_V(6); PG8_BAR; PG8_MMA(1, 1, At, B1); PG8_BAR;
            }
        }
        if constexpr (ALIGN_EPI) { if (wr == 0) PG8_BAR; }
        if constexpr (!Epi::AFTER_DRAIN) { E(acc, cur, wr, wc, fr, fq); S.done(cur); }
        if (!has_next) break;
#pragma unroll
        for (int a = 0; a < 2; ++a)
#pragma unroll
            for (int b = 0; b < 2; ++b)
#pragma unroll
                for (int m = 0; m < 4; ++m)
#pragma unroll
                    for (int n = 0; n < 2; ++n) acc[a][b][m][n] = (f32x4){0.f, 0.f, 0.f, 0.f};
        cur = nxt; cA = nA; cB = nB; ++ui;
        if constexpr (ALIGN_EPI) { if (wr == 1) PG8_BAR; }
    }
    PG8_WAIT_V(0);
    if constexpr (!ALIGN_EPI) { if (wr == 0) PG8_BAR; }
    PG8_BAR;
    if constexpr (Epi::AFTER_DRAIN) { E.fused(acc, cur, wr, wc, fr, fq, lds, wid, lane); S.done(cur); }
#undef PG8_SA
#undef PG8_SB
#undef PG8_STAGE
#undef PG8_LDA
#undef PG8_LDB
#undef PG8_MMA
#undef PG8_WAIT_V
#undef PG8_WAIT_L
#undef PG8_BAR
#undef PG8_SCHED
}
__device__ __forceinline__ unsigned cvt_pk_bf16(float lo, float hi) { unsigned r; asm volatile("v_cvt_pk_bf16_f32 %0, %1, %2" : "=v"(r) : "v"(lo), "v"(hi)); return r; }
__device__ __forceinline__ u32x4 pack8(const f32x4 a, const f32x4 b) { u32x4 w; w.x = cvt_pk_bf16(a[0], a[1]); w.y = cvt_pk_bf16(a[2], a[3]); w.z = cvt_pk_bf16(b[0], b[1]); w.w = cvt_pk_bf16(b[2], b[3]); return w; }

struct CarryOrder {
    int G, c;
    __device__ bool next(int i, Unit& u) const { const int L = i * G + c; if (L >= NG) return false; u.pm = L; u.pn = L; return true; }
    __device__ __forceinline__ void a_ready(const Unit&) const {}
    __device__ __forceinline__ void done(const Unit&) const {}
};
struct ChunkOrder {
    int G, c;
    __device__ bool next(int i, Unit& u) const { const int L = i * G + c; if (L >= 2 * NG) return false; u.pm = L >> 1; u.pn = L; return true; }
    __device__ __forceinline__ void a_ready(const Unit&) const {}
    __device__ __forceinline__ void done(const Unit&) const {}
};

struct EpiQKVU {
    static constexpr bool PERM = true, AFTER_DRAIN = false, MIDK = false;
    bf16_t* QKV; bf16_t* AALL;
    __device__ __forceinline__ void mid(f32x4 (&)[2][2][4][2], const Unit&, int, int) const {}
    __device__ __forceinline__ void operator()(const f32x4 (&acc)[2][2][4][2], const Unit& u, int wr, int wc, int fr, int fq) const {
        const int row0 = u.pm * BM + wr * 64 + fr;
#pragma unroll
        for (int bj = 0; bj < 2; ++bj) {
            const int ct = u.pn * BM + bj * HALF, cw = wc * 32 + 8 * fq;
            if (ct < 3072) {
                const int which = ct >> 10, head = (ct & 1023) >> 7;
                bf16_t* base = QKV + (size_t)(which * NH + head) * SEQ * HD + cw;
#pragma unroll
                for (int ai = 0; ai < 2; ++ai)
#pragma unroll
                    for (int m = 0; m < 4; ++m) { const int row = row0 + ai * HALF + m * 16; *(u32x4*)(base + (size_t)row * HD) = pack8(acc[ai][bj][m][0], acc[ai][bj][m][1]); }
            } else {
                const int cu = ct - 3072 + cw, g = cu >> 4, i0 = cu & 15;
#pragma unroll
                for (int ai = 0; ai < 2; ++ai)
#pragma unroll
                    for (int m = 0; m < 4; ++m) { const int row = row0 + ai * HALF + m * 16;
                        *(u32x4*)(AALL + ((size_t)(g * NCH + (row >> 5)) * KA + (row & 31) * GCH + i0)) = pack8(acc[ai][bj][m][0], acc[ai][bj][m][1]); }
            }
        }
    }
};

struct EpiCarry {
    static constexpr bool PERM = false, AFTER_DRAIN = true, MIDK = false;
    bf16_t* AALL; const float* P32;
    __device__ __forceinline__ void mid(f32x4 (&)[2][2][4][2], const Unit&, int, int) const {}
    __device__ __forceinline__ void operator()(const f32x4 (&)[2][2][4][2], const Unit&, int, int, int, int) const {}
    __device__ __forceinline__ void fused(f32x4 (&acc)[2][2][4][2], const Unit& u, int wr, int wc, int fr, int fq, PG8_LAS unsigned char* lds, int wid, int lane) const {
        PG8_LAS float* sS = (PG8_LAS float*)lds;
#pragma unroll
        for (int ai = 0; ai < 2; ++ai)
#pragma unroll
            for (int m = 0; m < 4; ++m) { const int r = ai * HALF + wr * 64 + m * 16 + fr;
#pragma unroll
                for (int n = 0; n < 2; ++n) *(PG8_LAS f32x4*)(sS + r * 128 + wc * 32 + 16 * n + 4 * fq) = acc[ai][0][m][n]; }
        asm volatile("s_waitcnt lgkmcnt(0)" ::: "memory"); __builtin_amdgcn_s_barrier(); asm volatile("" ::: "memory");
        if (wid == 0) {
            const int g = u.pm, p = lane;
            const float pr = P32[(g * NP + p) * 2], pi = P32[(g * NP + p) * 2 + 1];
            float xr = 0.f, xi = 0.f;
            bf16_t* dst = AALL + (size_t)g * NCH * KA + CL * GCH + p;
            for (int c = 0; c < NCH; ++c) {
                const unsigned w = cvt_pk_bf16(xr, xi);
                dst[(size_t)c * KA] = (bf16_t)(w & 0xffffu); dst[(size_t)c * KA + NP] = (bf16_t)(w >> 16);
                const float sr = sS[c * 128 + p], si = sS[c * 128 + NP + p];
                const float nr = pr * xr - pi * xi + sr, ni = pr * xi + pi * xr + si;
                xr = nr; xi = ni;
            }
        }
    }
};

struct EpiY {
    static constexpr bool PERM = true, AFTER_DRAIN = false, MIDK = false;
    bf16_t* YB;
    __device__ __forceinline__ void mid(f32x4 (&)[2][2][4][2], const Unit&, int, int) const {}
    __device__ __forceinline__ void operator()(const f32x4 (&acc)[2][2][4][2], const Unit& u, int wr, int wc, int fr, int fq) const {
        const int g = u.pm, j = u.pn & 1;
#pragma unroll
        for (int bj = 0; bj < 2; ++bj) { const int n0 = j * BM + bj * HALF + wc * 32 + 8 * fq, tl = n0 >> 4, h0 = n0 & 15;
#pragma unroll
            for (int ai = 0; ai < 2; ++ai)
#pragma unroll
                for (int m = 0; m < 4; ++m) { const int c = ai * HALF + wr * 64 + m * 16 + fr; const int t = CL * c + tl;
                    f32x4 a = acc[ai][bj][m][0], b = acc[ai][bj][m][1];
#pragma unroll
                    for (int e = 0; e < 4; ++e) { a[e] = gelu_tanh(a[e]); b[e] = gelu_tanh(b[e]); }
                    *(u32x4*)(YB + (size_t)t * SW + GCH * g + h0) = pack8(a, b); } }
    }
};

struct EpiGlu {
    static constexpr bool PERM = true, AFTER_DRAIN = false, MIDK = false;
    const bf16_t* YB; bf16_t* MIX; const float* bglu; float* SSQ;
    __device__ __forceinline__ void mid(f32x4 (&)[2][2][4][2], const Unit&, int, int) const {}
    __device__ __forceinline__ void operator()(const f32x4 (&acc)[2][2][4][2], const Unit& u, int wr, int wc, int fr, int fq) const {
        const int row0 = u.pm * BM + wr * 64 + fr;
        float ss[2][4];
#pragma unroll
        for (int ai = 0; ai < 2; ++ai)
#pragma unroll
            for (int m = 0; m < 4; ++m) ss[ai][m] = 0.f;
#pragma unroll
        for (int bj = 0; bj < 2; ++bj) { const int col0 = u.pn * BM + bj * HALF + wc * 32 + 8 * fq;
            const f32x4 b0 = *(const f32x4*)(bglu + col0), b1 = *(const f32x4*)(bglu + col0 + 4);
#pragma unroll
            for (int ai = 0; ai < 2; ++ai)
#pragma unroll
                for (int m = 0; m < 4; ++m) { const int row = row0 + ai * HALF + m * 16;
                    const u32x4 yw = *(const u32x4*)(YB + (size_t)row * SW + col0);
                    f32x4 ya = {bf_lo(yw.x), bf_hi(yw.x), bf_lo(yw.y), bf_hi(yw.y)}, yb = {bf_lo(yw.z), bf_hi(yw.z), bf_lo(yw.w), bf_hi(yw.w)};
                    const f32x4 za = acc[ai][bj][m][0] + b0, zb = acc[ai][bj][m][1] + b1;
                    float s = 0.f;
#pragma unroll
                    for (int e = 0; e < 4; ++e) { ya[e] *= fast_sigmoid(za[e]); yb[e] *= fast_sigmoid(zb[e]); s += ya[e] * ya[e] + yb[e] * yb[e]; }
                    ss[ai][m] += s;
                    *(u32x4*)(MIX + (size_t)row * DM + SW + col0) = pack8(ya, yb); } }
#pragma unroll
        for (int ai = 0; ai < 2; ++ai)
#pragma unroll
            for (int m = 0; m < 4; ++m) { float s = ss[ai][m]; s += __shfl_xor(s, 16); s += __shfl_xor(s, 32);
                if (fq == 0) SSQ[(size_t)(row0 + ai * HALF + m * 16) * 32 + 8 + u.pn * 4 + wc] = s; }
    }
};

struct EpiWout {
    static constexpr bool PERM = false, AFTER_DRAIN = false, MIDK = true;
    const PG8_LAS float* rtab;
    const float* X; const float* gt1; float* OUT;
    static __device__ __forceinline__ void rstds(const float* SSQ, int row, float& ra, float& rs) {
        const f32x4* p = (const f32x4*)(SSQ + (size_t)row * 32);
        const f32x4 a0 = p[0], a1 = p[1], s0 = p[2], s1 = p[3], s2 = p[4], s3 = p[5];
        const float sa = (a0[0] + a0[1]) + (a0[2] + a0[3]) + (a1[0] + a1[1]) + (a1[2] + a1[3]);
        const f32x4 st = (s0 + s1) + (s2 + s3); const float ssum = (st[0] + st[1]) + (st[2] + st[3]);
        ra = 1.0f / sqrtf(sa * (1.0f / AW) + EPS); rs = 1.0f / sqrtf(ssum * (1.0f / SW) + EPS);
    }
    __device__ __forceinline__ void mid(f32x4 (&acc)[2][2][4][2], const Unit& u, int wr, int fr) const {
#pragma unroll
        for (int ai = 0; ai < 2; ++ai)
#pragma unroll
            for (int m = 0; m < 4; ++m) { const float f = rtab[2 * (ai * HALF + wr * 64 + m * 16 + fr)];
#pragma unroll
                for (int bj = 0; bj < 2; ++bj)
#pragma unroll
                    for (int n = 0; n < 2; ++n) acc[ai][bj][m][n] *= f; }
    }
    __device__ __forceinline__ void operator()(const f32x4 (&acc)[2][2][4][2], const Unit& u, int wr, int wc, int fr, int fq) const {
        const int col0 = u.pn * BM + wc * 32 + 4 * fq;
        f32x4 gv[2][2];
#pragma unroll
        for (int bj = 0; bj < 2; ++bj)
#pragma unroll
            for (int n = 0; n < 2; ++n) gv[bj][n] = *(const f32x4*)(gt1 + col0 + bj * HALF + n * 16);
#pragma unroll
        for (int ai = 0; ai < 2; ++ai)
#pragma unroll
            for (int m = 0; m < 4; ++m) { const int rl = ai * HALF + wr * 64 + m * 16 + fr, row = u.pm * BM + rl; const float rs = rtab[2 * rl + 1];
                const size_t off = (size_t)row * DM + col0;
#pragma unroll
                for (int bj = 0; bj < 2; ++bj)
#pragma unroll
                    for (int n = 0; n < 2; ++n) { const f32x4 xv = *(const f32x4*)(X + off + bj * HALF + n * 16);
                        *(f32x4*)(OUT + off + bj * HALF + n * 16) = xv + gv[bj][n] * (acc[ai][bj][m][n] * rs); } }
    }
};

struct EpiUp {
    static constexpr bool PERM = true, AFTER_DRAIN = false, MIDK = false;
    bf16_t* ABUF; bf16_t* BBUF;
    __device__ __forceinline__ void mid(f32x4 (&)[2][2][4][2], const Unit&, int, int) const {}
    __device__ __forceinline__ void operator()(const f32x4 (&acc)[2][2][4][2], const Unit& u, int wr, int wc, int fr, int fq) const {
        const int row0 = u.pm * BM + wr * 64 + fr, col0 = u.pn * HALF + wc * 32 + 8 * fq;
#pragma unroll
        for (int bj = 0; bj < 2; ++bj) { bf16_t* base = (bj == 0 ? ABUF : BBUF) + col0;
#pragma unroll
            for (int ai = 0; ai < 2; ++ai)
#pragma unroll
                for (int m = 0; m < 4; ++m) { const int row = row0 + ai * HALF + m * 16; *(u32x4*)(base + (size_t)row * DFF) = pack8(acc[ai][bj][m][0], acc[ai][bj][m][1]); } }
    }
};

struct EpiDown {
    static constexpr bool PERM = false, AFTER_DRAIN = false, MIDK = false;
    const float* gt2; float* OUT; float* SSQ2;
    __device__ __forceinline__ void mid(f32x4 (&)[2][2][4][2], const Unit&, int, int) const {}
    __device__ __forceinline__ void operator()(const f32x4 (&acc)[2][2][4][2], const Unit& u, int wr, int wc, int fr, int fq) const {
        const int col0 = u.pn * BM + wc * 32 + 4 * fq;
        f32x4 gv[2][2];
#pragma unroll
        for (int bj = 0; bj < 2; ++bj)
#pragma unroll
            for (int n = 0; n < 2; ++n) gv[bj][n] = *(const f32x4*)(gt2 + col0 + bj * HALF + n * 16);
#pragma unroll
        for (int ai = 0; ai < 2; ++ai)
#pragma unroll
            for (int m = 0; m < 4; ++m) { const int row = u.pm * BM + ai * HALF + wr * 64 + m * 16 + fr; const size_t off = (size_t)row * DM + col0; float s = 0.f;
#pragma unroll
                for (int bj = 0; bj < 2; ++bj)
#pragma unroll
                    for (int n = 0; n < 2; ++n) { const f32x4 hv = *(const f32x4*)(OUT + off + bj * HALF + n * 16);
                        const f32x4 o = hv + gv[bj][n] * acc[ai][bj][m][n]; s += (o[0] * o[0] + o[1] * o[1]) + (o[2] * o[2] + o[3] * o[3]);
                        *(f32x4*)(OUT + off + bj * HALF + n * 16) = o; }
                s += __shfl_xor(s, 16); s += __shfl_xor(s, 32);
                if (fq == 0) SSQ2[(size_t)row * 32 + u.pn * 4 + wc] = s; }
    }
};
}
#include <hip/hip_bf16.h>
namespace att {
#define BIAS_LAS __attribute__((address_space(3)))
using bf16 = __hip_bfloat16;
typedef short bf16x8 __attribute__((ext_vector_type(8)));
typedef short s16x4 __attribute__((ext_vector_type(4)));
typedef float f32x16 __attribute__((ext_vector_type(16)));
typedef float f32x4 __attribute__((ext_vector_type(4)));
typedef unsigned u32x4 __attribute__((ext_vector_type(4)));
template <class A, class Bt> struct same_t { static constexpr bool v = false; };
template <class A> struct same_t<A, A> { static constexpr bool v = true; };
constexpr int D = 128, LDO = 2048;
constexpr float SCALE = 0.08838834764831845f;
constexpr float THR = 8.f;
constexpr bool WSKIP = false;
constexpr bool SEAM_PREFETCH = false;
constexpr int NW = 8, QBLK = 32, KVBLK = 64, QB = NW * QBLK;
constexpr int SHM_V = KVBLK * D * 2, SHM_K = KVBLK * D * 2;
constexpr int ATT_LDS = 2 * SHM_V + 2 * SHM_K + NW * 64 * 4;
constexpr int BIAS_OFF = 69632;
#define KSWZ(row, colB) ((row) * 256 + ((colB) ^ (((row) & 7) << 4)))
#define SBAR() __builtin_amdgcn_sched_barrier(0)
__device__ __forceinline__ int v_st(int k, int c) { const int kk = (k & ~0xC) | ((k & 4) << 1) | ((k & 8) >> 1); return ((kk >> 3) * 4 + (c >> 5)) * 512 + ((kk & 7) * 32 + (c & 31)) * 2; }
__device__ __forceinline__ int v_rd_base(int lane) { return ((lane & 3) << 3) | (((lane >> 2) & 3) << 6) | (((lane >> 4) & 1) << 5) | (((lane >> 5) & 1) << 8); }
constexpr int v_rd_off(int d0, int ks, int half) { return d0 * 512 + ks * 4096 + half * 2048; }
__device__ __forceinline__ int crow(int r, int hi) { return (r & 3) + 8 * (r >> 2) + 4 * hi; }
__device__ __forceinline__ unsigned cvtpk(float lo, float hi) {
    unsigned r; asm volatile("v_cvt_pk_bf16_f32 %0, %1, %2" : "=v"(r) : "v"(lo), "v"(hi)); return r;
}
__device__ __forceinline__ bf16x8 pack8(f32x4 a, f32x4 b) {
    u32x4 w = {cvtpk(a[0], a[1]), cvtpk(a[2], a[3]), cvtpk(b[0], b[1]), cvtpk(b[2], b[3])};
    return *reinterpret_cast<bf16x8*>(&w);
}
template <class T> __device__ __forceinline__ bf16x8 load8(const T* p) {
    if constexpr (same_t<T, float>::v) { return pack8(*(const f32x4*)p, *(const f32x4*)(p + 4)); }
    else { return *reinterpret_cast<const bf16x8*>(p); }
}
__device__ __forceinline__ void mask_tile(f32x16& p0, f32x16& p1, int dq, unsigned W) {
    const float NEG = -__builtin_inff();
#pragma unroll
    for (int r = 0; r < 16; ++r) {
        const int c = (r & 3) + 8 * (r >> 2);
        if ((unsigned)(dq - c) >= W) p0[r] = NEG;
        if ((unsigned)(dq - c - 32) >= W) p1[r] = NEG;
    }
}
__device__ __forceinline__ void partialSM(f32x16& p0, f32x16& p1, float& m_reg, float& mn, float& alpha) {
    float pmax = p0[0]; for (int r = 1; r < 16; ++r) pmax = fmaxf(pmax, p0[r]); for (int r = 0; r < 16; ++r) pmax = fmaxf(pmax, p1[r]);
    { auto rr = __builtin_amdgcn_permlane32_swap(__float_as_uint(pmax), __float_as_uint(pmax), false, false);
      pmax = fmaxf(__uint_as_float(rr[0]), __uint_as_float(rr[1])); }
    constexpr float C2 = 1.4426950408889634f * SCALE;
    if (__builtin_expect(__all((pmax - m_reg) * SCALE <= THR), 1)) { mn = m_reg; alpha = 1.f; }
    else { mn = fmaxf(m_reg, pmax); alpha = __builtin_amdgcn_exp2f((m_reg - mn) * C2); m_reg = mn; }
    const float mnL = -mn * C2;
    for (int r = 0; r < 16; ++r) p0[r] = fmaf(p0[r], C2, mnL); for (int r = 0; r < 16; ++r) p1[r] = fmaf(p1[r], C2, mnL);
    for (int r = 0; r < 16; ++r) p0[r] = __builtin_amdgcn_exp2f(p0[r]);
}
__device__ __forceinline__ void finishSM(f32x16& p0, f32x16& p1, float alpha, float& l_reg, bf16x8& pa0, bf16x8& pa1, bf16x8& pa2, bf16x8& pa3) {
    for (int r = 0; r < 16; ++r) p1[r] = __builtin_amdgcn_exp2f(p1[r]);
    float ps = 0; for (int r = 0; r < 16; ++r) ps += p0[r]; for (int r = 0; r < 16; ++r) ps += p1[r];
    { auto rr = __builtin_amdgcn_permlane32_swap(__float_as_uint(ps), __float_as_uint(ps), false, false);
      ps = __uint_as_float(rr[0]) + __uint_as_float(rr[1]); }
    l_reg = l_reg * alpha + ps;
#define PK4(P, B_, OUT) do { unsigned a0 = cvtpk(P[B_+0], P[B_+1]), a1 = cvtpk(P[B_+2], P[B_+3]);                          \
        unsigned b0 = cvtpk(P[B_+4], P[B_+5]), b1 = cvtpk(P[B_+6], P[B_+7]);                                             \
        auto r0 = __builtin_amdgcn_permlane32_swap(a0, b0, false, false); auto r1 = __builtin_amdgcn_permlane32_swap(a1, b1, false, false); \
        u32x4 w = {r0[0], r1[0], r0[1], r1[1]}; OUT = *reinterpret_cast<bf16x8*>(&w); } while (0)
    PK4(p0, 0, pa0); PK4(p0, 8, pa1); PK4(p1, 0, pa2); PK4(p1, 8, pa3);
#undef PK4
}
template <int KB, bool SK>
__device__ __forceinline__ void qkt(f32x16& p0, f32x16& p1, const char* K_lds, int r32, int hi, const bf16x8* qr, bool act, const BIAS_LAS float* bp) {
    if (SK && !act) { const float NEG = -__builtin_inff();
#pragma unroll
        for (int r = 0; r < 16; ++r) { p0[r] = NEG; p1[r] = NEG; } return; }
#ifdef NOBIAS
    p0 = f32x16{}; p1 = f32x16{};
#else
    { const BIAS_LAS f32x4* b4 = (const BIAS_LAS f32x4*)bp;
      const f32x4 t0 = b4[0], t1 = b4[2], t2 = b4[4], t3 = b4[6], t4 = b4[8], t5 = b4[10], t6 = b4[12], t7 = b4[14];
      p0 = f32x16{t0[0], t0[1], t0[2], t0[3], t1[0], t1[1], t1[2], t1[3], t2[0], t2[1], t2[2], t2[3], t3[0], t3[1], t3[2], t3[3]};
      p1 = f32x16{t4[0], t4[1], t4[2], t4[3], t5[0], t5[1], t5[2], t5[3], t6[0], t6[1], t6[2], t6[3], t7[0], t7[1], t7[2], t7[3]}; }
#endif
    const char* kb[4];
#pragma unroll
    for (int dd = 0; dd < 4; ++dd) kb[dd] = K_lds + KB * SHM_K + KSWZ(r32, (dd * 16 + hi * 8) * 2);
#pragma unroll
    for (int d0 = 0; d0 < 8; ++d0) { const char* a = kb[d0 & 3] + (d0 >> 2) * 128;
        bf16x8 b0 = *reinterpret_cast<const bf16x8*>(a);
        bf16x8 b1 = *reinterpret_cast<const bf16x8*>(a + 32 * 256);
        p0 = __builtin_amdgcn_mfma_f32_32x32x16_bf16(b0, qr[d0], p0, 0, 0, 0);
        p1 = __builtin_amdgcn_mfma_f32_32x32x16_bf16(b1, qr[d0], p1, 0, 0, 0); }
}
template <int VB, bool SK>
__device__ __forceinline__ void pv_tile(f32x16* o, int vb0, bf16x8 pa0, bf16x8 pa1, bf16x8 pa2, bf16x8 pa3, bool act) {
    if (SK && !act) return;
#define TRRD(dst, off) asm volatile("ds_read_b64_tr_b16 %0, %1 offset:%2" : "=&v"(dst) : "v"(vb0), "i"(off) : "memory")
#define PV_D0(d0) do { s16x4 l0, l1, l2, l3, h0, h1, h2, h3; constexpr int b_ = VB * SHM_V + v_rd_off(d0, 0, 0);     \
        TRRD(l0, b_); TRRD(h0, b_ + 2048); TRRD(l1, b_ + 4096); TRRD(h1, b_ + 6144); TRRD(l2, b_ + 8192); TRRD(h2, b_ + 10240); TRRD(l3, b_ + 12288); TRRD(h3, b_ + 14336); \
        asm volatile("s_waitcnt lgkmcnt(0)" ::: "memory"); SBAR();                 \
        o[d0] = __builtin_amdgcn_mfma_f32_32x32x16_bf16(pa0, (bf16x8){l0[0], l0[1], l0[2], l0[3], h0[0], h0[1], h0[2], h0[3]}, o[d0], 0, 0, 0);   \
        o[d0] = __builtin_amdgcn_mfma_f32_32x32x16_bf16(pa1, (bf16x8){l1[0], l1[1], l1[2], l1[3], h1[0], h1[1], h1[2], h1[3]}, o[d0], 0, 0, 0);   \
        o[d0] = __builtin_amdgcn_mfma_f32_32x32x16_bf16(pa2, (bf16x8){l2[0], l2[1], l2[2], l2[3], h2[0], h2[1], h2[2], h2[3]}, o[d0], 0, 0, 0);   \
        o[d0] = __builtin_amdgcn_mfma_f32_32x32x16_bf16(pa3, (bf16x8){l3[0], l3[1], l3[2], l3[3], h3[0], h3[1], h3[2], h3[3]}, o[d0], 0, 0, 0); } while (0)
    PV_D0(0); PV_D0(1); PV_D0(2); PV_D0(3);
#undef PV_D0
#undef TRRD
}
template <class TIn, class TOut> struct BlockRef { const TIn* Q; const TIn* K; const TIn* V; TOut* O; int P0; int JLO; float* SSQ; };
template <class TIn> struct Seam {
    bf16x8 qr[8];
    bf16x8 st_v0, st_v1, st_k0, st_k1; f32x4 sf0, sf1, sf2, sf3;
    f32x4 tq[16];
};
#define ROW(p, k0, rr) ((p) + (size_t)((k0) + (rr)) * D + sc)
#define VMW() asm volatile("s_waitcnt vmcnt(0)" ::: "memory")
#define VMWN(n) asm volatile("s_waitcnt vmcnt(%0)" :: "i"(n) : "memory")
#define SLOAD_H(Kp, Vp, k0) do { S.st_v0 = load8<TIn>(ROW(Vp, k0, sr)); S.st_v1 = load8<TIn>(ROW(Vp, k0, 32 + sr));              \
                         S.st_k0 = load8<TIn>(ROW(Kp, k0, sr)); S.st_k1 = load8<TIn>(ROW(Kp, k0, 32 + sr)); } while (0)
#define SWRITE_HK(bf) do { *(bf16x8*)(K_lds + (bf) * SHM_K + kws) = S.st_k0; *(bf16x8*)(K_lds + (bf) * SHM_K + kws + 32 * 256) = S.st_k1; } while (0)
#define SWRITE_HV(bf) do { *(bf16x8*)(V_lds + (bf) * SHM_V + vst0) = S.st_v0; *(bf16x8*)(V_lds + (bf) * SHM_V + vst1) = S.st_v1; } while (0)
#define SWRITE_H(bf) do { SWRITE_HV(bf); SWRITE_HK(bf); } while (0)
#define SLOAD_F(p, k0) do { S.sf0 = *(const f32x4*)ROW(p, k0, sr); S.sf1 = *(const f32x4*)(ROW(p, k0, sr) + 4);                \
                            S.sf2 = *(const f32x4*)ROW(p, k0, 32 + sr); S.sf3 = *(const f32x4*)(ROW(p, k0, 32 + sr) + 4); } while (0)
#define SWRITE_KF(bf) do { *(bf16x8*)(K_lds + (bf) * SHM_K + kws) = pack8(S.sf0, S.sf1); *(bf16x8*)(K_lds + (bf) * SHM_K + kws + 32 * 256) = pack8(S.sf2, S.sf3); } while (0)
#define SWRITE_VF(bf) do { *(bf16x8*)(V_lds + (bf) * SHM_V + vst0) = pack8(S.sf0, S.sf1); *(bf16x8*)(V_lds + (bf) * SHM_V + vst1) = pack8(S.sf2, S.sf3); } while (0)
template <class TIn, class TOut>
__device__ __forceinline__ void causal_swa_prime(const BlockRef<TIn, TOut>& cur, int W, char* lds, Seam<TIn>& S, const int wv) {
    constexpr bool F32 = same_t<TIn, float>::v;
    int tid_ = wv * 64 + ((int)__builtin_amdgcn_mbcnt_hi(~0u, __builtin_amdgcn_mbcnt_lo(~0u, 0u))); asm volatile("" : "+v"(tid_));
    const int tid = tid_, wid = __builtin_amdgcn_readfirstlane(tid >> 6), lane = tid & 63, r32 = lane & 31, hi = lane >> 5;
    const int sr = tid >> 4, sc = (tid & 15) * 8, kws = KSWZ(sr, sc * 2); char* K_lds = lds + 2 * SHM_V;
    const int kb0 = cur.JLO * KVBLK;
    for (int d0 = 0; d0 < 8; ++d0) S.qr[d0] = load8<TIn>(cur.Q + (size_t)(wid * QBLK + r32) * D + d0 * 16 + hi * 8);
    if constexpr (F32) { SLOAD_F((const float*)cur.K, kb0); VMW(); SWRITE_KF(0); SBAR(); SLOAD_F((const float*)cur.V, kb0); }
    else { SLOAD_H(cur.K, cur.V, kb0); VMW(); SWRITE_HK(0); }
    __syncthreads();
}
template <class TIn, class TOut>
__device__ __forceinline__ void causal_swa_block(const BlockRef<TIn, TOut>& cur, const BlockRef<TIn, TOut>& nxt, int skv, int W, char* lds, Seam<TIn>& S, const BIAS_LAS float* bias, const int wv) {
    constexpr bool F32 = same_t<TIn, float>::v;
    int tid_ = wv * 64 + ((int)__builtin_amdgcn_mbcnt_hi(~0u, __builtin_amdgcn_mbcnt_lo(~0u, 0u))); asm volatile("" : "+v"(tid_));
    const int tid = tid_, wid = __builtin_amdgcn_readfirstlane(tid >> 6), lane = tid & 63, r32 = lane & 31, hi = lane >> 5;
    const int j_lo = cur.JLO; const BIAS_LAS float* bias4 = bias + 4 * hi;
    int j_hi = (cur.P0 + QB - 1) / KVBLK + 1; if (j_hi > skv / KVBLK) j_hi = skv / KVBLK;
    const int NT = j_hi - j_lo;
    const int kbn = nxt.JLO * KVBLK;
    const int qlo = cur.P0 + wid * QBLK, qm = qlo + r32 - 4 * hi;
    char* V_lds = lds; char* K_lds = lds + 2 * SHM_V;
    float* ws = (float*)(lds + 2 * SHM_V + 2 * SHM_K) + wid * 64; float* li_l = ws, * al_l = ws + 32;
    float m_reg = -1e30f, l_reg = 0; f32x16 o[4] = {};
    const int sr = tid >> 4, sc = (tid & 15) * 8, vst0 = v_st(sr, sc), vst1 = v_st(32 + sr, sc), kws = KSWZ(sr, sc * 2);
    const int vb0 = (int)(uintptr_t)V_lds + v_rd_base(lane);
    const TIn* Kh = cur.K; const TIn* Vh = cur.V;
#define RESC(a) do { if (__any((a) < 1.f)) { if (hi == 0) al_l[r32] = (a); asm volatile("s_waitcnt lgkmcnt(0)" ::: "memory");              \
                     for (int d_ = 0; d_ < 4; ++d_) for (int r = 0; r < 16; ++r) o[d_][r] *= al_l[crow(r, hi)]; } } while (0)
#define KBASE(t) ((j_lo + (t)) * KVBLK)
#define BP(t) (bias4 + (t) * KVBLK)
#define ACT(t) (KBASE(t) <= qlo + QBLK - 1 && KBASE(t) + KVBLK - 1 >= qlo - W + 1)
#define MASKT(P0_, P1_, t) do { const int kb_ = KBASE(t); if ((!SK || ACT(t)) && (kb_ + KVBLK - 1 > qlo || kb_ <= qlo + QBLK - 1 - W)) mask_tile(P0_, P1_, qm - kb_, (unsigned)W); } while (0)
    constexpr int NQL = F32 ? 16 : 8;
    constexpr bool SK = WSKIP && !F32;
#define SEAM_K0() do { VMWN(NQL); if constexpr (F32) { SWRITE_KF(0); SBAR(); SLOAD_F((const float*)nxt.V, kbn); } else { SWRITE_HK(0); } SBAR(); } while (0)
    f32x16 pA0, pA1, pB0, pB1; float mnA, mnB, alA, alB; bf16x8 pa0, pa1, pa2, pa3;
    if constexpr (F32) { VMW(); SWRITE_VF(0); SBAR(); } else { SWRITE_HV(0); SBAR(); }
    if (NT > 1) { if constexpr (F32) SLOAD_F((const float*)Kh, KBASE(1)); else SLOAD_H(Kh, Vh, KBASE(1)); }
    SBAR(); qkt<0, SK>(pA0, pA1, K_lds, r32, hi, S.qr, ACT(0), BP(0));
    if constexpr (F32) { if (NT > 1) { VMW(); SWRITE_KF(1); SBAR(); SLOAD_F((const float*)Vh, KBASE(1)); } }
    MASKT(pA0, pA1, 0); partialSM(pA0, pA1, m_reg, mnA, alA);
    if (NT > 1) { VMW(); if constexpr (F32) { SWRITE_VF(1); SBAR(); if (NT > 2) SLOAD_F((const float*)Kh, KBASE(2)); } else SWRITE_H(1); }
    __syncthreads();
#define HALF_STEP(PX0, PX1, mnX, alX, PY0, PY1, alY, t, KB, VB, SB) do {                                                      \
        SBAR(); qkt<KB, SK>(PX0, PX1, K_lds, r32, hi, S.qr, ACT(t), BP(t));                                             \
        finishSM(PY0, PY1, alY, l_reg, pa0, pa1, pa2, pa3); SBAR();                                                           \
        if ((t) + 1 < NT) { if constexpr (F32) { VMW(); SWRITE_KF(SB); SBAR(); SLOAD_F((const float*)Vh, KBASE((t) + 1)); }  \
                            else { SLOAD_H(Kh, Vh, KBASE((t) + 1)); } SBAR(); }                                               \
        pv_tile<VB, SK>(o, vb0, pa0, pa1, pa2, pa3, ACT((t) - 1)); MASKT(PX0, PX1, (t)); partialSM(PX0, PX1, m_reg, mnX, alX);                                        \
        __syncthreads();                                                                                                      \
        if ((t) + 1 < NT) { VMW(); if constexpr (F32) { SWRITE_VF(SB); SBAR(); if ((t) + 2 < NT) SLOAD_F((const float*)Kh, KBASE((t) + 2)); } \
                            else { SWRITE_H(SB); } }                                                                          \
        RESC(alX); __syncthreads(); } while (0)
    for (int t = 1; t + 1 < NT; t += 2) {
        HALF_STEP(pB0, pB1, mnB, alB, pA0, pA1, alA, t, 1, 0, 0);
        HALF_STEP(pA0, pA1, mnA, alA, pB0, pB1, alB, t + 1, 0, 1, 1);
    }
    const bool even = (NT & 1) == 0;
    if (even) { SBAR(); qkt<1, SK>(pB0, pB1, K_lds, r32, hi, S.qr, ACT(NT - 1), BP(NT - 1)); SBAR(); }
#define QROW(e) (nxt.Q + (size_t)(wid * QBLK + r32) * D + ((e) >> 1) * 16 + hi * 8 + ((e) & 1) * 4)
    if constexpr (F32) { SLOAD_F((const float*)nxt.K, kbn); SBAR();
#pragma unroll
        for (int e = 0; e < 8; ++e) S.tq[e] = *(const f32x4*)QROW(e); }
    else if constexpr (SEAM_PREFETCH) { SLOAD_H(nxt.K, nxt.V, kbn); SBAR();
#pragma unroll
        for (int d0 = 0; d0 < 8; ++d0) S.qr[d0] = load8<TIn>(nxt.Q + (size_t)(wid * QBLK + r32) * D + d0 * 16 + hi * 8); }
    SBAR();
    finishSM(pA0, pA1, alA, l_reg, pa0, pa1, pa2, pa3); SBAR();
    if constexpr (F32) {
#pragma unroll
        for (int e = 8; e < 16; ++e) S.tq[e] = *(const f32x4*)QROW(e); SBAR(); }
#undef QROW
    pv_tile<0, SK>(o, vb0, pa0, pa1, pa2, pa3, ACT(even ? NT - 2 : NT - 1));
    if (even) { MASKT(pB0, pB1, NT - 1); partialSM(pB0, pB1, m_reg, mnB, alB); __syncthreads(); RESC(alB);
        finishSM(pB0, pB1, alB, l_reg, pa0, pa1, pa2, pa3); SBAR(); pv_tile<1, SK>(o, vb0, pa0, pa1, pa2, pa3, ACT(NT - 1)); }
    SBAR(); if constexpr (SEAM_PREFETCH) SEAM_K0();
    if (hi == 0) li_l[r32] = l_reg; asm volatile("s_waitcnt lgkmcnt(0)" ::: "memory");
    float rli[16];
#pragma unroll
    for (int r = 0; r < 16; ++r) rli[r] = __builtin_amdgcn_rcpf(li_l[crow(r, hi)]);
    TOut* Ow = cur.O + (size_t)(wid * QBLK) * LDO;
#pragma unroll
    for (int r = 0; r < 16; ++r) { int orow = crow(r, hi); asm volatile("" : "+v"(orow)); float sq = 0.f;
#pragma unroll
        for (int d0 = 0; d0 < 4; ++d0) { const float v = o[d0][r] * rli[r]; sq += v * v;
            { const float vn = __shfl_xor(v, 1);
                   if ((r32 & 1) == 0) *(unsigned*)(Ow + (size_t)orow * LDO + d0 * 32 + r32) = cvtpk(v, vn); } }
        sq += __shfl_xor(sq, 1); sq += __shfl_xor(sq, 2); sq += __shfl_xor(sq, 4); sq += __shfl_xor(sq, 8); sq += __shfl_xor(sq, 16);
        if (r32 == 0) cur.SSQ[(size_t)(wid * QBLK + orow) * 32] = sq; }
    if constexpr (F32) {
#pragma unroll
        for (int d0 = 0; d0 < 8; ++d0) S.qr[d0] = pack8(S.tq[2 * d0], S.tq[2 * d0 + 1]); }
    __syncthreads();
#undef RESC
#undef KBASE
#undef BP
#undef ACT
#undef MASKT
#undef SEAM_K0
#undef HALF_STEP
}
#undef ROW
#undef VMW
#undef VMWN
#undef SLOAD_H
#undef SWRITE_HK
#undef SWRITE_HV
#undef SWRITE_H
#undef SLOAD_F
#undef SWRITE_KF
#undef SWRITE_VF
}
#define LAS __attribute__((address_space(3)))
typedef unsigned short bf16_t;
struct Args { const float* in[26]; float* out; unsigned char* ws; };

#define XB_TMO      128
#define XB_XCNT(j)  (256  + 64 * (j))
#define XB_XSUB(j)  (1280 + 64 * (j))
#define XB_XGEN(j)  (2304 + 64 * (j))
#define XB_TOP      3328
#define XB_TOPGEN   3392
#define XCD_BAR_WORDS 3456
#define XB_SPIN_CAP (1u << 18)

__device__ __forceinline__ unsigned xb_ld(unsigned* p)              { return __hip_atomic_load(p, __ATOMIC_RELAXED, __HIP_MEMORY_SCOPE_AGENT); }
__device__ __forceinline__ unsigned xb_add(unsigned* p, unsigned v) { return __hip_atomic_fetch_add(p, v, __ATOMIC_RELAXED, __HIP_MEMORY_SCOPE_AGENT); }
__device__ __forceinline__ unsigned xb_xcc_id() { return (unsigned)__builtin_amdgcn_s_getreg((3 << 11) | 20) & 0xFu; }
#define XB_SPIN(cond, bar) do { unsigned _sp = 0; while (cond) { __builtin_amdgcn_s_sleep(1); \
    if ((++_sp & 255u) == 0u) { if (xb_ld(&(bar)[XB_TMO])) break; if (_sp > XB_SPIN_CAP) { atomicAdd(&(bar)[XB_TMO], 1u); break; } } } } while (0)

struct XcdBarrier {
    unsigned* bar; unsigned x;
    volatile LAS unsigned* st;
};

__device__ __forceinline__ XcdBarrier xcd_barrier_post(unsigned* bar, volatile LAS unsigned* st, bool t0) {
    XcdBarrier b; b.bar = bar; b.x = xb_xcc_id(); b.st = st;
    if (t0) (void)xb_add(&bar[XB_XCNT(b.x)], 1u);
    return b;
}
__device__ __forceinline__ void xcd_barrier_complete(unsigned* bar, unsigned x, unsigned& nloc, unsigned& nx) {
    const unsigned G = gridDim.x * gridDim.y * gridDim.z;
    unsigned sum, cnt, mine, sp = 0u;
    for (;;) {
        sum = 0u; cnt = 0u; mine = 0u;
#pragma unroll
        for (unsigned j = 0; j < 16; ++j) { const unsigned c = xb_ld(&bar[XB_XCNT(j)]); sum += c; cnt += (c > 0u) ? 1u : 0u; mine = (j == x) ? c : mine; }
        if (sum == G) break;
        __builtin_amdgcn_s_sleep(1);
        if ((++sp & 255u) == 0u) { if (xb_ld(&bar[XB_TMO])) break; if (sp > XB_SPIN_CAP) { atomicAdd(&bar[XB_TMO], 1u); break; } }
    }
    nloc = mine > 0u ? mine : 1u; nx = cnt > 0u ? cnt : 1u;
}

__device__ __forceinline__ void xcd_barrier(const XcdBarrier& b, bool t0) {
    asm volatile("s_waitcnt vmcnt(0)" ::: "memory");
    __syncthreads();
    if (t0) {
        unsigned* bar = b.bar;
        __builtin_amdgcn_s_waitcnt(0);
        unsigned nloc = b.st[0], nx = b.st[1];
        if (nloc == 0u) { xcd_barrier_complete(bar, b.x, nloc, nx); b.st[0] = nloc; b.st[1] = nx; }
        const unsigned old = xb_add(&bar[XB_XSUB(b.x)], 1u);
        const unsigned gen = old / nloc;
        if (old + 1u == (gen + 1u) * nloc) {
            __builtin_amdgcn_fence(__ATOMIC_RELEASE, "agent");
            asm volatile("s_waitcnt vmcnt(0)" ::: "memory");
            const unsigned og = xb_add(&bar[XB_TOP], 1u);
            const unsigned tg = og / nx;
            if (og + 1u == (tg + 1u) * nx) xb_add(&bar[XB_TOPGEN], 1u);
            else XB_SPIN(xb_ld(&bar[XB_TOPGEN]) == tg, bar);
            __builtin_amdgcn_fence(__ATOMIC_ACQUIRE, "agent");
            xb_add(&bar[XB_XGEN(b.x)], 1u);
            asm volatile("s_waitcnt vmcnt(0)" ::: "memory");
        } else {
            XB_SPIN(xb_ld(&bar[XB_XGEN(b.x)]) == gen, bar);
            __builtin_amdgcn_fence(__ATOMIC_ACQUIRE, "agent");
            asm volatile("s_waitcnt vmcnt(0)" ::: "memory");
        }
    }
    __syncthreads();
}

__device__ __forceinline__ float wave_sum(float v) {
#pragma unroll
    for (int o = 1; o < 64; o <<= 1) v += __shfl_xor(v, o);
    return v;
}
__device__ __forceinline__ unsigned pk2(float lo, float hi) { return pg8::cvt_pk_bf16(lo, hi); }

__device__ __forceinline__ void tr_item(const float* __restrict__ W, int ldw, int srccol0, int k0, bf16_t* __restrict__ WT, int K, int dstrow0,
                                        const float* rs0, const float* rs1, LAS float* scr, int lane) {
#pragma unroll 8
    for (int i = 0; i < 32; ++i) { const int kk = 2 * i + (lane >> 5); float v = W[(size_t)(k0 + kk) * ldw + srccol0 + (lane & 31)];
        if (rs0) { const int k = k0 + kk; v *= (k < 1024 ? rs0[k] : rs1[k - 1024]); }
        scr[kk * 33 + (lane & 31)] = v; }
    asm volatile("s_waitcnt lgkmcnt(0)" ::: "memory");
    const int c = lane & 7;
#pragma unroll
    for (int j = 0; j < 4; ++j) { const int n = (lane >> 3) + 8 * j; const LAS float* s = scr + (8 * c) * 33 + n;
        u32x4_t o; o.x = pk2(s[0 * 33], s[1 * 33]); o.y = pk2(s[2 * 33], s[3 * 33]); o.z = pk2(s[4 * 33], s[5 * 33]); o.w = pk2(s[6 * 33], s[7 * 33]);
        *(u32x4_t*)(WT + (size_t)(dstrow0 + n) * K + k0 + 8 * c) = o; }
    asm volatile("s_waitcnt lgkmcnt(0)" ::: "memory");
}

__device__ __forceinline__ void ssm_setup_item(const Args& a, unsigned char* ws, LAS unsigned char* lds, int g, int qtr, int tid) {
    LAS float* Bre = (LAS float*)lds; LAS float* Bim = Bre + 1024; LAS float* Cre = Bre + 2048; LAS float* Cim = Bre + 3072;
    LAS float* Pr = Bre + 4096; LAS float* Pi = Pr + 33 * 64; LAS float* MZr = Pi + 33 * 64; LAS float* MZi = MZr + 32 * 64; LAS float* KT = MZi + 32 * 64;
    const float* b_re = a.in[10] + (size_t)g * 1024; const float* b_im = a.in[11] + (size_t)g * 1024;
    const float* c_re = a.in[12] + (size_t)g * 1024; const float* c_im = a.in[13] + (size_t)g * 1024;
    for (int i = tid; i < 1024; i += 512) { Bre[i] = b_re[i]; Bim[i] = b_im[i]; Cre[i] = c_re[i]; Cim[i] = c_im[i]; }
    if (tid < 64) {
        const int p = tid; const float dt = expf(a.in[9][g]); const float ar = a.in[7][g * NP + p], ai = a.in[8][g * NP + p];
        const float mag = expf(dt * ar); const float abr = mag * cosf(dt * ai), abi = mag * sinf(dt * ai);
        const float nre = abr - 1.f, nim = abi, den = ar * ar + ai * ai;
        const float zr = (nre * ar + nim * ai) / den, zi = (nim * ar - nre * ai) / den;
        float pr = 1.f, pi = 0.f;
        for (int j = 0; j <= 32; ++j) {
            Pr[j * 64 + p] = pr; Pi[j * 64 + p] = pi;
            if (j < 32) { MZr[j * 64 + p] = pr * zr - pi * zi; MZi[j * 64 + p] = pr * zi + pi * zr; }
            const float nr = pr * abr - pi * abi, ni = pr * abi + pi * abr; pr = nr; pi = ni;
        }
        if (qtr == 0) { float* P32 = (float*)(ws + WS_P32); P32[(g * NP + p) * 2] = Pr[32 * 64 + p]; P32[(g * NP + p) * 2 + 1] = Pi[32 * 64 + p]; }
    }
    __syncthreads();
    const float* dsk = a.in[14] + g * GCH;
    for (int idx = tid; idx < 8192; idx += 512) {
        const int j = idx >> 8, h = (idx >> 4) & 15, i = idx & 15; float sum = 0.f;
        for (int p = 0; p < 64; ++p) { const float mr = MZr[j * 64 + p], mi = MZi[j * 64 + p], br = Bre[p * 16 + i], bi = Bim[p * 16 + i];
            const float bzr = mr * br - mi * bi, bzi = mr * bi + mi * br; sum += Cre[h * 64 + p] * bzr - Cim[h * 64 + p] * bzi; }
        if (j == 0 && h == i) sum += dsk[h];
        KT[idx] = sum;
    }
    __syncthreads();
    bf16_t* GC = (bf16_t*)(ws + WS_GC) + (size_t)g * 512 * KA;
    for (int ci = tid; ci < 128 * 80; ci += 512) {
        const int nl = ci / 80, ch = ci - nl * 80, n = qtr * 128 + nl, t = n >> 4, h = n & 15; float v[8];
        if (ch < 64) { const int s = ch >> 1, i0 = (ch & 1) * 8;
#pragma unroll
            for (int e = 0; e < 8; ++e) v[e] = (s <= t) ? KT[((t - s) << 8) + (h << 4) + i0 + e] : 0.f;
        } else { const int pp = (ch - 64) * 8;
#pragma unroll
            for (int e = 0; e < 8; ++e) { const int p = (pp + e) & 63; const float cr = Cre[h * 64 + p], cim = Cim[h * 64 + p], pr = Pr[(t + 1) * 64 + p], pi = Pi[(t + 1) * 64 + p];
                v[e] = (pp < 64) ? (cr * pr - cim * pi) : -(cr * pi + cim * pr); }
        }
        u32x4_t o; o.x = pk2(v[0], v[1]); o.y = pk2(v[2], v[3]); o.z = pk2(v[4], v[5]); o.w = pk2(v[6], v[7]);
        *(u32x4_t*)(GC + (size_t)n * KA + ch * 8) = o;
    }
    bf16_t* WE = (bf16_t*)(ws + WS_WEND) + (size_t)g * 256 * 512;
    for (int ci = tid; ci < 64 * 64; ci += 512) {
        const int rl = ci >> 6, ch = ci & 63, pr_ = qtr * 64 + rl, s = ch >> 1, i0 = (ch & 1) * 8, p = pr_ & 63; float v[8];
#pragma unroll
        for (int e = 0; e < 8; ++e) { const float mr = MZr[(31 - s) * 64 + p], mi = MZi[(31 - s) * 64 + p], br = Bre[p * 16 + i0 + e], bi = Bim[p * 16 + i0 + e];
            v[e] = (pr_ < 64) ? (mr * br - mi * bi) : ((pr_ < 128) ? (mr * bi + mi * br) : 0.f); }
        u32x4_t o; o.x = pk2(v[0], v[1]); o.y = pk2(v[2], v[3]); o.z = pk2(v[4], v[5]); o.w = pk2(v[6], v[7]);
        *(u32x4_t*)(WE + (size_t)pr_ * 512 + ch * 8) = o;
    }
    __syncthreads();
}

__device__ __forceinline__ void norm_mod_row(const float* xrow, bf16_t* orow, const LAS float* gs, const LAS float* shv, int lane, f32x4_t (&v)[8]) {
    const f32x4_t* xr = (const f32x4_t*)xrow + lane; float s = 0.f;
#pragma unroll
    for (int j = 0; j < 8; ++j) { v[j] = xr[64 * j]; s += (v[j][0] * v[j][0] + v[j][1] * v[j][1]) + (v[j][2] * v[j][2] + v[j][3] * v[j][3]); }
    const float rstd = 1.0f / sqrtf(wave_sum(s) * (1.0f / DM) + EPS);
#pragma unroll
    for (int j = 0; j < 8; ++j) { const int k = 4 * lane + 256 * j; const f32x4_t g4 = *(const LAS f32x4_t*)(gs + k), s4 = *(const LAS f32x4_t*)(shv + k);
        v[j] = v[j] * rstd * g4 + s4;
        u32x2_t o; o.x = pk2(v[j][0], v[j][1]); o.y = pk2(v[j][2], v[j][3]); *(u32x2_t*)(orow + k) = o; }
}

__global__ void __launch_bounds__(512, 2) fwd_kernel(Args a) {
    extern __shared__ __attribute__((aligned(16))) unsigned char lds_raw[];
    cg::grid_group grid = cg::this_grid();
    LAS unsigned char* lds = (LAS unsigned char*)lds_raw;
    const int wave = __builtin_amdgcn_readfirstlane((int)threadIdx.x >> 6), G = gridDim.x, bid = blockIdx.x;
#define lane ((int)__builtin_amdgcn_mbcnt_hi(~0u, __builtin_amdgcn_mbcnt_lo(~0u, 0u)))
#define tid (wave * 64 + lane)
    const int gw = bid * 8 + wave, NGW = G * 8;
    unsigned char* ws = a.ws;
    volatile LAS unsigned* xst = (volatile LAS unsigned*)(lds + LDS_BYTES - 64);
    if (tid < 2) xst[tid] = 0u;
    __syncthreads();
    XcdBarrier xbar = xcd_barrier_post((unsigned*)(ws + WS_CTL) + 4096, xst, tid == 0);
#define GRID_BAR() xcd_barrier(xbar, tid == 0)
#define MODP ((float*)(ws + WS_MODP))
#define MOD ((float*)(ws + WS_MOD))
#define LF ((float*)(ws + WS_LF))
#define CBR ((float*)(ws + WS_CBR))
#define SSQB ((float*)(ws + WS_SSQ))
#define SSQ2B ((float*)(ws + WS_SSQ2))
#define WDT ((bf16_t*)(ws + WS_WDT))
#define W1T ((bf16_t*)(ws + WS_W1T))
#define WGT ((bf16_t*)(ws + WS_WGT))
#define WOT ((bf16_t*)(ws + WS_WOT))
#define WUT ((bf16_t*)(ws + WS_WUT))
#define GC ((bf16_t*)(ws + WS_GC))
#define WEND ((bf16_t*)(ws + WS_WEND))
#define AALL ((bf16_t*)(ws + WS_AALL))
#define QKV ((bf16_t*)(ws + WS_QKV))
#define YB ((bf16_t*)(ws + WS_YB))
#define MIX ((bf16_t*)(ws + WS_MIX))
#define HN ((bf16_t*)(ws + WS_HN))
#define ABUF ((bf16_t*)(ws + WS_ABUF))
#define BBUF ((bf16_t*)(ws + WS_BBUF))
#define XIN (a.in[0])
#define OUT (a.out)


    {
        LAS f32x4_t* red = (LAS f32x4_t*)lds; const float* cvec = a.in[1]; const float* w_ada = a.in[2];
        for (int it = bid; it < 768; it += G) {
            const int nc = it % 48, ks = it / 48, n0 = nc * 256, k0 = ks * 128 + wave * 16;
            f32x4_t acc = {0.f, 0.f, 0.f, 0.f};
#pragma unroll
            for (int r = 0; r < 16; ++r) { const int k = k0 + r; const float cv = cvec[k]; const float sv = cv / (1.0f + expf(-cv));
                const f32x4_t w = *(const f32x4_t*)(w_ada + (size_t)k * (6 * DM) + n0 + 4 * lane); acc += sv * w; }
            red[wave * 64 + lane] = acc;
            __syncthreads();
            if (tid < 256) { float s = 0.f;
#pragma unroll
                for (int w = 0; w < 8; ++w) s += ((LAS float*)red)[w * 256 + tid];
                MODP[ks * (6 * DM) + n0 + tid] = s; }
            __syncthreads();
        }
    }
    for (int it = bid; it < 4 * NG; it += G) ssm_setup_item(a, ws, lds, it >> 2, it & 3, tid);
    __syncthreads();
    {
        LAS float* scr = (LAS float*)(lds + wave * 16384);
        constexpr int I_IN = 32 * 128, I_GLU = 16 * 32, I_OUT = 32 * 64, I_UP = 32 * 352, I_DN = 88 * 64, I_ALL = I_IN + I_GLU + I_OUT + I_UP + I_DN;
        for (int it = gw; it < I_ALL; it += NGW) {
            int r = it;
            if (r < I_IN) { const int kb = r / 128, n0 = 32 * (r % 128); tr_item(a.in[5], INW, n0 < 3072 ? n0 : n0 + 8, 64 * kb, W1T, DM, n0, nullptr, nullptr, scr, lane); continue; } r -= I_IN;
            if (r < I_GLU) { const int kb = r / 32, n0 = 32 * (r % 32); tr_item(a.in[15], SW, n0, 64 * kb, WGT, SW, n0, nullptr, nullptr, scr, lane); continue; } r -= I_GLU;
            if (r < I_OUT) { const int kb = r / 64, n0 = 32 * (r % 64); tr_item(a.in[19], DM, n0, 64 * kb, WOT, DM, n0, a.in[17], a.in[18], scr, lane); continue; } r -= I_OUT;
            if (r < I_UP) { const int kb = r / 352, n0 = 32 * (r % 352); const int pn = n0 >> 8, bj = (n0 >> 7) & 1, w = n0 & 127;
                tr_item(a.in[21], 2 * DFF, bj * DFF + 128 * pn + w, 64 * kb, WUT, DM, n0, nullptr, nullptr, scr, lane); continue; } r -= I_UP;
            { const int kb = r / 64, n0 = 32 * (r % 64); tr_item(a.in[24], DM, n0, 64 * kb, WDT, DFF, n0, nullptr, nullptr, scr, lane); }
        }
    }
    grid.sync();

    {
        LAS float* gs = (LAS float*)lds; LAS float* shv = gs + DM; LAS float* wf = shv + DM;
        const float* b_ada = a.in[3]; const float* g_mix = a.in[4]; const float* w_in = a.in[5];
        for (int k = tid; k < DM; k += 512) { float sh = b_ada[k], sc = b_ada[DM + k];
            for (int j = 0; j < 16; ++j) { sh += MODP[j * (6 * DM) + k]; sc += MODP[j * (6 * DM) + DM + k]; }
            gs[k] = g_mix[k] * (1.0f + sc); shv[k] = sh; }
        for (int i = tid; i < DM * 8; i += 512) wf[i] = w_in[(size_t)(i >> 3) * INW + 3072 + (i & 7)];
        for (int n = bid * 512 + tid; n < 6 * DM; n += G * 512) { float m = b_ada[n]; for (int j = 0; j < 16; ++j) m += MODP[j * (6 * DM) + n]; MOD[n] = m; }
        __syncthreads();
        const float* b_f = a.in[6];
        for (int row = gw; row < SEQ; row += NGW) {
            f32x4_t v[8]; norm_mod_row(XIN + (size_t)row * DM, HN + (size_t)row * DM, gs, shv, lane, v);
            f32x4_t f0 = {0.f, 0.f, 0.f, 0.f}, f1 = {0.f, 0.f, 0.f, 0.f};
#pragma unroll
            for (int j = 0; j < 8; ++j)
#pragma unroll
                for (int e = 0; e < 4; ++e) { const int k = 4 * lane + 256 * j + e; const f32x4_t w0 = *(const LAS f32x4_t*)(wf + k * 8), w1 = *(const LAS f32x4_t*)(wf + k * 8 + 4);
                    f0 += v[j][e] * w0; f1 += v[j][e] * w1; }
            float fd = 0.f;
#pragma unroll
            for (int h = 0; h < 8; ++h) { const float t = wave_sum(h < 4 ? f0[h & 3] : f1[h & 3]); if (lane == h) fd = t; }
            if (lane < 8) { const float z = fd + b_f[lane]; LF[lane * SEQ + row] = fminf(z, 0.f) - log1pf(expf(-fabsf(z))); }
        }
    }
    GRID_BAR();

    if (bid < NH) {
        LAS double* tot = (LAS double*)lds; const int h = bid; const float* src = LF + h * SEQ + tid * 16;
        float vals[16];
#pragma unroll
        for (int q = 0; q < 4; ++q) { const f32x4_t t = *(const f32x4_t*)(src + 4 * q); vals[4 * q] = t[0]; vals[4 * q + 1] = t[1]; vals[4 * q + 2] = t[2]; vals[4 * q + 3] = t[3]; }
        double run = 0.0;
#pragma unroll
        for (int e = 0; e < 16; ++e) run += (double)vals[e];
        tot[tid] = run;
        __syncthreads();
        double c = 0.0; for (int i = 0; i < tid; ++i) c += tot[i];
        float* dst = CBR + h * SEQ + tid * 16;
#pragma unroll
        for (int e = 0; e < 16; ++e) { c += (double)vals[e]; dst[e] = -(float)(c * 11.313708498984761); }
        __syncthreads();
    }
    {
        pg8::Gemm g{HN, W1T, SEQ, 4096, DM, DM, DM}; pg8::StaticOrder S; S.init(SEQ, 4096, G, bid);
        pg8::EpiQKVU E{QKV, AALL};
#ifndef NO_G1
        pg8::gemm_phase<pg8::EpiQKVU, pg8::StaticOrder, true, true>(lds, g, S, E, wave);
#endif
    }
    GRID_BAR();

    {
        pg8::Gemm g{AALL, WEND, NG * NCH, NG * 256, CL * GCH, KA, CL * GCH}; pg8::CarryOrder S{G, bid};
        pg8::EpiCarry E{AALL, (const float*)(ws + WS_P32)};
#ifndef NO_G2
        pg8::gemm_phase<pg8::EpiCarry, pg8::CarryOrder, false, true>(lds, g, S, E, wave);
#endif
        if (bid >= NG && G > NG + 2) {
            const int nw = (G - NG) * 8, per = nw / 16, w = (bid - NG) * 8 + wave, ha = w / per, j = w - ha * per;
            if (ha < 16) {
                const bf16_t* base = QKV + (size_t)ha * SEQ * HD; float mx = 0.f;
                for (int q4 = j; q4 < SEQ / 4; q4 += per) {
                    const u32x4_t v = *(const u32x4_t*)(base + (size_t)(4 * q4 + (lane >> 4)) * HD + (lane & 15) * 8);
                    float s = bf_lo(v.x) * bf_lo(v.x) + bf_hi(v.x) * bf_hi(v.x) + bf_lo(v.y) * bf_lo(v.y) + bf_hi(v.y) * bf_hi(v.y)
                            + bf_lo(v.z) * bf_lo(v.z) + bf_hi(v.z) * bf_hi(v.z) + bf_lo(v.w) * bf_lo(v.w) + bf_hi(v.w) * bf_hi(v.w);
                    s += __shfl_xor(s, 1); s += __shfl_xor(s, 2); s += __shfl_xor(s, 4); s += __shfl_xor(s, 8);
                    mx = fmaxf(mx, s);
                }
                mx = fmaxf(mx, __shfl_xor(mx, 16)); mx = fmaxf(mx, __shfl_xor(mx, 32));
                if (lane == 0) atomicMax((unsigned*)(ws + WS_NRM) + ha, __float_as_uint(mx));
            }
        }
    }
    GRID_BAR();

    {
        using abf = att::bf16;
        char* ldsg = (char*)lds_raw;
        BIAS_LAS float* bias = (BIAS_LAS float*)(lds + att::BIAS_OFF);
        att::Seam<abf> Sm;
        if (bid < NH * (SEQ / att::QB)) { const int it = bid;
            const int head = it & 7, qb = (SEQ / att::QB - 1) - (it >> 3), P0 = qb * att::QB;
            const float qk = sqrtf(__uint_as_float(((const unsigned*)(ws + WS_NRM))[head]) * __uint_as_float(((const unsigned*)(ws + WS_NRM))[8 + head]));
            const float thr = 1131.4f + 2.02f * qk + 1.0f;
            const int jlo = __syncthreads_count((tid < P0 / 64) && (CBR[head * SEQ + P0] - CBR[head * SEQ + 64 * tid + 63] > thr));
            for (int k = 64 * jlo + tid * 4; k < P0 + att::QB; k += 2048) *(BIAS_LAS f32x4_t*)(bias + (k - 64 * jlo)) = *(const f32x4_t*)(CBR + head * SEQ + k);
            __syncthreads();
            att::BlockRef<abf, abf> cur;
            cur.Q = (const abf*)QKV + ((size_t)(0 * NH + head) * SEQ + P0) * HD; cur.K = (const abf*)QKV + (size_t)(1 * NH + head) * SEQ * HD; cur.V = (const abf*)QKV + (size_t)(2 * NH + head) * SEQ * HD;
            cur.O = (abf*)MIX + (size_t)P0 * DM + head * HD; cur.P0 = P0; cur.JLO = jlo; cur.SSQ = SSQB + (size_t)P0 * 32 + head;
#ifndef NO_ATT
            att::causal_swa_prime<abf, abf>(cur, 1 << 30, ldsg, Sm, wave);
            att::causal_swa_block<abf, abf>(cur, cur, SEQ, 1 << 30, ldsg, Sm, bias, wave);
#endif
        }
        asm volatile("s_waitcnt vmcnt(0)" ::: "memory");
        __syncthreads();
        pg8::Gemm g{AALL, GC, NG * NCH, NG * 512, KA, KA, KA}; pg8::ChunkOrder S{G, G - 1 - bid};
        pg8::EpiY E{YB};
#ifndef NO_G3
        pg8::gemm_phase<pg8::EpiY, pg8::ChunkOrder, true, true>(lds, g, S, E, wave);
#endif
    }
    GRID_BAR();

    {
        pg8::Gemm g{YB, WGT, SEQ, SW, SW, SW, SW}; pg8::StaticOrder S; S.init(SEQ, SW, G, bid);
        pg8::EpiGlu E{YB, MIX, a.in[16], SSQB};
#ifndef NO_G4
        pg8::gemm_phase<pg8::EpiGlu, pg8::StaticOrder, true, true>(lds, g, S, E, wave);
#endif
    }
    GRID_BAR();

    {
        pg8::Gemm g{MIX, WOT, SEQ, DM, DM, DM, DM}; pg8::StaticOrder S; S.init(SEQ, DM, G, bid);
        LAS float* rtab = (LAS float*)(lds + RING_BYTES);
        { pg8::Unit u0; if (S.next(0, u0) && tid < 256) { float ra, rs; pg8::EpiWout::rstds(SSQB, u0.pm * 256 + tid, ra, rs); rtab[2 * tid] = ra / rs; rtab[2 * tid + 1] = rs; } }
        __syncthreads();
        pg8::EpiWout E{rtab, XIN, MOD + 2 * DM, OUT};
#ifndef NO_G5
        pg8::gemm_phase<pg8::EpiWout, pg8::StaticOrder, true, true>(lds, g, S, E, wave);
#endif
    }
    GRID_BAR();

    {
        LAS float* gs = (LAS float*)lds; LAS float* shv = gs + DM; const float* g_ffn = a.in[20];
        for (int k = tid; k < DM; k += 512) { gs[k] = g_ffn[k] * (1.0f + MOD[4 * DM + k]); shv[k] = MOD[3 * DM + k]; }
        __syncthreads();
        for (int row = gw; row < SEQ; row += NGW) { f32x4_t v[8]; norm_mod_row(OUT + (size_t)row * DM, HN + (size_t)row * DM, gs, shv, lane, v); }
    }
    GRID_BAR();

    {
        pg8::Gemm g{HN, WUT, SEQ, 2 * DFF, DM, DM, DM}; pg8::StaticOrder S; S.init(SEQ, 2 * DFF, G, bid);
        pg8::EpiUp E{ABUF, BBUF};
#ifndef NO_G6
        pg8::gemm_phase<pg8::EpiUp, pg8::StaticOrder, true, true>(lds, g, S, E, wave);
#endif
    }
    GRID_BAR();

    {
        const float* cw = a.in[22]; const float* cbias = a.in[23];
        constexpr int NCC = DFF / 8, NRB = SEQ / 16;
        for (int id = bid * 512 + tid; id < NRB * NCC; id += G * 512) {
            const int rb = id / NCC, cc = id - rb * NCC, col = cc * 8, t0 = rb * 16;
            float w0[8], w1[8], w2[8], cb[8], am2[8], am1[8];
#pragma unroll
            for (int q = 0; q < 2; ++q) { const f32x4_t u0 = *(const f32x4_t*)(cw + col + 4 * q), u1 = *(const f32x4_t*)(cw + DFF + col + 4 * q), u2 = *(const f32x4_t*)(cw + 2 * DFF + col + 4 * q), u3 = *(const f32x4_t*)(cbias + col + 4 * q);
#pragma unroll
                for (int e = 0; e < 4; ++e) { w0[4 * q + e] = u0[e]; w1[4 * q + e] = u1[e]; w2[4 * q + e] = u2[e]; cb[4 * q + e] = u3[e]; } }
#pragma unroll
            for (int e = 0; e < 8; ++e) { am2[e] = 0.f; am1[e] = 0.f; }
            if (t0 > 0) { const u32x4_t p2 = *(const u32x4_t*)(ABUF + (size_t)(t0 - 2) * DFF + col), p1 = *(const u32x4_t*)(ABUF + (size_t)(t0 - 1) * DFF + col);
                am2[0] = bf_lo(p2.x); am2[1] = bf_hi(p2.x); am2[2] = bf_lo(p2.y); am2[3] = bf_hi(p2.y); am2[4] = bf_lo(p2.z); am2[5] = bf_hi(p2.z); am2[6] = bf_lo(p2.w); am2[7] = bf_hi(p2.w);
                am1[0] = bf_lo(p1.x); am1[1] = bf_hi(p1.x); am1[2] = bf_lo(p1.y); am1[3] = bf_hi(p1.y); am1[4] = bf_lo(p1.z); am1[5] = bf_hi(p1.z); am1[6] = bf_lo(p1.w); am1[7] = bf_hi(p1.w); }
            for (int r = 0; r < 16; ++r) {
                const size_t off = (size_t)(t0 + r) * DFF + col;
                const u32x4_t pa = *(const u32x4_t*)(ABUF + off), pb = *(const u32x4_t*)(BBUF + off);
                float av[8], bv[8], gv[8];
                av[0] = bf_lo(pa.x); av[1] = bf_hi(pa.x); av[2] = bf_lo(pa.y); av[3] = bf_hi(pa.y); av[4] = bf_lo(pa.z); av[5] = bf_hi(pa.z); av[6] = bf_lo(pa.w); av[7] = bf_hi(pa.w);
                bv[0] = bf_lo(pb.x); bv[1] = bf_hi(pb.x); bv[2] = bf_lo(pb.y); bv[3] = bf_hi(pb.y); bv[4] = bf_lo(pb.z); bv[5] = bf_hi(pb.z); bv[6] = bf_lo(pb.w); bv[7] = bf_hi(pb.w);
#pragma unroll
                for (int e = 0; e < 8; ++e) { const float cv = cb[e] + w0[e] * am2[e] + w1[e] * am1[e] + w2[e] * av[e]; gv[e] = cv * fast_sigmoid(cv) * bv[e]; am2[e] = am1[e]; am1[e] = av[e]; }
                u32x4_t o; o.x = pk2(gv[0], gv[1]); o.y = pk2(gv[2], gv[3]); o.z = pk2(gv[4], gv[5]); o.w = pk2(gv[6], gv[7]);
                *(u32x4_t*)(BBUF + off) = o;
            }
        }
    }
    GRID_BAR();

    {
        pg8::Gemm g{BBUF, WDT, SEQ, DM, DFF, DFF, DFF}; pg8::StaticOrder S; S.init(SEQ, DM, G, bid);
        pg8::EpiDown E{MOD + 5 * DM, OUT, SSQ2B};
#ifndef NO_G7
        pg8::gemm_phase<pg8::EpiDown, pg8::StaticOrder, true, true>(lds, g, S, E, wave);
#endif
    }
    GRID_BAR();

    {
        const float* gf = a.in[25];
        for (int row = gw; row < SEQ; row += NGW) {
            const float part = lane < 32 ? SSQ2B[(size_t)row * 32 + lane] : 0.f;
            const float rstd = 1.0f / sqrtf(wave_sum(part) * (1.0f / DM) + EPS);
            f32x4_t* orow = (f32x4_t*)(OUT + (size_t)row * DM) + lane; const f32x4_t* g4 = (const f32x4_t*)gf + lane;
#pragma unroll
            for (int j = 0; j < 8; ++j) orow[64 * j] = orow[64 * j] * rstd * g4[64 * j];
        }
    }
}

extern "C" void kernel_launch(void* const* d_in, const int* in_sizes, int n_in, void* d_out, int out_size, void* d_ws, size_t ws_size, hipStream_t stream) {
    static int grid = 0;
    if (grid == 0) {
        if (n_in != 26 || out_size != SEQ * DM || ws_size < WS_END) { fprintf(stderr, "kernel_launch: unexpected shapes (n_in %d out %d ws %zu)\n", n_in, out_size, ws_size); grid = -1; return; }
        int dev = 0, cus = 0, per_cu = 0;
        (void)hipGetDevice(&dev); (void)hipDeviceGetAttribute(&cus, hipDeviceAttributeMultiprocessorCount, dev);
        if (hipFuncSetAttribute((const void*)fwd_kernel, hipFuncAttributeMaxDynamicSharedMemorySize, LDS_BYTES) != hipSuccess) { fprintf(stderr, "kernel_launch: hipFuncSetAttribute failed\n"); grid = -1; return; }
        if (hipOccupancyMaxActiveBlocksPerMultiprocessor(&per_cu, (const void*)fwd_kernel, 512, LDS_BYTES) != hipSuccess || per_cu < 1) { fprintf(stderr, "kernel_launch: occupancy query gave %d\n", per_cu); per_cu = 1; }
        (void)hipGetLastError();
        grid = cus;
        if (grid > 256) grid = 256;
    }
    if (grid < 0) return;
    (void)hipMemsetAsync((char*)d_ws + WS_CTL, 0, CTL_ZERO_BYTES, stream);
    Args a{};
    for (int i = 0; i < 26; ++i) a.in[i] = (const float*)d_in[i];
    a.out = (float*)d_out; a.ws = (unsigned char*)d_ws;
    void* args[] = {&a};
    hipError_t e = hipLaunchCooperativeKernel((const void*)fwd_kernel, dim3(grid), dim3(512), args, LDS_BYTES, stream);
    if (e != hipSuccess) fprintf(stderr, "cooperative launch failed: %s (grid %d)\n", hipGetErrorString(e), grid);
}
```

```cpp
#include <hip/hip_runtime.h>
#include <hip/hip_cooperative_groups.h>
#include <cstdio>
#include <cstdint>
namespace cg = cooperative_groups;

constexpr int SEQ = 8192, DM = 2048, AW = 1024, HD = 128, NH = 8, SW = 1024, NG = 64, GCH = 16, NP = 64, INW = 4104, DFF = 5632;
constexpr int CL = 32, NCH = SEQ / CL;
constexpr int KA = CL * GCH + 2 * NP;
constexpr float EPS = 1e-6f;
constexpr size_t MiB = 1u << 20, KiB = 1024;
constexpr size_t WS_CTL = 0, CTL_ZERO_BYTES = 1 * MiB;
constexpr size_t WS_NRM = 512 * KiB;
constexpr size_t WS_MODP = 1 * MiB;
constexpr size_t WS_MOD = 2 * MiB;
constexpr size_t WS_LF = 2 * MiB + 64 * KiB;
constexpr size_t WS_CBR = 2 * MiB + 320 * KiB;
constexpr size_t WS_P32 = 2 * MiB + 576 * KiB;
constexpr size_t WS_SSQ = 3 * MiB;
constexpr size_t WS_SSQ2 = 4 * MiB;
constexpr size_t WS_WDT = 8 * MiB;
constexpr size_t WS_W1T = 30 * MiB;
constexpr size_t WS_WGT = 46 * MiB;
constexpr size_t WS_WOT = 48 * MiB;
constexpr size_t WS_WUT = 56 * MiB;
constexpr size_t WS_GC = 100 * MiB;
constexpr size_t WS_WEND = 140 * MiB;
constexpr size_t WS_AALL = 156 * MiB;
constexpr size_t WS_QKV = 176 * MiB;
constexpr size_t WS_YB = 224 * MiB;
constexpr size_t WS_MIX = 240 * MiB;
constexpr size_t WS_HN = 280 * MiB;
constexpr size_t WS_ABUF = 100 * MiB;
constexpr size_t WS_BBUF = 188 * MiB;
constexpr size_t WS_END = 312 * MiB;
static_assert(WS_ABUF + (size_t)SEQ * DFF * 2 <= WS_BBUF && WS_BBUF + (size_t)SEQ * DFF * 2 <= WS_HN && WS_HN + (size_t)SEQ * DM * 2 <= WS_END, "ws map");
static_assert(WS_WUT + (size_t)2 * DFF * DM * 2 <= WS_GC && WS_GC + (size_t)NG * 512 * KA * 2 <= WS_WEND && WS_WEND + (size_t)NG * 256 * 512 * 2 <= WS_AALL && WS_AALL + (size_t)NG * 256 * KA * 2 <= WS_QKV, "ws map 2");
static_assert(WS_QKV + (size_t)3 * SEQ * AW * 2 <= WS_YB && WS_YB + (size_t)SEQ * SW * 2 <= WS_MIX && WS_MIX + (size_t)SEQ * DM * 2 <= WS_HN, "ws map 3");
static_assert(WS_WDT + (size_t)DM * DFF * 2 <= WS_W1T && WS_W1T + (size_t)4096 * DM * 2 <= WS_WGT && WS_WOT + (size_t)DM * DM * 2 <= WS_WUT, "ws map 4");
constexpr int LDS_BYTES = 147456;
constexpr int RING_BYTES = 131072;

typedef float f32x4_t __attribute__((ext_vector_type(4)));
typedef unsigned u32x4_t __attribute__((ext_vector_type(4)));
typedef unsigned u32x2_t __attribute__((ext_vector_type(2)));
__device__ __forceinline__ float bf_lo(unsigned w) { return __uint_as_float(w << 16); }
__device__ __forceinline__ float bf_hi(unsigned w) { return __uint_as_float(w & 0xffff0000u); }
__device__ __forceinline__ float fast_sigmoid(float z) { return __builtin_amdgcn_rcpf(1.0f + __builtin_amdgcn_exp2f(-1.4426950408889634f * z)); }
__device__ __forceinline__ float gelu_tanh(float v) { const float z = 1.5957691216057308f * (v + 0.044715f * v * v * v); return v * fast_sigmoid(z); }

namespace pg8 {
#define PG8_LAS __attribute__((address_space(3)))
typedef unsigned short bf16_t;
typedef short bf16x8 __attribute__((ext_vector_type(8)));
typedef float f32x4 __attribute__((ext_vector_type(4)));
typedef unsigned u32x4 __attribute__((ext_vector_type(4)));
constexpr int BM = 256, BK = 64, HALF = 128, HTB = HALF * BK * 2  , STAGE_BYTES = 8 * HTB, NXCD = 8, WGM = 8;

__host__ __device__ __forceinline__ int lds_byte(int r, int c) { const int st = (r >> 4) * 2 + (c >> 5), rr = r & 15, cc = c & 31, ob = rr * 64 + cc * 2; return st * 1024 + (ob ^ (((ob >> 9) & 1) << 5)); }
__host__ __device__ __forceinline__ void stage_rc(int b, int& R, int& C) { const int st = b / 1024, sb = b % 1024, swz = sb ^ (((sb >> 9) & 1) << 5); R = (st >> 1) * 16 + swz / 64; C = (st & 1) * 32 + (swz % 64) / 2; }
__host__ __device__ __forceinline__ int perm32(int rho) { const int n = rho >> 4, i = rho & 15; return 8 * (i >> 2) + 4 * n + (i & 3); }

struct Unit { int pm, pn; };
struct Gemm { const bf16_t* A; const bf16_t* Bt; int M, N, K, lda, ldb; };

struct StaticOrder {
    int nM, nN, nwg, G, c;
    __host__ __device__ void init(int M, int N, int G_, int c_) { nM = M / BM; nN = N / BM; nwg = nM * nN; G = G_; c = c_; }
    __host__ __device__ bool next(int i, Unit& u) const {
        const long L = (long)i * G + c; if (L >= nwg) return false;
        int wgid = (int)L; { const int q = nwg / NXCD, r = nwg % NXCD, xcd = wgid % NXCD, off = wgid / NXCD; wgid = (xcd < r ? xcd * (q + 1) : r * (q + 1) + (xcd - r) * q) + off; }
        const int nig = WGM * nN, gid = wgid / nig, fm = gid * WGM, gsz = (nM - fm) < WGM ? (nM - fm) : WGM;
        u.pm = fm + ((wgid % nig) % gsz); u.pn = (wgid % nig) / gsz; return true;
    }
    __device__ __forceinline__ void a_ready(const Unit&) const {}
    __device__ __forceinline__ void done(const Unit&) const {}
};


template <class Epi, class Sched, bool ALIGN_EPI = false, bool SP2 = false>
__device__ __forceinline__ void gemm_phase(PG8_LAS unsigned char* lds, const Gemm g, const Sched& S, const Epi& E, const int wv  ) {
    int tid_ = wv * 64 + ((int)__builtin_amdgcn_mbcnt_hi(~0u, __builtin_amdgcn_mbcnt_lo(~0u, 0u))); asm volatile("" : "+v"(tid_));
    const int tid = tid_, wid = __builtin_amdgcn_readfirstlane(tid >> 6), lane = tid & 63, wr = wid >> 2, wc = wid & 3, fr = lane & 15, fq = lane >> 4;
    const int K = g.K, nt = K / BK;
    unsigned voffA[2], voffB[2];
#pragma unroll
    for (int i = 0; i < 2; ++i) { int R, C; stage_rc(tid * 16 + i * 8192, R, C); const int Rb = Epi::PERM ? ((R & ~31) + perm32(R & 31)) : R;
        voffA[i] = (unsigned)(R * g.lda + C) * 2u; voffB[i] = (unsigned)(Rb * g.ldb + C) * 2u; }
    const size_t kstep = (size_t)(BK * 2);
    const size_t hstepA = (size_t)HALF * g.lda * 2, hstepB = (size_t)HALF * g.ldb * 2;
    const size_t tstepA = 2 * hstepA, tstepB = 2 * hstepB;
    const unsigned ldsw = (unsigned)wid * 1024u;
    const int aoff = lds_byte(wr * 64 + fr, fq * 8), boff = lds_byte(wc * 32 + fr, fq * 8);
#define PG8_SA(b, h) (((b) * 2 + (h)) * HTB)
#define PG8_SB(b, h) ((4 + (b) * 2 + (h)) * HTB)
#define PG8_STAGE(bufoff, gbase, voff) do { _Pragma("unroll") for (int _i = 0; _i < 2; ++_i) \
        __builtin_amdgcn_global_load_lds((const unsigned*)((const char*)(gbase) + (voff)[_i]), (PG8_LAS unsigned*)(lds + (bufoff) + ldsw + _i * 8192), 16, 0, 0); } while (0)
#define PG8_LDA(dst, b, h) do { _Pragma("unroll") for (int m = 0; m < 4; ++m) _Pragma("unroll") for (int k = 0; k < 2; ++k) dst[m][k] = *(const PG8_LAS bf16x8*)(lds + PG8_SA(b, h) + aoff + m * 2048 + k * 1024); } while (0)
#define PG8_LDB(dst, b, h) do { _Pragma("unroll") for (int n = 0; n < 2; ++n) _Pragma("unroll") for (int k = 0; k < 2; ++k) dst[n][k] = *(const PG8_LAS bf16x8*)(lds + PG8_SB(b, h) + boff + n * 2048 + k * 1024); } while (0)
#define PG8_MMA(ai, bj, At, Bt) do { __builtin_amdgcn_s_setprio(1); _Pragma("unroll") for (int m = 0; m < 4; ++m) _Pragma("unroll") for (int n = 0; n < 2; ++n) _Pragma("unroll") for (int k = 0; k < 2; ++k) \
        acc[ai][bj][m][n] = __builtin_amdgcn_mfma_f32_16x16x32_bf16(Bt[n][k], At[m][k], acc[ai][bj][m][n], 0, 0, 0); __builtin_amdgcn_s_setprio(0); } while (0)
#define PG8_WAIT_V(n) asm volatile("s_waitcnt vmcnt(" #n ")" ::: "memory")
#define PG8_WAIT_L(n) asm volatile("s_waitcnt lgkmcnt(" #n ")" ::: "memory")
#define PG8_BAR __builtin_amdgcn_s_barrier()
#define PG8_SCHED __builtin_amdgcn_sched_barrier(0)
    Unit cur, nxt; int ui = 0;
    if (!S.next(0, cur)) return;
    f32x4 acc[2][2][4][2];
#pragma unroll
    for (int a = 0; a < 2; ++a)
#pragma unroll
        for (int b = 0; b < 2; ++b)
#pragma unroll
            for (int m = 0; m < 4; ++m)
#pragma unroll
                for (int n = 0; n < 2; ++n) acc[a][b][m][n] = (f32x4){0.f, 0.f, 0.f, 0.f};
    bf16x8 At[4][2], B0[2][2], B1[2][2];
    const char* cA = (const char*)g.A + (size_t)cur.pm * tstepA; const char* cB = (const char*)g.Bt + (size_t)cur.pn * tstepB;
    S.a_ready(cur);
    if constexpr (SP2) {
        PG8_STAGE(PG8_SB(0, 0), cB, voffB); PG8_STAGE(PG8_SB(0, 1), cB + hstepB, voffB); PG8_STAGE(PG8_SA(0, 0), cA, voffA); PG8_STAGE(PG8_SA(0, 1), cA + hstepA, voffA);
        if (wr == 1) PG8_BAR;
        PG8_WAIT_V(2); PG8_BAR;
        PG8_STAGE(PG8_SB(1, 0), cB + kstep, voffB); PG8_STAGE(PG8_SA(1, 0), cA + kstep, voffA); PG8_STAGE(PG8_SB(1, 1), cB + hstepB + kstep, voffB);
        PG8_WAIT_V(6); PG8_BAR;
    } else {
        PG8_STAGE(PG8_SB(0, 0), cB, voffB); PG8_STAGE(PG8_SA(0, 0), cA, voffA); PG8_STAGE(PG8_SB(0, 1), cB + hstepB, voffB); PG8_STAGE(PG8_SA(0, 1), cA + hstepA, voffA);
        if (wr == 1) PG8_BAR;
        PG8_WAIT_V(4); PG8_BAR;
        PG8_STAGE(PG8_SB(1, 0), cB + kstep, voffB); PG8_STAGE(PG8_SA(1, 0), cA + kstep, voffA); PG8_STAGE(PG8_SB(1, 1), cB + hstepB + kstep, voffB);
        PG8_WAIT_V(6); PG8_BAR;
    }
    for (;;) {
        const bool has_next = S.next(ui + 1, nxt);
        const char* nA = has_next ? (const char*)g.A + (size_t)nxt.pm * tstepA : cA; const char* nB = has_next ? (const char*)g.Bt + (size_t)nxt.pn * tstepB : cB;
        for (int t = 0; t < nt; t += 2) {
            const bool last = (t == nt - 2);
            const char* a1 = cA + (size_t)(t + 1) * kstep;
            const char* a2 = last ? nA : cA + (size_t)(t + 2) * kstep; const char* b2 = last ? nB : cB + (size_t)(t + 2) * kstep;
            const char* a3 = a2 + kstep; const char* b3 = b2 + kstep;
            if (last && has_next) S.a_ready(nxt);
            if constexpr (Epi::MIDK) { if (t == (nt >> 1)) E.mid(acc, cur, wr, fr); }
            if constexpr (SP2) {
            PG8_LDB(B0, 0, 0); PG8_LDB(B1, 0, 1); PG8_SCHED; PG8_LDA(At, 0, 0); PG8_STAGE(PG8_SA(1, 1), a1 + hstepA, voffA);
            PG8_WAIT_V(8); PG8_WAIT_L(0); PG8_BAR; PG8_MMA(0, 0, At, B0); PG8_MMA(0, 1, At, B1); PG8_BAR; PG8_SCHED;
            PG8_LDA(At, 0, 1); PG8_STAGE(PG8_SB(0, 0), b2, voffB); PG8_STAGE(PG8_SB(0, 1), b2 + hstepB, voffB); PG8_STAGE(PG8_SA(0, 0), a2, voffA);
            PG8_WAIT_V(8); PG8_WAIT_L(0); PG8_BAR; PG8_MMA(1, 0, At, B0); PG8_MMA(1, 1, At, B1); PG8_BAR; PG8_SCHED;
            PG8_LDB(B0, 1, 0); PG8_LDB(B1, 1, 1); PG8_SCHED; PG8_LDA(At, 1, 0); PG8_STAGE(PG8_SA(0, 1), a2 + hstepA, voffA);
            PG8_WAIT_V(8); PG8_WAIT_L(0); PG8_BAR; PG8_MMA(0, 0, At, B0); PG8_MMA(0, 1, At, B1); PG8_BAR; PG8_SCHED;
            PG8_LDA(At, 1, 1); PG8_STAGE(PG8_SB(1, 0), b3, voffB); PG8_STAGE(PG8_SB(1, 1), b3 + hstepB, voffB); PG8_STAGE(PG8_SA(1, 0), a3, voffA);
            PG8_WAIT_V(8); PG8_WAIT_L(0); PG8_BAR; PG8_MMA(1, 0, At, B0); PG8_MMA(1, 1, At, B1); PG8_BAR; PG8_SCHED;
            } else {
            PG8_LDB(B0, 0, 0); PG8_SCHED; PG8_LDA(At, 0, 0); PG8_STAGE(PG8_SA(1, 1), a1 + hstepA, voffA);
            PG8_WAIT_L(8); PG8_BAR; PG8_WAIT_L(0); PG8_MMA(0, 0, At, B0); PG8_BAR; PG8_SCHED;
            PG8_LDB(B1, 0, 1); PG8_STAGE(PG8_SB(0, 0), b2, voffB);
            PG8_BAR; PG8_WAIT_L(0); PG8_MMA(0, 1, At, B1); PG8_BAR;
            PG8_LDA(At, 0, 1); PG8_STAGE(PG8_SA(0, 0), a2, voffA);
            PG8_BAR; PG8_WAIT_L(0); PG8_MMA(1, 0, At, B0); PG8_BAR; PG8_SCHED;
            PG8_STAGE(PG8_SB(0, 1), b2 + hstepB, voffB);
            PG8_WAIT_V(6); PG8_BAR; PG8_MMA(1, 1, At, B1); PG8_BAR;
            PG8_LDB(B0, 1, 0); PG8_SCHED; PG8_LDA(At, 1, 0); PG8_STAGE(PG8_SA(0, 1), a2 + hstepA, voffA);
            PG8_WAIT_L(8); PG8_BAR; PG8_WAIT_L(0); PG8_MMA(0, 0, At, B0); PG8_BAR; PG8_SCHED;
            PG8_LDB(B1, 1, 1); PG8_STAGE(PG8_SB(1, 0), b3, voffB);
            PG8_BAR; PG8_WAIT_L(0); PG8_MMA(0, 1, At, B1); PG8_BAR;
            PG8_LDA(At, 1, 1); PG8_STAGE(PG8_SA(1, 0), a3, voffA);
            PG8_BAR; PG8_WAIT_L(0); PG8_MMA(1, 0, At, B0); PG8_BAR; PG8_SCHED;
            PG8_STAGE(PG8_SB(1, 1), b3 + hstepB, voffB);
            PG8_WAIT_V(6); PG8_BAR; PG8_MMA(1, 1, At, B1); PG8_BAR;
            }
        }
        if constexpr (ALIGN_EPI) { if (wr == 0) PG8_BAR; }
        if constexpr (!Epi::AFTER_DRAIN) { E(acc, cur, wr, wc, fr, fq); S.done(cur); }
        if (!has_next) break;
#pragma unroll
        for (int a = 0; a < 2; ++a)
#pragma unroll
            for (int b = 0; b < 2; ++b)
#pragma unroll
                for (int m = 0; m < 4; ++m)
#pragma unroll
                    for (int n = 0; n < 2; ++n) acc[a][b][m][n] = (f32x4){0.f, 0.f, 0.f, 0.f};
        cur = nxt; cA = nA; cB = nB; ++ui;
        if constexpr (ALIGN_EPI) { if (wr == 1) PG8_BAR; }
    }
    PG8_WAIT_V(0);
    if constexpr (!ALIGN_EPI) { if (wr == 0) PG8_BAR; }
    PG8_BAR;
    if constexpr (Epi::AFTER_DRAIN) { E.fused(acc, cur, wr, wc, fr, fq, lds, wid, lane); S.done(cur); }
#undef PG8_SA
#undef PG8_SB
#undef PG8_STAGE
#undef PG8_LDA
#undef PG8_LDB
#undef PG8_MMA
#undef PG8_WAIT_V
#undef PG8_WAIT_L
#undef PG8_BAR
#undef PG8_SCHED
}
__device__ __forceinline__ unsigned cvt_pk_bf16(float lo, float hi) { unsigned r; asm volatile("v_cvt_pk_bf16_f32 %0, %1, %2" : "=v"(r) : "v"(lo), "v"(hi)); return r; }
__device__ __forceinline__ u32x4 pack8(const f32x4 a, const f32x4 b) { u32x4 w; w.x = cvt_pk_bf16(a[0], a[1]); w.y = cvt_pk_bf16(a[2], a[3]); w.z = cvt_pk_bf16(b[0], b[1]); w.w = cvt_pk_bf16(b[2], b[3]); return w; }

struct CarryOrder {
    int G, c;
    __device__ bool next(int i, Unit& u) const { const int L = i * G + c; if (L >= NG) return false; u.pm = L; u.pn = L; return true; }
    __device__ __forceinline__ void a_ready(const Unit&) const {}
    __device__ __forceinline__ void done(const Unit&) const {}
};
struct ChunkOrder {
    int G, c;
    __device__ bool next(int i, Unit& u) const { const int L = i * G + c; if (L >= 2 * NG) return false; u.pm = L >> 1; u.pn = L; return true; }
    __device__ __forceinline__ void a_ready(const Unit&) const {}
    __device__ __forceinline__ void done(const Unit&) const {}
};

struct EpiQKVU {
    static constexpr bool PERM = true, AFTER_DRAIN = false, MIDK = false;
    bf16_t* QKV; bf16_t* AALL;
    __device__ __forceinline__ void mid(f32x4 (&)[2][2][4][2], const Unit&, int, int) const {}
    __device__ __forceinline__ void operator()(const f32x4 (&acc)[2][2][4][2], const Unit& u, int wr, int wc, int fr, int fq) const {
        const int row0 = u.pm * BM + wr * 64 + fr;
#pragma unroll
        for (int bj = 0; bj < 2; ++bj) {
            const int ct = u.pn * BM + bj * HALF, cw = wc * 32 + 8 * fq;
            if (ct < 3072) {
                const int which = ct >> 10, head = (ct & 1023) >> 7;
                bf16_t* base = QKV + (size_t)(which * NH + head) * SEQ * HD + cw;
#pragma unroll
                for (int ai = 0; ai < 2; ++ai)
#pragma unroll
                    for (int m = 0; m < 4; ++m) { const int row = row0 + ai * HALF + m * 16; *(u32x4*)(base + (size_t)row * HD) = pack8(acc[ai][bj][m][0], acc[ai][bj][m][1]); }
            } else {
                const int cu = ct - 3072 + cw, g = cu >> 4, i0 = cu & 15;
#pragma unroll
                for (int ai = 0; ai < 2; ++ai)
#pragma unroll
                    for (int m = 0; m < 4; ++m) { const int row = row0 + ai * HALF + m * 16;
                        *(u32x4*)(AALL + ((size_t)(g * NCH + (row >> 5)) * KA + (row & 31) * GCH + i0)) = pack8(acc[ai][bj][m][0], acc[ai][bj][m][1]); }
            }
        }
    }
};

struct EpiCarry {
    static constexpr bool PERM = false, AFTER_DRAIN = true, MIDK = false;
    bf16_t* AALL; const float* P32;
    __device__ __forceinline__ void mid(f32x4 (&)[2][2][4][2], const Unit&, int, int) const {}
    __device__ __forceinline__ void operator()(const f32x4 (&)[2][2][4][2], const Unit&, int, int, int, int) const {}
    __device__ __forceinline__ void fused(f32x4 (&acc)[2][2][4][2], const Unit& u, int wr, int wc, int fr, int fq, PG8_LAS unsigned char* lds, int wid, int lane) const {
        PG8_LAS float* sS = (PG8_LAS float*)lds;
#pragma unroll
        for (int ai = 0; ai < 2; ++ai)
#pragma unroll
            for (int m = 0; m < 4; ++m) { const int r = ai * HALF + wr * 64 + m * 16 + fr;
#pragma unroll
                for (int n = 0; n < 2; ++n) *(PG8_LAS f32x4*)(sS + r * 128 + wc * 32 + 16 * n + 4 * fq) = acc[ai][0][m][n]; }
        asm volatile("s_waitcnt lgkmcnt(0)" ::: "memory"); __builtin_amdgcn_s_barrier(); asm volatile("" ::: "memory");
        if (wid == 0) {
            const int g = u.pm, p = lane;
            const float pr = P32[(g * NP + p) * 2], pi = P32[(g * NP + p) * 2 + 1];
            float xr = 0.f, xi = 0.f;
            bf16_t* dst = AALL + (size_t)g * NCH * KA + CL * GCH + p;
            for (int c = 0; c < NCH; ++c) {
                const unsigned w = cvt_pk_bf16(xr, xi);
                dst[(size_t)c * KA] = (bf16_t)(w & 0xffffu); dst[(size_t)c * KA + NP] = (bf16_t)(w >> 16);
                const float sr = sS[c * 128 + p], si = sS[c * 128 + NP + p];
                const float nr = pr * xr - pi * xi + sr, ni = pr * xi + pi * xr + si;
                xr = nr; xi = ni;
            }
        }
    }
};

struct EpiY {
    static constexpr bool PERM = true, AFTER_DRAIN = false, MIDK = false;
    bf16_t* YB;
    __device__ __forceinline__ void mid(f32x4 (&)[2][2][4][2], const Unit&, int, int) const {}
    __device__ __forceinline__ void operator()(const f32x4 (&acc)[2][2][4][2], const Unit& u, int wr, int wc, int fr, int fq) const {
        const int g = u.pm, j = u.pn & 1;
#pragma unroll
        for (int bj = 0; bj < 2; ++bj) { const int n0 = j * BM + bj * HALF + wc * 32 + 8 * fq, tl = n0 >> 4, h0 = n0 & 15;
#pragma unroll
            for (int ai = 0; ai < 2; ++ai)
#pragma unroll
                for (int m = 0; m < 4; ++m) { const int c = ai * HALF + wr * 64 + m * 16 + fr; const int t = CL * c + tl;
                    f32x4 a = acc[ai][bj][m][0], b = acc[ai][bj][m][1];
#pragma unroll
                    for (int e = 0; e < 4; ++e) { a[e] = gelu_tanh(a[e]); b[e] = gelu_tanh(b[e]); }
                    *(u32x4*)(YB + (size_t)t * SW + GCH * g + h0) = pack8(a, b); } }
    }
};

struct EpiGlu {
    static constexpr bool PERM = true, AFTER_DRAIN = false, MIDK = false;
    const bf16_t* YB; bf16_t* MIX; const float* bglu; float* SSQ;
    __device__ __forceinline__ void mid(f32x4 (&)[2][2][4][2], const Unit&, int, int) const {}
    __device__ __forceinline__ void operator()(const f32x4 (&acc)[2][2][4][2], const Unit& u, int wr, int wc, int fr, int fq) const {
        const int row0 = u.pm * BM + wr * 64 + fr;
        float ss[2][4];
#pragma unroll
        for (int ai = 0; ai < 2; ++ai)
#pragma unroll
            for (int m = 0; m < 4; ++m) ss[ai][m] = 0.f;
#pragma unroll
        for (int bj = 0; bj < 2; ++bj) { const int col0 = u.pn * BM + bj * HALF + wc * 32 + 8 * fq;
            const f32x4 b0 = *(const f32x4*)(bglu + col0), b1 = *(const f32x4*)(bglu + col0 + 4);
#pragma unroll
            for (int ai = 0; ai < 2; ++ai)
#pragma unroll
                for (int m = 0; m < 4; ++m) { const int row = row0 + ai * HALF + m * 16;
                    const u32x4 yw = *(const u32x4*)(YB + (size_t)row * SW + col0);
                    f32x4 ya = {bf_lo(yw.x), bf_hi(yw.x), bf_lo(yw.y), bf_hi(yw.y)}, yb = {bf_lo(yw.z), bf_hi(yw.z), bf_lo(yw.w), bf_hi(yw.w)};
                    const f32x4 za = acc[ai][bj][m][0] + b0, zb = acc[ai][bj][m][1] + b1;
                    float s = 0.f;
#pragma unroll
                    for (int e = 0; e < 4; ++e) { ya[e] *= fast_sigmoid(za[e]); yb[e] *= fast_sigmoid(zb[e]); s += ya[e] * ya[e] + yb[e] * yb[e]; }
                    ss[ai][m] += s;
                    *(u32x4*)(MIX + (size_t)row * DM + SW + col0) = pack8(ya, yb); } }
#pragma unroll
        for (int ai = 0; ai < 2; ++ai)
#pragma unroll
            for (int m = 0; m < 4; ++m) { float s = ss[ai][m]; s += __shfl_xor(s, 16); s += __shfl_xor(s, 32);
                if (fq == 0) SSQ[(size_t)(row0 + ai * HALF + m * 16) * 32 + 8 + u.pn * 4 + wc] = s; }
    }
};

struct EpiWout {
    static constexpr bool PERM = false, AFTER_DRAIN = false, MIDK = true;
    const PG8_LAS float* rtab;
    const float* X; const float* gt1; float* OUT;
    static __device__ __forceinline__ void rstds(const float* SSQ, int row, float& ra, float& rs) {
        const f32x4* p = (const f32x4*)(SSQ + (size_t)row * 32);
        const f32x4 a0 = p[0], a1 = p[1], s0 = p[2], s1 = p[3], s2 = p[4], s3 = p[5];
        const float sa = (a0[0] + a0[1]) + (a0[2] + a0[3]) + (a1[0] + a1[1]) + (a1[2] + a1[3]);
        const f32x4 st = (s0 + s1) + (s2 + s3); const float ssum = (st[0] + st[1]) + (st[2] + st[3]);
        ra = 1.0f / sqrtf(sa * (1.0f / AW) + EPS); rs = 1.0f / sqrtf(ssum * (1.0f / SW) + EPS);
    }
    __device__ __forceinline__ void mid(f32x4 (&acc)[2][2][4][2], const Unit& u, int wr, int fr) const {
#pragma unroll
        for (int ai = 0; ai < 2; ++ai)
#pragma unroll
            for (int m = 0; m < 4; ++m) { const float f = rtab[2 * (ai * HALF + wr * 64 + m * 16 + fr)];
#pragma unroll
                for (int bj = 0; bj < 2; ++bj)
#pragma unroll
                    for (int n = 0; n < 2; ++n) acc[ai][bj][m][n] *= f; }
    }
    __device__ __forceinline__ void operator()(const f32x4 (&acc)[2][2][4][2], const Unit& u, int wr, int wc, int fr, int fq) const {
        const int col0 = u.pn * BM + wc * 32 + 4 * fq;
        f32x4 gv[2][2];
#pragma unroll
        for (int bj = 0; bj < 2; ++bj)
#pragma unroll
            for (int n = 0; n < 2; ++n) gv[bj][n] = *(const f32x4*)(gt1 + col0 + bj * HALF + n * 16);
#pragma unroll
        for (int ai = 0; ai < 2; ++ai)
#pragma unroll
            for (int m = 0; m < 4; ++m) { const int rl = ai * HALF + wr * 64 + m * 16 + fr, row = u.pm * BM + rl; const float rs = rtab[2 * rl + 1];
                const size_t off = (size_t)row * DM + col0;
#pragma unroll
                for (int bj = 0; bj < 2; ++bj)
#pragma unroll
                    for (int n = 0; n < 2; ++n) { const f32x4 xv = *(const f32x4*)(X + off + bj * HALF + n * 16);
                        *(f32x4*)(OUT + off + bj * HALF + n * 16) = xv + gv[bj][n] * (acc[ai][bj][m][n] * rs); } }
    }
};

struct EpiUp {
    static constexpr bool PERM = true, AFTER_DRAIN = false, MIDK = false;
    bf16_t* ABUF; bf16_t* BBUF;
    __device__ __forceinline__ void mid(f32x4 (&)[2][2][4][2], const Unit&, int, int) const {}
    __device__ __forceinline__ void operator()(const f32x4 (&acc)[2][2][4][2], const Unit& u, int wr, int wc, int fr, int fq) const {
        const int row0 = u.pm * BM + wr * 64 + fr, col0 = u.pn * HALF + wc * 32 + 8 * fq;
#pragma unroll
        for (int bj = 0; bj < 2; ++bj) { bf16_t* base = (bj == 0 ? ABUF : BBUF) + col0;
#pragma unroll
            for (int ai = 0; ai < 2; ++ai)
#pragma unroll
                for (int m = 0; m < 4; ++m) { const int row = row0 + ai * HALF + m * 16; *(u32x4*)(base + (size_t)row * DFF) = pack8(acc[ai][bj][m][0], acc[ai][bj][m][1]); } }
    }
};

struct EpiDown {
    static constexpr bool PERM = false, AFTER_DRAIN = false, MIDK = false;
    const float* gt2; float* OUT; float* SSQ2;
    __device__ __forceinline__ void mid(f32x4 (&)[2][2][4][2], const Unit&, int, int) const {}
    __device__ __forceinline__ void operator()(const f32x4 (&acc)[2][2][4][2], const Unit& u, int wr, int wc, int fr, int fq) const {
        const int col0 = u.pn * BM + wc * 32 + 4 * fq;
        f32x4 gv[2][2];
#pragma unroll
        for (int bj = 0; bj < 2; ++bj)
#pragma unroll
            for (int n = 0; n < 2; ++n) gv[bj][n] = *(const f32x4*)(gt2 + col0 + bj * HALF + n * 16);
#pragma unroll
        for (int ai = 0; ai < 2; ++ai)
#pragma unroll
            for (int m = 0; m < 4; ++m) { const int row = u.pm * BM + ai * HALF + wr * 64 + m * 16 + fr; const size_t off = (size_t)row * DM + col0; float s = 0.f;
#pragma unroll
                for (int bj = 0; bj < 2; ++bj)
#pragma unroll
                    for (int n = 0; n < 2; ++n) { const f32x4 hv = *(const f32x4*)(OUT + off + bj * HALF + n * 16);
                        const f32x4 o = hv + gv[bj][n] * acc[ai][bj][m][n]; s += (o[0] * o[0] + o[1] * o[1]) + (o[2] * o[2] + o[3] * o[3]);
                        *(f32x4*)(OUT + off + bj * HALF + n * 16) = o; }
                s += __shfl_xor(s, 16); s += __shfl_xor(s, 32);
                if (fq == 0) SSQ2[(size_t)row * 32 + u.pn * 4 + wc] = s; }
    }
};
}
#include <hip/hip_bf16.h>
namespace att {
#define BIAS_LAS __attribute__((address_space(3)))
using bf16 = __hip_bfloat16;
typedef short bf16x8 __attribute__((ext_vector_type(8)));
typedef short s16x4 __attribute__((ext_vector_type(4)));
typedef float f32x16 __attribute__((ext_vector_type(16)));
typedef float f32x4 __attribute__((ext_vector_type(4)));
typedef unsigned u32x4 __attribute__((ext_vector_type(4)));
template <class A, class Bt> struct same_t { static constexpr bool v = false; };
template <class A> struct same_t<A, A> { static constexpr bool v = true; };
constexpr int D = 128, LDO = 2048;
constexpr float SCALE = 0.08838834764831845f;
constexpr float THR = 8.f;
constexpr bool WSKIP = false;
constexpr bool SEAM_PREFETCH = false;
constexpr int NW = 8, QBLK = 32, KVBLK = 64, QB = NW * QBLK;
constexpr int SHM_V = KVBLK * D * 2, SHM_K = KVBLK * D * 2;
constexpr int ATT_LDS = 2 * SHM_V + 2 * SHM_K + NW * 64 * 4;
constexpr int BIAS_OFF = 69632;
#define KSWZ(row, colB) ((row) * 256 + ((colB) ^ (((row) & 7) << 4)))
#define SBAR() __builtin_amdgcn_sched_barrier(0)
__device__ __forceinline__ int v_st(int k, int c) { const int kk = (k & ~0xC) | ((k & 4) << 1) | ((k & 8) >> 1); return ((kk >> 3) * 4 + (c >> 5)) * 512 + ((kk & 7) * 32 + (c & 31)) * 2; }
__device__ __forceinline__ int v_rd_base(int lane) { return ((lane & 3) << 3) | (((lane >> 2) & 3) << 6) | (((lane >> 4) & 1) << 5) | (((lane >> 5) & 1) << 8); }
constexpr int v_rd_off(int d0, int ks, int half) { return d0 * 512 + ks * 4096 + half * 2048; }
__device__ __forceinline__ int crow(int r, int hi) { return (r & 3) + 8 * (r >> 2) + 4 * hi; }
__device__ __forceinline__ unsigned cvtpk(float lo, float hi) {
    unsigned r; asm volatile("v_cvt_pk_bf16_f32 %0, %1, %2" : "=v"(r) : "v"(lo), "v"(hi)); return r;
}
__device__ __forceinline__ bf16x8 pack8(f32x4 a, f32x4 b) {
    u32x4 w = {cvtpk(a[0], a[1]), cvtpk(a[2], a[3]), cvtpk(b[0], b[1]), cvtpk(b[2], b[3])};
    return *reinterpret_cast<bf16x8*>(&w);
}
template <class T> __device__ __forceinline__ bf16x8 load8(const T* p) {
    if constexpr (same_t<T, float>::v) { return pack8(*(const f32x4*)p, *(const f32x4*)(p + 4)); }
    else { return *reinterpret_cast<const bf16x8*>(p); }
}
__device__ __forceinline__ void mask_tile(f32x16& p0, f32x16& p1, int dq, unsigned W) {
    const float NEG = -__builtin_inff();
#pragma unroll
    for (int r = 0; r < 16; ++r) {
        const int c = (r & 3) + 8 * (r >> 2);
        if ((unsigned)(dq - c) >= W) p0[r] = NEG;
        if ((unsigned)(dq - c - 32) >= W) p1[r] = NEG;
    }
}
__device__ __forceinline__ void partialSM(f32x16& p0, f32x16& p1, float& m_reg, float& mn, float& alpha) {
    float pmax = p0[0]; for (int r = 1; r < 16; ++r) pmax = fmaxf(pmax, p0[r]); for (int r = 0; r < 16; ++r) pmax = fmaxf(pmax, p1[r]);
    { auto rr = __builtin_amdgcn_permlane32_swap(__float_as_uint(pmax), __float_as_uint(pmax), false, false);
      pmax = fmaxf(__uint_as_float(rr[0]), __uint_as_float(rr[1])); }
    constexpr float C2 = 1.4426950408889634f * SCALE;
    if (__builtin_expect(__all((pmax - m_reg) * SCALE <= THR), 1)) { mn = m_reg; alpha = 1.f; }
    else { mn = fmaxf(m_reg, pmax); alpha = __builtin_amdgcn_exp2f((m_reg - mn) * C2); m_reg = mn; }
    const float mnL = -mn * C2;
    for (int r = 0; r < 16; ++r) p0[r] = fmaf(p0[r], C2, mnL); for (int r = 0; r < 16; ++r) p1[r] = fmaf(p1[r], C2, mnL);
    for (int r = 0; r < 16; ++r) p0[r] = __builtin_amdgcn_exp2f(p0[r]);
}
__device__ __forceinline__ void finishSM(f32x16& p0, f32x16& p1, float alpha, float& l_reg, bf16x8& pa0, bf16x8& pa1, bf16x8& pa2, bf16x8& pa3) {
    for (int r = 0; r < 16; ++r) p1[r] = __builtin_amdgcn_exp2f(p1[r]);
    float ps = 0; for (int r = 0; r < 16; ++r) ps += p0[r]; for (int r = 0; r < 16; ++r) ps += p1[r];
    { auto rr = __builtin_amdgcn_permlane32_swap(__float_as_uint(ps), __float_as_uint(ps), false, false);
      ps = __uint_as_float(rr[0]) + __uint_as_float(rr[1]); }
    l_reg = l_reg * alpha + ps;
#define PK4(P, B_, OUT) do { unsigned a0 = cvtpk(P[B_+0], P[B_+1]), a1 = cvtpk(P[B_+2], P[B_+3]);                          \
        unsigned b0 = cvtpk(P[B_+4], P[B_+5]), b1 = cvtpk(P[B_+6], P[B_+7]);                                             \
        auto r0 = __builtin_amdgcn_permlane32_swap(a0, b0, false, false); auto r1 = __builtin_amdgcn_permlane32_swap(a1, b1, false, false); \
        u32x4 w = {r0[0], r1[0], r0[1], r1[1]}; OUT = *reinterpret_cast<bf16x8*>(&w); } while (0)
    PK4(p0, 0, pa0); PK4(p0, 8, pa1); PK4(p1, 0, pa2); PK4(p1, 8, pa3);
#undef PK4
}
template <int KB, bool SK>
__device__ __forceinline__ void qkt(f32x16& p0, f32x16& p1, const char* K_lds, int r32, int hi, const bf16x8* qr, bool act, const BIAS_LAS float* bp) {
    if (SK && !act) { const float NEG = -__builtin_inff();
#pragma unroll
        for (int r = 0; r < 16; ++r) { p0[r] = NEG; p1[r] = NEG; } return; }
#ifdef NOBIAS
    p0 = f32x16{}; p1 = f32x16{};
#else
    { const BIAS_LAS f32x4* b4 = (const BIAS_LAS f32x4*)bp;
      const f32x4 t0 = b4[0], t1 = b4[2], t2 = b4[4], t3 = b4[6], t4 = b4[8], t5 = b4[10], t6 = b4[12], t7 = b4[14];
      p0 = f32x16{t0[0], t0[1], t0[2], t0[3], t1[0], t1[1], t1[2], t1[3], t2[0], t2[1], t2[2], t2[3], t3[0], t3[1], t3[2], t3[3]};
      p1 = f32x16{t4[0], t4[1], t4[2], t4[3], t5[0], t5[1], t5[2], t5[3], t6[0], t6[1], t6[2], t6[3], t7[0], t7[1], t7[2], t7[3]}; }
#endif
    const char* kb[4];
#pragma unroll
    for (int dd = 0; dd < 4; ++dd) kb[dd] = K_lds + KB * SHM_K + KSWZ(r32, (dd * 16 + hi * 8) * 2);
#pragma unroll
    for (int d0 = 0; d0 < 8; ++d0) { const char* a = kb[d0 & 3] + (d0 >> 2) * 128;
        bf16x8 b0 = *reinterpret_cast<const bf16x8*>(a);
        bf16x8 b1 = *reinterpret_cast<const bf16x8*>(a + 32 * 256);
        p0 = __builtin_amdgcn_mfma_f32_32x32x16_bf16(b0, qr[d0], p0, 0, 0, 0);
        p1 = __builtin_amdgcn_mfma_f32_32x32x16_bf16(b1, qr[d0], p1, 0, 0, 0); }
}
template <int VB, bool SK>
__device__ __forceinline__ void pv_tile(f32x16* o, int vb0, bf16x8 pa0, bf16x8 pa1, bf16x8 pa2, bf16x8 pa3, bool act) {
    if (SK && !act) return;
#define TRRD(dst, off) asm volatile("ds_read_b64_tr_b16 %0, %1 offset:%2" : "=&v"(dst) : "v"(vb0), "i"(off) : "memory")
#define PV_D0(d0) do { s16x4 l0, l1, l2, l3, h0, h1, h2, h3; constexpr int b_ = VB * SHM_V + v_rd_off(d0, 0, 0);     \
        TRRD(l0, b_); TRRD(h0, b_ + 2048); TRRD(l1, b_ + 4096); TRRD(h1, b_ + 6144); TRRD(l2, b_ + 8192); TRRD(h2, b_ + 10240); TRRD(l3, b_ + 12288); TRRD(h3, b_ + 14336); \
        asm volatile("s_waitcnt lgkmcnt(0)" ::: "memory"); SBAR();                 \
        o[d0] = __builtin_amdgcn_mfma_f32_32x32x16_bf16(pa0, (bf16x8){l0[0], l0[1], l0[2], l0[3], h0[0], h0[1], h0[2], h0[3]}, o[d0], 0, 0, 0);   \
        o[d0] = __builtin_amdgcn_mfma_f32_32x32x16_bf16(pa1, (bf16x8){l1[0], l1[1], l1[2], l1[3], h1[0], h1[1], h1[2], h1[3]}, o[d0], 0, 0, 0);   \
        o[d0] = __builtin_amdgcn_mfma_f32_32x32x16_bf16(pa2, (bf16x8){l2[0], l2[1], l2[2], l2[3], h2[0], h2[1], h2[2], h2[3]}, o[d0], 0, 0, 0);   \
        o[d0] = __builtin_amdgcn_mfma_f32_32x32x16_bf16(pa3, (bf16x8){l3[0], l3[1], l3[2], l3[3], h3[0], h3[1], h3[2], h3[3]}, o[d0], 0, 0, 0); } while (0)
    PV_D0(0); PV_D0(1); PV_D0(2); PV_D0(3);
#undef PV_D0
#undef TRRD
}
template <class TIn, class TOut> struct BlockRef { const TIn* Q; const TIn* K; const TIn* V; TOut* O; int P0; int JLO; float* SSQ; };
template <class TIn> struct Seam {
    bf16x8 qr[8];
    bf16x8 st_v0, st_v1, st_k0, st_k1; f32x4 sf0, sf1, sf2, sf3;
    f32x4 tq[16];
};
#define ROW(p, k0, rr) ((p) + (size_t)((k0) + (rr)) * D + sc)
#define VMW() asm volatile("s_waitcnt vmcnt(0)" ::: "memory")
#define VMWN(n) asm volatile("s_waitcnt vmcnt(%0)" :: "i"(n) : "memory")
#define SLOAD_H(Kp, Vp, k0) do { S.st_v0 = load8<TIn>(ROW(Vp, k0, sr)); S.st_v1 = load8<TIn>(ROW(Vp, k0, 32 + sr));              \
                         S.st_k0 = load8<TIn>(ROW(Kp, k0, sr)); S.st_k1 = load8<TIn>(ROW(Kp, k0, 32 + sr)); } while (0)
#define SWRITE_HK(bf) do { *(bf16x8*)(K_lds + (bf) * SHM_K + kws) = S.st_k0; *(bf16x8*)(K_lds + (bf) * SHM_K + kws + 32 * 256) = S.st_k1; } while (0)
#define SWRITE_HV(bf) do { *(bf16x8*)(V_lds + (bf) * SHM_V + vst0) = S.st_v0; *(bf16x8*)(V_lds + (bf) * SHM_V + vst1) = S.st_v1; } while (0)
#define SWRITE_H(bf) do { SWRITE_HV(bf); SWRITE_HK(bf); } while (0)
#define SLOAD_F(p, k0) do { S.sf0 = *(const f32x4*)ROW(p, k0, sr); S.sf1 = *(const f32x4*)(ROW(p, k0, sr) + 4);                \
                            S.sf2 = *(const f32x4*)ROW(p, k0, 32 + sr); S.sf3 = *(const f32x4*)(ROW(p, k0, 32 + sr) + 4); } while (0)
#define SWRITE_KF(bf) do { *(bf16x8*)(K_lds + (bf) * SHM_K + kws) = pack8(S.sf0, S.sf1); *(bf16x8*)(K_lds + (bf) * SHM_K + kws + 32 * 256) = pack8(S.sf2, S.sf3); } while (0)
#define SWRITE_VF(bf) do { *(bf16x8*)(V_lds + (bf) * SHM_V + vst0) = pack8(S.sf0, S.sf1); *(bf16x8*)(V_lds + (bf) * SHM_V + vst1) = pack8(S.sf2, S.sf3); } while (0)
template <class TIn, class TOut>
__device__ __forceinline__ void causal_swa_prime(const BlockRef<TIn, TOut>& cur, int W, char* lds, Seam<TIn>& S, const int wv) {
    constexpr bool F32 = same_t<TIn, float>::v;
    int tid_ = wv * 64 + ((int)__builtin_amdgcn_mbcnt_hi(~0u, __builtin_amdgcn_mbcnt_lo(~0u, 0u))); asm volatile("" : "+v"(tid_));
    const int tid = tid_, wid = __builtin_amdgcn_readfirstlane(tid >> 6), lane = tid & 63, r32 = lane & 31, hi = lane >> 5;
    const int sr = tid >> 4, sc = (tid & 15) * 8, kws = KSWZ(sr, sc * 2); char* K_lds = lds + 2 * SHM_V;
    const int kb0 = cur.JLO * KVBLK;
    for (int d0 = 0; d0 < 8; ++d0) S.qr[d0] = load8<TIn>(cur.Q + (size_t)(wid * QBLK + r32) * D + d0 * 16 + hi * 8);
    if constexpr (F32) { SLOAD_F((const float*)cur.K, kb0); VMW(); SWRITE_KF(0); SBAR(); SLOAD_F((const float*)cur.V, kb0); }
    else { SLOAD_H(cur.K, cur.V, kb0); VMW(); SWRITE_HK(0); }
    __syncthreads();
}
template <class TIn, class TOut>
__device__ __forceinline__ void causal_swa_block(const BlockRef<TIn, TOut>& cur, const BlockRef<TIn, TOut>& nxt, int skv, int W, char* lds, Seam<TIn>& S, const BIAS_LAS float* bias, const int wv) {
    constexpr bool F32 = same_t<TIn, float>::v;
    int tid_ = wv * 64 + ((int)__builtin_amdgcn_mbcnt_hi(~0u, __builtin_amdgcn_mbcnt_lo(~0u, 0u))); asm volatile("" : "+v"(tid_));
    const int tid = tid_, wid = __builtin_amdgcn_readfirstlane(tid >> 6), lane = tid & 63, r32 = lane & 31, hi = lane >> 5;
    const int j_lo = cur.JLO; const BIAS_LAS float* bias4 = bias + 4 * hi;
    int j_hi = (cur.P0 + QB - 1) / KVBLK + 1; if (j_hi > skv / KVBLK) j_hi = skv / KVBLK;
    const int NT = j_hi - j_lo;
    const int kbn = nxt.JLO * KVBLK;
    const int qlo = cur.P0 + wid * QBLK, qm = qlo + r32 - 4 * hi;
    char* V_lds = lds; char* K_lds = lds + 2 * SHM_V;
    float* ws = (float*)(lds + 2 * SHM_V + 2 * SHM_K) + wid * 64; float* li_l = ws, * al_l = ws + 32;
    float m_reg = -1e30f, l_reg = 0; f32x16 o[4] = {};
    const int sr = tid >> 4, sc = (tid & 15) * 8, vst0 = v_st(sr, sc), vst1 = v_st(32 + sr, sc), kws = KSWZ(sr, sc * 2);
    const int vb0 = (int)(uintptr_t)V_lds + v_rd_base(lane);
    const TIn* Kh = cur.K; const TIn* Vh = cur.V;
#define RESC(a) do { if (__any((a) < 1.f)) { if (hi == 0) al_l[r32] = (a); asm volatile("s_waitcnt lgkmcnt(0)" ::: "memory");              \
                     for (int d_ = 0; d_ < 4; ++d_) for (int r = 0; r < 16; ++r) o[d_][r] *= al_l[crow(r, hi)]; } } while (0)
#define KBASE(t) ((j_lo + (t)) * KVBLK)
#define BP(t) (bias4 + (t) * KVBLK)
#define ACT(t) (KBASE(t) <= qlo + QBLK - 1 && KBASE(t) + KVBLK - 1 >= qlo - W + 1)
#define MASKT(P0_, P1_, t) do { const int kb_ = KBASE(t); if ((!SK || ACT(t)) && (kb_ + KVBLK - 1 > qlo || kb_ <= qlo + QBLK - 1 - W)) mask_tile(P0_, P1_, qm - kb_, (unsigned)W); } while (0)
    constexpr int NQL = F32 ? 16 : 8;
    constexpr bool SK = WSKIP && !F32;
#define SEAM_K0() do { VMWN(NQL); if constexpr (F32) { SWRITE_KF(0); SBAR(); SLOAD_F((const float*)nxt.V, kbn); } else { SWRITE_HK(0); } SBAR(); } while (0)
    f32x16 pA0, pA1, pB0, pB1; float mnA, mnB, alA, alB; bf16x8 pa0, pa1, pa2, pa3;
    if constexpr (F32) { VMW(); SWRITE_VF(0); SBAR(); } else { SWRITE_HV(0); SBAR(); }
    if (NT > 1) { if constexpr (F32) SLOAD_F((const float*)Kh, KBASE(1)); else SLOAD_H(Kh, Vh, KBASE(1)); }
    SBAR(); qkt<0, SK>(pA0, pA1, K_lds, r32, hi, S.qr, ACT(0), BP(0));
    if constexpr (F32) { if (NT > 1) { VMW(); SWRITE_KF(1); SBAR(); SLOAD_F((const float*)Vh, KBASE(1)); } }
    MASKT(pA0, pA1, 0); partialSM(pA0, pA1, m_reg, mnA, alA);
    if (NT > 1) { VMW(); if constexpr (F32) { SWRITE_VF(1); SBAR(); if (NT > 2) SLOAD_F((const float*)Kh, KBASE(2)); } else SWRITE_H(1); }
    __syncthreads();
#define HALF_STEP(PX0, PX1, mnX, alX, PY0, PY1, alY, t, KB, VB, SB) do {                                                      \
        SBAR(); qkt<KB, SK>(PX0, PX1, K_lds, r32, hi, S.qr, ACT(t), BP(t));                                             \
        finishSM(PY0, PY1, alY, l_reg, pa0, pa1, pa2, pa3); SBAR();                                                           \
        if ((t) + 1 < NT) { if constexpr (F32) { VMW(); SWRITE_KF(SB); SBAR(); SLOAD_F((const float*)Vh, KBASE((t) + 1)); }  \
                            else { SLOAD_H(Kh, Vh, KBASE((t) + 1)); } SBAR(); }                                               \
        pv_tile<VB, SK>(o, vb0, pa0, pa1, pa2, pa3, ACT((t) - 1)); MASKT(PX0, PX1, (t)); partialSM(PX0, PX1, m_reg, mnX, alX);                                        \
        __syncthreads();                                                                                                      \
        if ((t) + 1 < NT) { VMW(); if constexpr (F32) { SWRITE_VF(SB); SBAR(); if ((t) + 2 < NT) SLOAD_F((const float*)Kh, KBASE((t) + 2)); } \
                            else { SWRITE_H(SB); } }                                                                          \
        RESC(alX); __syncthreads(); } while (0)
    for (int t = 1; t + 1 < NT; t += 2) {
        HALF_STEP(pB0, pB1, mnB, alB, pA0, pA1, alA, t, 1, 0, 0);
        HALF_STEP(pA0, pA1, mnA, alA, pB0, pB1, alB, t + 1, 0, 1, 1);
    }
    const bool even = (NT & 1) == 0;
    if (even) { SBAR(); qkt<1, SK>(pB0, pB1, K_lds, r32, hi, S.qr, ACT(NT - 1), BP(NT - 1)); SBAR(); }
#define QROW(e) (nxt.Q + (size_t)(wid * QBLK + r32) * D + ((e) >> 1) * 16 + hi * 8 + ((e) & 1) * 4)
    if constexpr (F32) { SLOAD_F((const float*)nxt.K, kbn); SBAR();
#pragma unroll
        for (int e = 0; e < 8; ++e) S.tq[e] = *(const f32x4*)QROW(e); }
    else if constexpr (SEAM_PREFETCH) { SLOAD_H(nxt.K, nxt.V, kbn); SBAR();
#pragma unroll
        for (int d0 = 0; d0 < 8; ++d0) S.qr[d0] = load8<TIn>(nxt.Q + (size_t)(wid * QBLK + r32) * D + d0 * 16 + hi * 8); }
    SBAR();
    finishSM(pA0, pA1, alA, l_reg, pa0, pa1, pa2, pa3); SBAR();
    if constexpr (F32) {
#pragma unroll
        for (int e = 8; e < 16; ++e) S.tq[e] = *(const f32x4*)QROW(e); SBAR(); }
#undef QROW
    pv_tile<0, SK>(o, vb0, pa0, pa1, pa2, pa3, ACT(even ? NT - 2 : NT - 1));
    if (even) { MASKT(pB0, pB1, NT - 1); partialSM(pB0, pB1, m_reg, mnB, alB); __syncthreads(); RESC(alB);
        finishSM(pB0, pB1, alB, l_reg, pa0, pa1, pa2, pa3); SBAR(); pv_tile<1, SK>(o, vb0, pa0, pa1, pa2, pa3, ACT(NT - 1)); }
    SBAR(); if constexpr (SEAM_PREFETCH) SEAM_K0();
    if (hi == 0) li_l[r32] = l_reg; asm volatile("s_waitcnt lgkmcnt(0)" ::: "memory");
    float rli[16];
#pragma unroll
    for (int r = 0; r < 16; ++r) rli[r] = __builtin_amdgcn_rcpf(li_l[crow(r, hi)]);
    TOut* Ow = cur.O + (size_t)(wid * QBLK) * LDO;
#pragma unroll
    for (int r = 0; r < 16; ++r) { int orow = crow(r, hi); asm volatile("" : "+v"(orow)); float sq = 0.f;
#pragma unroll
        for (int d0 = 0; d0 < 4; ++d0) { const float v = o[d0][r] * rli[r]; sq += v * v;
            { const float vn = __shfl_xor(v, 1);
                   if ((r32 & 1) == 0) *(unsigned*)(Ow + (size_t)orow * LDO + d0 * 32 + r32) = cvtpk(v, vn); } }
        sq += __shfl_xor(sq, 1); sq += __shfl_xor(sq, 2); sq += __shfl_xor(sq, 4); sq += __shfl_xor(sq, 8); sq += __shfl_xor(sq, 16);
        if (r32 == 0) cur.SSQ[(size_t)(wid * QBLK + orow) * 32] = sq; }
    if constexpr (F32) {
#pragma unroll
        for (int d0 = 0; d0 < 8; ++d0) S.qr[d0] = pack8(S.tq[2 * d0], S.tq[2 * d0 + 1]); }
    __syncthreads();
#undef RESC
#undef KBASE
#undef BP
#undef ACT
#undef MASKT
#undef SEAM_K0
#undef HALF_STEP
}
#undef ROW
#undef VMW
#undef VMWN
#undef SLOAD_H
#undef SWRITE_HK
#undef SWRITE_HV
#undef SWRITE_H
#undef SLOAD_F
#undef SWRITE_KF
#undef SWRITE_VF
}
#define LAS __attribute__((address_space(3)))
typedef unsigned short bf16_t;
struct Args { const float* in[26]; float* out; unsigned char* ws; };

#define XB_TMO      128
#define XB_XCNT(j)  (256  + 64 * (j))
#define XB_XSUB(j)  (1280 + 64 * (j))
#define XB_XGEN(j)  (2304 + 64 * (j))
#define XB_TOP      3328
#define XB_TOPGEN   3392
#define XCD_BAR_WORDS 3456
#define XB_SPIN_CAP (1u << 18)

__device__ __forceinline__ unsigned xb_ld(unsigned* p)              { return __hip_atomic_load(p, __ATOMIC_RELAXED, __HIP_MEMORY_SCOPE_AGENT); }
__device__ __forceinline__ unsigned xb_add(unsigned* p, unsigned v) { return __hip_atomic_fetch_add(p, v, __ATOMIC_RELAXED, __HIP_MEMORY_SCOPE_AGENT); }
__device__ __forceinline__ unsigned xb_xcc_id() { return (unsigned)__builtin_amdgcn_s_getreg((3 << 11) | 20) & 0xFu; }
#define XB_SPIN(cond, bar) do { unsigned _sp = 0; while (cond) { __builtin_amdgcn_s_sleep(1); \
    if ((++_sp & 255u) == 0u) { if (xb_ld(&(bar)[XB_TMO])) break; if (_sp > XB_SPIN_CAP) { atomicAdd(&(bar)[XB_TMO], 1u); break; } } } } while (0)

struct XcdBarrier {
    unsigned* bar; unsigned x;
    volatile LAS unsigned* st;
};

__device__ __forceinline__ XcdBarrier xcd_barrier_post(unsigned* bar, volatile LAS unsigned* st, bool t0) {
    XcdBarrier b; b.bar = bar; b.x = xb_xcc_id(); b.st = st;
    if (t0) (void)xb_add(&bar[XB_XCNT(b.x)], 1u);
    return b;
}
__device__ __forceinline__ void xcd_barrier_complete(unsigned* bar, unsigned x, unsigned& nloc, unsigned& nx) {
    const unsigned G = gridDim.x * gridDim.y * gridDim.z;
    unsigned sum, cnt, mine, sp = 0u;
    for (;;) {
        sum = 0u; cnt = 0u; mine = 0u;
#pragma unroll
        for (unsigned j = 0; j < 16; ++j) { const unsigned c = xb_ld(&bar[XB_XCNT(j)]); sum += c; cnt += (c > 0u) ? 1u : 0u; mine = (j == x) ? c : mine; }
        if (sum == G) break;
        __builtin_amdgcn_s_sleep(1);
        if ((++sp & 255u) == 0u) { if (xb_ld(&bar[XB_TMO])) break; if (sp > XB_SPIN_CAP) { atomicAdd(&bar[XB_TMO], 1u); break; } }
    }
    nloc = mine > 0u ? mine : 1u; nx = cnt > 0u ? cnt : 1u;
}

__device__ __forceinline__ void xcd_barrier(const XcdBarrier& b, bool t0) {
    asm volatile("s_waitcnt vmcnt(0)" ::: "memory");
    __syncthreads();
    if (t0) {
        unsigned* bar = b.bar;
        __builtin_amdgcn_s_waitcnt(0);
        unsigned nloc = b.st[0], nx = b.st[1];
        if (nloc == 0u) { xcd_barrier_complete(bar, b.x, nloc, nx); b.st[0] = nloc; b.st[1] = nx; }
        const unsigned old = xb_add(&bar[XB_XSUB(b.x)], 1u);
        const unsigned gen = old / nloc;
        if (old + 1u == (gen + 1u) * nloc) {
            __builtin_amdgcn_fence(__ATOMIC_RELEASE, "agent");
            asm volatile("s_waitcnt vmcnt(0)" ::: "memory");
            const unsigned og = xb_add(&bar[XB_TOP], 1u);
            const unsigned tg = og / nx;
            if (og + 1u == (tg + 1u) * nx) xb_add(&bar[XB_TOPGEN], 1u);
            else XB_SPIN(xb_ld(&bar[XB_TOPGEN]) == tg, bar);
            __builtin_amdgcn_fence(__ATOMIC_ACQUIRE, "agent");
            xb_add(&bar[XB_XGEN(b.x)], 1u);
            asm volatile("s_waitcnt vmcnt(0)" ::: "memory");
        } else {
            XB_SPIN(xb_ld(&bar[XB_XGEN(b.x)]) == gen, bar);
            __builtin_amdgcn_fence(__ATOMIC_ACQUIRE, "agent");
            asm volatile("s_waitcnt vmcnt(0)" ::: "memory");
        }
    }
    __syncthreads();
}

__device__ __forceinline__ float wave_sum(float v) {
#pragma unroll
    for (int o = 1; o < 64; o <<= 1) v += __shfl_xor(v, o);
    return v;
}
__device__ __forceinline__ unsigned pk2(float lo, float hi) { return pg8::cvt_pk_bf16(lo, hi); }

__device__ __forceinline__ void tr_item(const float* __restrict__ W, int ldw, int srccol0, int k0, bf16_t* __restrict__ WT, int K, int dstrow0,
                                        const float* rs0, const float* rs1, LAS float* scr, int lane) {
#pragma unroll 8
    for (int i = 0; i < 32; ++i) { const int kk = 2 * i + (lane >> 5); float v = W[(size_t)(k0 + kk) * ldw + srccol0 + (lane & 31)];
        if (rs0) { const int k = k0 + kk; v *= (k < 1024 ? rs0[k] : rs1[k - 1024]); }
        scr[kk * 33 + (lane & 31)] = v; }
    asm volatile("s_waitcnt lgkmcnt(0)" ::: "memory");
    const int c = lane & 7;
#pragma unroll
    for (int j = 0; j < 4; ++j) { const int n = (lane >> 3) + 8 * j; const LAS float* s = scr + (8 * c) * 33 + n;
        u32x4_t o; o.x = pk2(s[0 * 33], s[1 * 33]); o.y = pk2(s[2 * 33], s[3 * 33]); o.z = pk2(s[4 * 33], s[5 * 33]); o.w = pk2(s[6 * 33], s[7 * 33]);
        *(u32x4_t*)(WT + (size_t)(dstrow0 + n) * K + k0 + 8 * c) = o; }
    asm volatile("s_waitcnt lgkmcnt(0)" ::: "memory");
}

__device__ __forceinline__ void ssm_setup_item(const Args& a, unsigned char* ws, LAS unsigned char* lds, int g, int qtr, int tid) {
    LAS float* Bre = (LAS float*)lds; LAS float* Bim = Bre + 1024; LAS float* Cre = Bre + 2048; LAS float* Cim = Bre + 3072;
    LAS float* Pr = Bre + 4096; LAS float* Pi = Pr + 33 * 64; LAS float* MZr = Pi + 33 * 64; LAS float* MZi = MZr + 32 * 64; LAS float* KT = MZi + 32 * 64;
    const float* b_re = a.in[10] + (size_t)g * 1024; const float* b_im = a.in[11] + (size_t)g * 1024;
    const float* c_re = a.in[12] + (size_t)g * 1024; const float* c_im = a.in[13] + (size_t)g * 1024;
    for (int i = tid; i < 1024; i += 512) { Bre[i] = b_re[i]; Bim[i] = b_im[i]; Cre[i] = c_re[i]; Cim[i] = c_im[i]; }
    if (tid < 64) {
        const int p = tid; const float dt = expf(a.in[9][g]); const float ar = a.in[7][g * NP + p], ai = a.in[8][g * NP + p];
        const float mag = expf(dt * ar); const float abr = mag * cosf(dt * ai), abi = mag * sinf(dt * ai);
        const float nre = abr - 1.f, nim = abi, den = ar * ar + ai * ai;
        const float zr = (nre * ar + nim * ai) / den, zi = (nim * ar - nre * ai) / den;
        float pr = 1.f, pi = 0.f;
        for (int j = 0; j <= 32; ++j) {
            Pr[j * 64 + p] = pr; Pi[j * 64 + p] = pi;
            if (j < 32) { MZr[j * 64 + p] = pr * zr - pi * zi; MZi[j * 64 + p] = pr * zi + pi * zr; }
            const float nr = pr * abr - pi * abi, ni = pr * abi + pi * abr; pr = nr; pi = ni;
        }
        if (qtr == 0) { float* P32 = (float*)(ws + WS_P32); P32[(g * NP + p) * 2] = Pr[32 * 64 + p]; P32[(g * NP + p) * 2 + 1] = Pi[32 * 64 + p]; }
    }
    __syncthreads();
    const float* dsk = a.in[14] + g * GCH;
    for (int idx = tid; idx < 8192; idx += 512) {
        const int j = idx >> 8, h = (idx >> 4) & 15, i = idx & 15; float sum = 0.f;
        for (int p = 0; p < 64; ++p) { const float mr = MZr[j * 64 + p], mi = MZi[j * 64 + p], br = Bre[p * 16 + i], bi = Bim[p * 16 + i];
            const float bzr = mr * br - mi * bi, bzi = mr * bi + mi * br; sum += Cre[h * 64 + p] * bzr - Cim[h * 64 + p] * bzi; }
        if (j == 0 && h == i) sum += dsk[h];
        KT[idx] = sum;
    }
    __syncthreads();
    bf16_t* GC = (bf16_t*)(ws + WS_GC) + (size_t)g * 512 * KA;
    for (int ci = tid; ci < 128 * 80; ci += 512) {
        const int nl = ci / 80, ch = ci - nl * 80, n = qtr * 128 + nl, t = n >> 4, h = n & 15; float v[8];
        if (ch < 64) { const int s = ch >> 1, i0 = (ch & 1) * 8;
#pragma unroll
            for (int e = 0; e < 8; ++e) v[e] = (s <= t) ? KT[((t - s) << 8) + (h << 4) + i0 + e] : 0.f;
        } else { const int pp = (ch - 64) * 8;
#pragma unroll
            for (int e = 0; e < 8; ++e) { const int p = (pp + e) & 63; const float cr = Cre[h * 64 + p], cim = Cim[h * 64 + p], pr = Pr[(t + 1) * 64 + p], pi = Pi[(t + 1) * 64 + p];
                v[e] = (pp < 64) ? (cr * pr - cim * pi) : -(cr * pi + cim * pr); }
        }
        u32x4_t o; o.x = pk2(v[0], v[1]); o.y = pk2(v[2], v[3]); o.z = pk2(v[4], v[5]); o.w = pk2(v[6], v[7]);
        *(u32x4_t*)(GC + (size_t)n * KA + ch * 8) = o;
    }
    bf16_t* WE = (bf16_t*)(ws + WS_WEND) + (size_t)g * 256 * 512;
    for (int ci = tid; ci < 64 * 64; ci += 512) {
        const int rl = ci >> 6, ch = ci & 63, pr_ = qtr * 64 + rl, s = ch >> 1, i0 = (ch & 1) * 8, p = pr_ & 63; float v[8];
#pragma unroll
        for (int e = 0; e < 8; ++e) { const float mr = MZr[(31 - s) * 64 + p], mi = MZi[(31 - s) * 64 + p], br = Bre[p * 16 + i0 + e], bi = Bim[p * 16 + i0 + e];
            v[e] = (pr_ < 64) ? (mr * br - mi * bi) : ((pr_ < 128) ? (mr * bi + mi * br) : 0.f); }
        u32x4_t o; o.x = pk2(v[0], v[1]); o.y = pk2(v[2], v[3]); o.z = pk2(v[4], v[5]); o.w = pk2(v[6], v[7]);
        *(u32x4_t*)(WE + (size_t)pr_ * 512 + ch * 8) = o;
    }
    __syncthreads();
}

__device__ __forceinline__ void norm_mod_row(const float* xrow, bf16_t* orow, const LAS float* gs, const LAS float* shv, int lane, f32x4_t (&v)[8]) {
    const f32x4_t* xr = (const f32x4_t*)xrow + lane; float s = 0.f;
#pragma unroll
    for (int j = 0; j < 8; ++j) { v[j] = xr[64 * j]; s += (v[j][0] * v[j][0] + v[j][1] * v[j][1]) + (v[j][2] * v[j][2] + v[j][3] * v[j][3]); }
    const float rstd = 1.0f / sqrtf(wave_sum(s) * (1.0f / DM) + EPS);
#pragma unroll
    for (int j = 0; j < 8; ++j) { const int k = 4 * lane + 256 * j; const f32x4_t g4 = *(const LAS f32x4_t*)(gs + k), s4 = *(const LAS f32x4_t*)(shv + k);
        v[j] = v[j] * rstd * g4 + s4;
        u32x2_t o; o.x = pk2(v[j][0], v[j][1]); o.y = pk2(v[j][2], v[j][3]); *(u32x2_t*)(orow + k) = o; }
}

__global__ void __launch_bounds__(512, 2) fwd_kernel(Args a) {
    extern __shared__ __attribute__((aligned(16))) unsigned char lds_raw[];
    LAS unsigned char* lds = (LAS unsigned char*)lds_raw;
    const int wave = __builtin_amdgcn_readfirstlane((int)threadIdx.x >> 6), G = gridDim.x, bid = blockIdx.x;
#define lane ((int)__builtin_amdgcn_mbcnt_hi(~0u, __builtin_amdgcn_mbcnt_lo(~0u, 0u)))
#define tid (wave * 64 + lane)
    const int gw = bid * 8 + wave, NGW = G * 8;
    unsigned char* ws = a.ws;
    volatile LAS unsigned* xst = (volatile LAS unsigned*)(lds + LDS_BYTES - 64);
    if (tid < 2) xst[tid] = 0u;
    __syncthreads();
    XcdBarrier xbar = xcd_barrier_post((unsigned*)(ws + WS_CTL) + 4096, xst, tid == 0);
#define GRID_BAR() xcd_barrier(xbar, tid == 0)
#define MODP ((float*)(ws + WS_MODP))
#define MOD ((float*)(ws + WS_MOD))
#define LF ((float*)(ws + WS_LF))
#define CBR ((float*)(ws + WS_CBR))
#define SSQB ((float*)(ws + WS_SSQ))
#define SSQ2B ((float*)(ws + WS_SSQ2))
#define WDT ((bf16_t*)(ws + WS_WDT))
#define W1T ((bf16_t*)(ws + WS_W1T))
#define WGT ((bf16_t*)(ws + WS_WGT))
#define WOT ((bf16_t*)(ws + WS_WOT))
#define WUT ((bf16_t*)(ws + WS_WUT))
#define GC ((bf16_t*)(ws + WS_GC))
#define WEND ((bf16_t*)(ws + WS_WEND))
#define AALL ((bf16_t*)(ws + WS_AALL))
#define QKV ((bf16_t*)(ws + WS_QKV))
#define YB ((bf16_t*)(ws + WS_YB))
#define MIX ((bf16_t*)(ws + WS_MIX))
#define HN ((bf16_t*)(ws + WS_HN))
#define ABUF ((bf16_t*)(ws + WS_ABUF))
#define BBUF ((bf16_t*)(ws + WS_BBUF))
#define XIN (a.in[0])
#define OUT (a.out)


    {
        LAS f32x4_t* red = (LAS f32x4_t*)lds; const float* cvec = a.in[1]; const float* w_ada = a.in[2];
        for (int it = bid; it < 768; it += G) {
            const int nc = it % 48, ks = it / 48, n0 = nc * 256, k0 = ks * 128 + wave * 16;
            f32x4_t acc = {0.f, 0.f, 0.f, 0.f};
#pragma unroll
            for (int r = 0; r < 16; ++r) { const int k = k0 + r; const float cv = cvec[k]; const float sv = cv / (1.0f + expf(-cv));
                const f32x4_t w = *(const f32x4_t*)(w_ada + (size_t)k * (6 * DM) + n0 + 4 * lane); acc += sv * w; }
            red[wave * 64 + lane] = acc;
            __syncthreads();
            if (tid < 256) { float s = 0.f;
#pragma unroll
                for (int w = 0; w < 8; ++w) s += ((LAS float*)red)[w * 256 + tid];
                MODP[ks * (6 * DM) + n0 + tid] = s; }
            __syncthreads();
        }
    }
    for (int it = bid; it < 4 * NG; it += G) ssm_setup_item(a, ws, lds, it >> 2, it & 3, tid);
    __syncthreads();
    {
        LAS float* scr = (LAS float*)(lds + wave * 16384);
        constexpr int I_IN = 32 * 128, I_GLU = 16 * 32, I_OUT = 32 * 64, I_UP = 32 * 352, I_DN = 88 * 64, I_ALL = I_IN + I_GLU + I_OUT + I_UP + I_DN;
        for (int it = gw; it < I_ALL; it += NGW) {
            int r = it;
            if (r < I_IN) { const int kb = r / 128, n0 = 32 * (r % 128); tr_item(a.in[5], INW, n0 < 3072 ? n0 : n0 + 8, 64 * kb, W1T, DM, n0, nullptr, nullptr, scr, lane); continue; } r -= I_IN;
            if (r < I_GLU) { const int kb = r / 32, n0 = 32 * (r % 32); tr_item(a.in[15], SW, n0, 64 * kb, WGT, SW, n0, nullptr, nullptr, scr, lane); continue; } r -= I_GLU;
            if (r < I_OUT) { const int kb = r / 64, n0 = 32 * (r % 64); tr_item(a.in[19], DM, n0, 64 * kb, WOT, DM, n0, a.in[17], a.in[18], scr, lane); continue; } r -= I_OUT;
            if (r < I_UP) { const int kb = r / 352, n0 = 32 * (r % 352); const int pn = n0 >> 8, bj = (n0 >> 7) & 1, w = n0 & 127;
                tr_item(a.in[21], 2 * DFF, bj * DFF + 128 * pn + w, 64 * kb, WUT, DM, n0, nullptr, nullptr, scr, lane); continue; } r -= I_UP;
            { const int kb = r / 64, n0 = 32 * (r % 64); tr_item(a.in[24], DM, n0, 64 * kb, WDT, DFF, n0, nullptr, nullptr, scr, lane); }
        }
    }
    GRID_BAR();

    {
        LAS float* gs = (LAS float*)lds; LAS float* shv = gs + DM; LAS float* wf = shv + DM;
        const float* b_ada = a.in[3]; const float* g_mix = a.in[4]; const float* w_in = a.in[5];
        for (int k = tid; k < DM; k += 512) { float sh = b_ada[k], sc = b_ada[DM + k];
            for (int j = 0; j < 16; ++j) { sh += MODP[j * (6 * DM) + k]; sc += MODP[j * (6 * DM) + DM + k]; }
            gs[k] = g_mix[k] * (1.0f + sc); shv[k] = sh; }
        for (int i = tid; i < DM * 8; i += 512) wf[i] = w_in[(size_t)(i >> 3) * INW + 3072 + (i & 7)];
        for (int n = bid * 512 + tid; n < 6 * DM; n += G * 512) { float m = b_ada[n]; for (int j = 0; j < 16; ++j) m += MODP[j * (6 * DM) + n]; MOD[n] = m; }
        __syncthreads();
        const float* b_f = a.in[6];
        for (int row = gw; row < SEQ; row += NGW) {
            f32x4_t v[8]; norm_mod_row(XIN + (size_t)row * DM, HN + (size_t)row * DM, gs, shv, lane, v);
            f32x4_t f0 = {0.f, 0.f, 0.f, 0.f}, f1 = {0.f, 0.f, 0.f, 0.f};
#pragma unroll
            for (int j = 0; j < 8; ++j)
#pragma unroll
                for (int e = 0; e < 4; ++e) { const int k = 4 * lane + 256 * j + e; const f32x4_t w0 = *(const LAS f32x4_t*)(wf + k * 8), w1 = *(const LAS f32x4_t*)(wf + k * 8 + 4);
                    f0 += v[j][e] * w0; f1 += v[j][e] * w1; }
            float fd = 0.f;
#pragma unroll
            for (int h = 0; h < 8; ++h) { const float t = wave_sum(h < 4 ? f0[h & 3] : f1[h & 3]); if (lane == h) fd = t; }
            if (lane < 8) { const float z = fd + b_f[lane]; LF[lane * SEQ + row] = fminf(z, 0.f) - log1pf(expf(-fabsf(z))); }
        }
    }
    GRID_BAR();

    if (bid < NH) {
        LAS double* tot = (LAS double*)lds; const int h = bid; const float* src = LF + h * SEQ + tid * 16;
        float vals[16];
#pragma unroll
        for (int q = 0; q < 4; ++q) { const f32x4_t t = *(const f32x4_t*)(src + 4 * q); vals[4 * q] = t[0]; vals[4 * q + 1] = t[1]; vals[4 * q + 2] = t[2]; vals[4 * q + 3] = t[3]; }
        double run = 0.0;
#pragma unroll
        for (int e = 0; e < 16; ++e) run += (double)vals[e];
        tot[tid] = run;
        __syncthreads();
        double c = 0.0; for (int i = 0; i < tid; ++i) c += tot[i];
        float* dst = CBR + h * SEQ + tid * 16;
#pragma unroll
        for (int e = 0; e < 16; ++e) { c += (double)vals[e]; dst[e] = -(float)(c * 11.313708498984761); }
        __syncthreads();
    }
    {
        pg8::Gemm g{HN, W1T, SEQ, 4096, DM, DM, DM}; pg8::StaticOrder S; S.init(SEQ, 4096, G, bid);
        pg8::EpiQKVU E{QKV, AALL};
#ifndef NO_G1
        pg8::gemm_phase<pg8::EpiQKVU, pg8::StaticOrder, true, true>(lds, g, S, E, wave);
#endif
    }
    GRID_BAR();

    {
        pg8::Gemm g{AALL, WEND, NG * NCH, NG * 256, CL * GCH, KA, CL * GCH}; pg8::CarryOrder S{G, bid};
        pg8::EpiCarry E{AALL, (const float*)(ws + WS_P32)};
#ifndef NO_G2
        pg8::gemm_phase<pg8::EpiCarry, pg8::CarryOrder, false, true>(lds, g, S, E, wave);
#endif
        if (bid >= NG && G > NG + 2) {
            const int nw = (G - NG) * 8, per = nw / 16, w = (bid - NG) * 8 + wave, ha = w / per, j = w - ha * per;
            if (ha < 16) {
                const bf16_t* base = QKV + (size_t)ha * SEQ * HD; float mx = 0.f;
                for (int q4 = j; q4 < SEQ / 4; q4 += per) {
                    const u32x4_t v = *(const u32x4_t*)(base + (size_t)(4 * q4 + (lane >> 4)) * HD + (lane & 15) * 8);
                    float s = bf_lo(v.x) * bf_lo(v.x) + bf_hi(v.x) * bf_hi(v.x) + bf_lo(v.y) * bf_lo(v.y) + bf_hi(v.y) * bf_hi(v.y)
                            + bf_lo(v.z) * bf_lo(v.z) + bf_hi(v.z) * bf_hi(v.z) + bf_lo(v.w) * bf_lo(v.w) + bf_hi(v.w) * bf_hi(v.w);
                    s += __shfl_xor(s, 1); s += __shfl_xor(s, 2); s += __shfl_xor(s, 4); s += __shfl_xor(s, 8);
                    mx = fmaxf(mx, s);
                }
                mx = fmaxf(mx, __shfl_xor(mx, 16)); mx = fmaxf(mx, __shfl_xor(mx, 32));
                if (lane == 0) atomicMax((unsigned*)(ws + WS_NRM) + ha, __float_as_uint(mx));
            }
        }
    }
    GRID_BAR();

    {
        using abf = att::bf16;
        char* ldsg = (char*)lds_raw;
        BIAS_LAS float* bias = (BIAS_LAS float*)(lds + att::BIAS_OFF);
        att::Seam<abf> Sm;
        if (bid < NH * (SEQ / att::QB)) { const int it = bid;
            const int head = it & 7, qb = (SEQ / att::QB - 1) - (it >> 3), P0 = qb * att::QB;
            const float qk = sqrtf(__uint_as_float(((const unsigned*)(ws + WS_NRM))[head]) * __uint_as_float(((const unsigned*)(ws + WS_NRM))[8 + head]));
            const float thr = 1131.4f + 2.02f * qk + 1.0f;
            const int jlo = __syncthreads_count((tid < P0 / 64) && (CBR[head * SEQ + P0] - CBR[head * SEQ + 64 * tid + 63] > thr));
            for (int k = 64 * jlo + tid * 4; k < P0 + att::QB; k += 2048) *(BIAS_LAS f32x4_t*)(bias + (k - 64 * jlo)) = *(const f32x4_t*)(CBR + head * SEQ + k);
            __syncthreads();
            att::BlockRef<abf, abf> cur;
            cur.Q = (const abf*)QKV + ((size_t)(0 * NH + head) * SEQ + P0) * HD; cur.K = (const abf*)QKV + (size_t)(1 * NH + head) * SEQ * HD; cur.V = (const abf*)QKV + (size_t)(2 * NH + head) * SEQ * HD;
            cur.O = (abf*)MIX + (size_t)P0 * DM + head * HD; cur.P0 = P0; cur.JLO = jlo; cur.SSQ = SSQB + (size_t)P0 * 32 + head;
#ifndef NO_ATT
            att::causal_swa_prime<abf, abf>(cur, 1 << 30, ldsg, Sm, wave);
            att::causal_swa_block<abf, abf>(cur, cur, SEQ, 1 << 30, ldsg, Sm, bias, wave);
#endif
        }
        asm volatile("s_waitcnt vmcnt(0)" ::: "memory");
        __syncthreads();
        pg8::Gemm g{AALL, GC, NG * NCH, NG * 512, KA, KA, KA}; pg8::ChunkOrder S{G, G - 1 - bid};
        pg8::EpiY E{YB};
#ifndef NO_G3
        pg8::gemm_phase<pg8::EpiY, pg8::ChunkOrder, true, true>(lds, g, S, E, wave);
#endif
    }
    GRID_BAR();

    {
        pg8::Gemm g{YB, WGT, SEQ, SW, SW, SW, SW}; pg8::StaticOrder S; S.init(SEQ, SW, G, bid);
        pg8::EpiGlu E{YB, MIX, a.in[16], SSQB};
#ifndef NO_G4
        pg8::gemm_phase<pg8::EpiGlu, pg8::StaticOrder, true, true>(lds, g, S, E, wave);
#endif
    }
    GRID_BAR();

    {
        pg8::Gemm g{MIX, WOT, SEQ, DM, DM, DM, DM}; pg8::StaticOrder S; S.init(SEQ, DM, G, bid);
        LAS float* rtab = (LAS float*)(lds + RING_BYTES);
        { pg8::Unit u0; if (S.next(0, u0) && tid < 256) { float ra, rs; pg8::EpiWout::rstds(SSQB, u0.pm * 256 + tid, ra, rs); rtab[2 * tid] = ra / rs; rtab[2 * tid + 1] = rs; } }
        __syncthreads();
        pg8::EpiWout E{rtab, XIN, MOD + 2 * DM, OUT};
#ifndef NO_G5
        pg8::gemm_phase<pg8::EpiWout, pg8::StaticOrder, true, true>(lds, g, S, E, wave);
#endif
    }
    GRID_BAR();

    {
        LAS float* gs = (LAS float*)lds; LAS float* shv = gs + DM; const float* g_ffn = a.in[20];
        for (int k = tid; k < DM; k += 512) { gs[k] = g_ffn[k] * (1.0f + MOD[4 * DM + k]); shv[k] = MOD[3 * DM + k]; }
        __syncthreads();
        for (int row = gw; row < SEQ; row += NGW) { f32x4_t v[8]; norm_mod_row(OUT + (size_t)row * DM, HN + (size_t)row * DM, gs, shv, lane, v); }
    }
    GRID_BAR();

    {
        pg8::Gemm g{HN, WUT, SEQ, 2 * DFF, DM, DM, DM}; pg8::StaticOrder S; S.init(SEQ, 2 * DFF, G, bid);
        pg8::EpiUp E{ABUF, BBUF};
#ifndef NO_G6
        pg8::gemm_phase<pg8::EpiUp, pg8::StaticOrder, true, true>(lds, g, S, E, wave);
#endif
    }
    GRID_BAR();

    {
        const float* cw = a.in[22]; const float* cbias = a.in[23];
        constexpr int NCC = DFF / 8, NRB = SEQ / 16;
        for (int id = bid * 512 + tid; id < NRB * NCC; id += G * 512) {
            const int rb = id / NCC, cc = id - rb * NCC, col = cc * 8, t0 = rb * 16;
            float w0[8], w1[8], w2[8], cb[8], am2[8], am1[8];
#pragma unroll
            for (int q = 0; q < 2; ++q) { const f32x4_t u0 = *(const f32x4_t*)(cw + col + 4 * q), u1 = *(const f32x4_t*)(cw + DFF + col + 4 * q), u2 = *(const f32x4_t*)(cw + 2 * DFF + col + 4 * q), u3 = *(const f32x4_t*)(cbias + col + 4 * q);
#pragma unroll
                for (int e = 0; e < 4; ++e) { w0[4 * q + e] = u0[e]; w1[4 * q + e] = u1[e]; w2[4 * q + e] = u2[e]; cb[4 * q + e] = u3[e]; } }
#pragma unroll
            for (int e = 0; e < 8; ++e) { am2[e] = 0.f; am1[e] = 0.f; }
            if (t0 > 0) { const u32x4_t p2 = *(const u32x4_t*)(ABUF + (size_t)(t0 - 2) * DFF + col), p1 = *(const u32x4_t*)(ABUF + (size_t)(t0 - 1) * DFF + col);
                am2[0] = bf_lo(p2.x); am2[1] = bf_hi(p2.x); am2[2] = bf_lo(p2.y); am2[3] = bf_hi(p2.y); am2[4] = bf_lo(p2.z); am2[5] = bf_hi(p2.z); am2[6] = bf_lo(p2.w); am2[7] = bf_hi(p2.w);
                am1[0] = bf_lo(p1.x); am1[1] = bf_hi(p1.x); am1[2] = bf_lo(p1.y); am1[3] = bf_hi(p1.y); am1[4] = bf_lo(p1.z); am1[5] = bf_hi(p1.z); am1[6] = bf_lo(p1.w); am1[7] = bf_hi(p1.w); }
            for (int r = 0; r < 16; ++r) {
                const size_t off = (size_t)(t0 + r) * DFF + col;
                const u32x4_t pa = *(const u32x4_t*)(ABUF + off), pb = *(const u32x4_t*)(BBUF + off);
                float av[8], bv[8], gv[8];
                av[0] = bf_lo(pa.x); av[1] = bf_hi(pa.x); av[2] = bf_lo(pa.y); av[3] = bf_hi(pa.y); av[4] = bf_lo(pa.z); av[5] = bf_hi(pa.z); av[6] = bf_lo(pa.w); av[7] = bf_hi(pa.w);
                bv[0] = bf_lo(pb.x); bv[1] = bf_hi(pb.x); bv[2] = bf_lo(pb.y); bv[3] = bf_hi(pb.y); bv[4] = bf_lo(pb.z); bv[5] = bf_hi(pb.z); bv[6] = bf_lo(pb.w); bv[7] = bf_hi(pb.w);
#pragma unroll
                for (int e = 0; e < 8; ++e) { const float cv = cb[e] + w0[e] * am2[e] + w1[e] * am1[e] + w2[e] * av[e]; gv[e] = cv * fast_sigmoid(cv) * bv[e]; am2[e] = am1[e]; am1[e] = av[e]; }
                u32x4_t o; o.x = pk2(gv[0], gv[1]); o.y = pk2(gv[2], gv[3]); o.z = pk2(gv[4], gv[5]); o.w = pk2(gv[6], gv[7]);
                *(u32x4_t*)(BBUF + off) = o;
            }
        }
    }
    GRID_BAR();

    {
        pg8::Gemm g{BBUF, WDT, SEQ, DM, DFF, DFF, DFF}; pg8::StaticOrder S; S.init(SEQ, DM, G, bid);
        pg8::EpiDown E{MOD + 5 * DM, OUT, SSQ2B};
#ifndef NO_G7
        pg8::gemm_phase<pg8::EpiDown, pg8::StaticOrder, true, true>(lds, g, S, E, wave);
#endif
    }
    GRID_BAR();

    {
        const float* gf = a.in[25];
        for (int row = gw; row < SEQ; row += NGW) {
            const float part = lane < 32 ? SSQ2B[(size_t)row * 32 + lane] : 0.f;
            const float rstd = 1.0f / sqrtf(wave_sum(part) * (1.0f / DM) + EPS);
            f32x4_t* orow = (f32x4_t*)(OUT + (size_t)row * DM) + lane; const f32x4_t* g4 = (const f32x4_t*)gf + lane;
#pragma unroll
            for (int j = 0; j < 8; ++j) orow[64 * j] = orow[64 * j] * rstd * g4[64 * j];
        }
    }
}

extern "C" void kernel_launch(void* const* d_in, const int* in_sizes, int n_in, void* d_out, int out_size, void* d_ws, size_t ws_size, hipStream_t stream) {
    static int grid = 0;
    if (grid == 0) {
        if (n_in != 26 || out_size != SEQ * DM || ws_size < WS_END) { fprintf(stderr, "kernel_launch: unexpected shapes (n_in %d out %d ws %zu)\n", n_in, out_size, ws_size); grid = -1; return; }
        int dev = 0, cus = 0, per_cu = 0;
        (void)hipGetDevice(&dev); (void)hipDeviceGetAttribute(&cus, hipDeviceAttributeMultiprocessorCount, dev);
        if (hipFuncSetAttribute((const void*)fwd_kernel, hipFuncAttributeMaxDynamicSharedMemorySize, LDS_BYTES) != hipSuccess) { fprintf(stderr, "kernel_launch: hipFuncSetAttribute failed\n"); grid = -1; return; }
        if (hipOccupancyMaxActiveBlocksPerMultiprocessor(&per_cu, (const void*)fwd_kernel, 512, LDS_BYTES) != hipSuccess || per_cu < 1) { fprintf(stderr, "kernel_launch: occupancy query gave %d\n", per_cu); per_cu = 1; }
        (void)hipGetLastError();
        grid = cus;
        if (grid > 256) grid = 256;
    }
    if (grid < 0) return;
    (void)hipMemsetAsync((char*)d_ws + WS_CTL, 0, CTL_ZERO_BYTES, stream);
    Args a{};
    for (int i = 0; i < 26; ++i) a.in[i] = (const float*)d_in[i];
    a.out = (float*)d_out; a.ws = (unsigned char*)d_ws;
    void* args[] = {&a};
    hipError_t e = hipLaunchCooperativeKernel((const void*)fwd_kernel, dim3(grid), dim3(512), args, LDS_BYTES, stream);
    if (e != hipSuccess) fprintf(stderr, "cooperative launch failed: %s (grid %d)\n", hipGetErrorString(e), grid);
}
```

```cpp
#include <hip/hip_runtime.h>
#include <hip/hip_cooperative_groups.h>
#include <cstdio>
#include <cstdint>
namespace cg = cooperative_groups;

constexpr int SEQ = 8192, DM = 2048, AW = 1024, HD = 128, NH = 8, SW = 1024, NG = 64, GCH = 16, NP = 64, INW = 4104, DFF = 5632;
constexpr int CL = 32, NCH = SEQ / CL;
constexpr int KA = CL * GCH + 2 * NP;
constexpr float EPS = 1e-6f;
constexpr size_t MiB = 1u << 20, KiB = 1024;
constexpr size_t WS_CTL = 0, CTL_ZERO_BYTES = 1 * MiB;
constexpr size_t WS_NRM = 512 * KiB;
constexpr size_t WS_MODP = 1 * MiB;
constexpr size_t WS_MOD = 2 * MiB;
constexpr size_t WS_LF = 2 * MiB + 64 * KiB;
constexpr size_t WS_CBR = 2 * MiB + 320 * KiB;
constexpr size_t WS_P32 = 2 * MiB + 576 * KiB;
constexpr size_t WS_SSQ = 3 * MiB;
constexpr size_t WS_SSQ2 = 4 * MiB;
constexpr size_t WS_WDT = 8 * MiB;
constexpr size_t WS_W1T = 30 * MiB;
constexpr size_t WS_WGT = 46 * MiB;
constexpr size_t WS_WOT = 48 * MiB;
constexpr size_t WS_WUT = 56 * MiB;
constexpr size_t WS_GC = 100 * MiB;
constexpr size_t WS_WEND = 140 * MiB;
constexpr size_t WS_AALL = 156 * MiB;
constexpr size_t WS_QKV = 176 * MiB;
constexpr size_t WS_YB = 224 * MiB;
constexpr size_t WS_MIX = 240 * MiB;
constexpr size_t WS_HN = 280 * MiB;
constexpr size_t WS_ABUF = 100 * MiB;
constexpr size_t WS_BBUF = 188 * MiB;
constexpr size_t WS_END = 312 * MiB;
static_assert(WS_ABUF + (size_t)SEQ * DFF * 2 <= WS_BBUF && WS_BBUF + (size_t)SEQ * DFF * 2 <= WS_HN && WS_HN + (size_t)SEQ * DM * 2 <= WS_END, "ws map");
static_assert(WS_WUT + (size_t)2 * DFF * DM * 2 <= WS_GC && WS_GC + (size_t)NG * 512 * KA * 2 <= WS_WEND && WS_WEND + (size_t)NG * 256 * 512 * 2 <= WS_AALL && WS_AALL + (size_t)NG * 256 * KA * 2 <= WS_QKV, "ws map 2");
static_assert(WS_QKV + (size_t)3 * SEQ * AW * 2 <= WS_YB && WS_YB + (size_t)SEQ * SW * 2 <= WS_MIX && WS_MIX + (size_t)SEQ * DM * 2 <= WS_HN, "ws map 3");
static_assert(WS_WDT + (size_t)DM * DFF * 2 <= WS_W1T && WS_W1T + (size_t)4096 * DM * 2 <= WS_WGT && WS_WOT + (size_t)DM * DM * 2 <= WS_WUT, "ws map 4");
constexpr int LDS_BYTES = 147456;
constexpr int RING_BYTES = 131072;

typedef float f32x4_t __attribute__((ext_vector_type(4)));
typedef unsigned u32x4_t __attribute__((ext_vector_type(4)));
typedef unsigned u32x2_t __attribute__((ext_vector_type(2)));
__device__ __forceinline__ float bf_lo(unsigned w) { return __uint_as_float(w << 16); }
__device__ __forceinline__ float bf_hi(unsigned w) { return __uint_as_float(w & 0xffff0000u); }
__device__ __forceinline__ float fast_sigmoid(float z) { return __builtin_amdgcn_rcpf(1.0f + __builtin_amdgcn_exp2f(-1.4426950408889634f * z)); }
__device__ __forceinline__ float gelu_tanh(float v) { const float z = 1.5957691216057308f * (v + 0.044715f * v * v * v); return v * fast_sigmoid(z); }

namespace pg8 {
#define PG8_LAS __attribute__((address_space(3)))
typedef unsigned short bf16_t;
typedef short bf16x8 __attribute__((ext_vector_type(8)));
typedef float f32x4 __attribute__((ext_vector_type(4)));
typedef unsigned u32x4 __attribute__((ext_vector_type(4)));
constexpr int BM = 256, BK = 64, HALF = 128, HTB = HALF * BK * 2  , STAGE_BYTES = 8 * HTB, NXCD = 8, WGM = 8;

__host__ __device__ __forceinline__ int lds_byte(int r, int c) { const int st = (r >> 4) * 2 + (c >> 5), rr = r & 15, cc = c & 31, ob = rr * 64 + cc * 2; return st * 1024 + (ob ^ (((ob >> 9) & 1) << 5)); }
__host__ __device__ __forceinline__ void stage_rc(int b, int& R, int& C) { const int st = b / 1024, sb = b % 1024, swz = sb ^ (((sb >> 9) & 1) << 5); R = (st >> 1) * 16 + swz / 64; C = (st & 1) * 32 + (swz % 64) / 2; }
__host__ __device__ __forceinline__ int perm32(int rho) { const int n = rho >> 4, i = rho & 15; return 8 * (i >> 2) + 4 * n + (i & 3); }

struct Unit { int pm, pn; };
struct Gemm { const bf16_t* A; const bf16_t* Bt; int M, N, K, lda, ldb; };

struct StaticOrder {
    int nM, nN, nwg, G, c;
    __host__ __device__ void init(int M, int N, int G_, int c_) { nM = M / BM; nN = N / BM; nwg = nM * nN; G = G_; c = c_; }
    __host__ __device__ bool next(int i, Unit& u) const {
        const long L = (long)i * G + c; if (L >= nwg) return false;
        int wgid = (int)L; { const int q = nwg / NXCD, r = nwg % NXCD, xcd = wgid % NXCD, off = wgid / NXCD; wgid = (xcd < r ? xcd * (q + 1) : r * (q + 1) + (xcd - r) * q) + off; }
        const int nig = WGM * nN, gid = wgid / nig, fm = gid * WGM, gsz = (nM - fm) < WGM ? (nM - fm) : WGM;
        u.pm = fm + ((wgid % nig) % gsz); u.pn = (wgid % nig) / gsz; return true;
    }
    __device__ __forceinline__ void a_ready(const Unit&) const {}
    __device__ __forceinline__ void done(const Unit&) const {}
};


template <class Epi, class Sched, bool ALIGN_EPI = false, bool SP2 = false>
__device__ __forceinline__ void gemm_phase(PG8_LAS unsigned char* lds, const Gemm g, const Sched& S, const Epi& E, const int wv  ) {
    int tid_ = wv * 64 + ((int)__builtin_amdgcn_mbcnt_hi(~0u, __builtin_amdgcn_mbcnt_lo(~0u, 0u))); asm volatile("" : "+v"(tid_));
    const int tid = tid_, wid = __builtin_amdgcn_readfirstlane(tid >> 6), lane = tid & 63, wr = wid >> 2, wc = wid & 3, fr = lane & 15, fq = lane >> 4;
    const int K = g.K, nt = K / BK;
    unsigned voffA[2], voffB[2];
#pragma unroll
    for (int i = 0; i < 2; ++i) { int R, C; stage_rc(tid * 16 + i * 8192, R, C); const int Rb = Epi::PERM ? ((R & ~31) + perm32(R & 31)) : R;
        voffA[i] = (unsigned)(R * g.lda + C) * 2u; voffB[i] = (unsigned)(Rb * g.ldb + C) * 2u; }
    const size_t kstep = (size_t)(BK * 2);
    const size_t hstepA = (size_t)HALF * g.lda * 2, hstepB = (size_t)HALF * g.ldb * 2;
    const size_t tstepA = 2 * hstepA, tstepB = 2 * hstepB;
    const unsigned ldsw = (unsigned)wid * 1024u;
    const int aoff = lds_byte(wr * 64 + fr, fq * 8), boff = lds_byte(wc * 32 + fr, fq * 8);
#define PG8_SA(b, h) (((b) * 2 + (h)) * HTB)
#define PG8_SB(b, h) ((4 + (b) * 2 + (h)) * HTB)
#define PG8_STAGE(bufoff, gbase, voff) do { _Pragma("unroll") for (int _i = 0; _i < 2; ++_i) \
        __builtin_amdgcn_global_load_lds((const unsigned*)((const char*)(gbase) + (voff)[_i]), (PG8_LAS unsigned*)(lds + (bufoff) + ldsw + _i * 8192), 16, 0, 0); } while (0)
#define PG8_LDA(dst, b, h) do { _Pragma("unroll") for (int m = 0; m < 4; ++m) _Pragma("unroll") for (int k = 0; k < 2; ++k) dst[m][k] = *(const PG8_LAS bf16x8*)(lds + PG8_SA(b, h) + aoff + m * 2048 + k * 1024); } while (0)
#define PG8_LDB(dst, b, h) do { _Pragma("unroll") for (int n = 0; n < 2; ++n) _Pragma("unroll") for (int k = 0; k < 2; ++k) dst[n][k] = *(const PG8_LAS bf16x8*)(lds + PG8_SB(b, h) + boff + n * 2048 + k * 1024); } while (0)
#define PG8_MMA(ai, bj, At, Bt) do { __builtin_amdgcn_s_setprio(1); _Pragma("unroll") for (int m = 0; m < 4; ++m) _Pragma("unroll") for (int n = 0; n < 2; ++n) _Pragma("unroll") for (int k = 0; k < 2; ++k) \
        acc[ai][bj][m][n] = __builtin_amdgcn_mfma_f32_16x16x32_bf16(Bt[n][k], At[m][k], acc[ai][bj][m][n], 0, 0, 0); __builtin_amdgcn_s_setprio(0); } while (0)
#define PG8_WAIT_V(n) asm volatile("s_waitcnt vmcnt(" #n ")" ::: "memory")
#define PG8_WAIT_L(n) asm volatile("s_waitcnt lgkmcnt(" #n ")" ::: "memory")
#define PG8_BAR __builtin_amdgcn_s_barrier()
#define PG8_SCHED __builtin_amdgcn_sched_barrier(0)
    Unit cur, nxt; int ui = 0;
    if (!S.next(0, cur)) return;
    f32x4 acc[2][2][4][2];
#pragma unroll
    for (int a = 0; a < 2; ++a)
#pragma unroll
        for (int b = 0; b < 2; ++b)
#pragma unroll
            for (int m = 0; m < 4; ++m)
#pragma unroll
                for (int n = 0; n < 2; ++n) acc[a][b][m][n] = (f32x4){0.f, 0.f, 0.f, 0.f};
    bf16x8 At[4][2], B0[2][2], B1[2][2];
    const char* cA = (const char*)g.A + (size_t)cur.pm * tstepA; const char* cB = (const char*)g.Bt + (size_t)cur.pn * tstepB;
    S.a_ready(cur);
    if constexpr (SP2) {
        PG8_STAGE(PG8_SB(0, 0), cB, voffB); PG8_STAGE(PG8_SB(0, 1), cB + hstepB, voffB); PG8_STAGE(PG8_SA(0, 0), cA, voffA); PG8_STAGE(PG8_SA(0, 1), cA + hstepA, voffA);
        if (wr == 1) PG8_BAR;
        PG8_WAIT_V(2); PG8_BAR;
        PG8_STAGE(PG8_SB(1, 0), cB + kstep, voffB); PG8_STAGE(PG8_SA(1, 0), cA + kstep, voffA); PG8_STAGE(PG8_SB(1, 1), cB + hstepB + kstep, voffB);
        PG8_WAIT_V(6); PG8_BAR;
    } else {
        PG8_STAGE(PG8_SB(0, 0), cB, voffB); PG8_STAGE(PG8_SA(0, 0), cA, voffA); PG8_STAGE(PG8_SB(0, 1), cB + hstepB, voffB); PG8_STAGE(PG8_SA(0, 1), cA + hstepA, voffA);
        if (wr == 1) PG8_BAR;
        PG8_WAIT_V(4); PG8_BAR;
        PG8_STAGE(PG8_SB(1, 0), cB + kstep, voffB); PG8_STAGE(PG8_SA(1, 0), cA + kstep, voffA); PG8_STAGE(PG8_SB(1, 1), cB + hstepB + kstep, voffB);
        PG8_WAIT_V(6); PG8_BAR;
    }
    for (;;) {
        const bool has_next = S.next(ui + 1, nxt);
        const char* nA = has_next ? (const char*)g.A + (size_t)nxt.pm * tstepA : cA; const char* nB = has_next ? (const char*)g.Bt + (size_t)nxt.pn * tstepB : cB;
        for (int t = 0; t < nt; t += 2) {
            const bool last = (t == nt - 2);
            const char* a1 = cA + (size_t)(t + 1) * kstep;
            const char* a2 = last ? nA : cA + (size_t)(t + 2) * kstep; const char* b2 = last ? nB : cB + (size_t)(t + 2) * kstep;
            const char* a3 = a2 + kstep; const char* b3 = b2 + kstep;
            if (last && has_next) S.a_ready(nxt);
            if constexpr (Epi::MIDK) { if (t == (nt >> 1)) E.mid(acc, cur, wr, fr); }
            if constexpr (SP2) {
            PG8_LDB(B0, 0, 0); PG8_LDB(B1, 0, 1); PG8_SCHED; PG8_LDA(At, 0, 0); PG8_STAGE(PG8_SA(1, 1), a1 + hstepA, voffA);
            PG8_WAIT_V(8); PG8_WAIT_L(0); PG8_BAR; PG8_MMA(0, 0, At, B0); PG8_MMA(0, 1, At, B1); PG8_BAR; PG8_SCHED;
            PG8_LDA(At, 0, 1); PG8_STAGE(PG8_SB(0, 0), b2, voffB); PG8_STAGE(PG8_SB(0, 1), b2 + hstepB, voffB); PG8_STAGE(PG8_SA(0, 0), a2, voffA);
            PG8_WAIT_V(8); PG8_WAIT_L(0); PG8_BAR; PG8_MMA(1, 0, At, B0); PG8_MMA(1, 1, At, B1); PG8_BAR; PG8_SCHED;
            PG8_LDB(B0, 1, 0); PG8_LDB(B1, 1, 1); PG8_SCHED; PG8_LDA(At, 1, 0); PG8_STAGE(PG8_SA(0, 1), a2 + hstepA, voffA);
            PG8_WAIT_V(8); PG8_WAIT_L(0); PG8_BAR; PG8_MMA(0, 0, At, B0); PG8_MMA(0, 1, At, B1); PG8_BAR; PG8_SCHED;
            PG8_LDA(At, 1, 1); PG8_STAGE(PG8_SB(1, 0), b3, voffB); PG8_STAGE(PG8_SB(1, 1), b3 + hstepB, voffB); PG8_STAGE(PG8_SA(1, 0), a3, voffA);
            PG8_WAIT_V(8); PG8_WAIT_L(0); PG8_BAR; PG8_MMA(1, 0, At, B0); PG8_MMA(1, 1, At, B1); PG8_BAR; PG8_SCHED;
            } else {
            PG8_LDB(B0, 0, 0); PG8_SCHED; PG8_LDA(At, 0, 0); PG8_STAGE(PG8_SA(1, 1), a1 + hstepA, voffA);
            PG8_WAIT_L(8); PG8_BAR; PG8_WAIT_L(0); PG8_MMA(0, 0, At, B0); PG8_BAR; PG8_SCHED;
            PG8_LDB(B1, 0, 1); PG8_STAGE(PG8_SB(0, 0), b2, voffB);
            PG8_BAR; PG8_WAIT_L(0); PG8_MMA(0, 1, At, B1); PG8_BAR;
            PG8_LDA(At, 0, 1); PG8_STAGE(PG8_SA(0, 0), a2, voffA);
            PG8_BAR; PG8_WAIT_L(0); PG8_MMA(1, 0, At, B0); PG8_BAR; PG8_SCHED;
            PG8_STAGE(PG8_SB(0, 1), b2 + hstepB, voffB);
            PG8_WAIT_V(6); PG8_BAR; PG8_MMA(1, 1, At, B1); PG8_BAR;
            PG8_LDB(B0, 1, 0); PG8_SCHED; PG8_LDA(At, 1, 0); PG8_STAGE(PG8_SA(0, 1), a2 + hstepA, voffA);
            PG8_WAIT_L(8); PG8_BAR; PG8_WAIT_L(0); PG8_MMA(0, 0, At, B0); PG8_BAR; PG8_SCHED;
            PG8_LDB(B1, 1, 1); PG8_STAGE(PG8_SB(1, 0), b3, voffB);
            PG8_BAR; PG8_WAIT_L(0); PG8_MMA(0, 1, At, B1); PG8_BAR;
            PG8_LDA(At, 1, 1); PG8_STAGE(PG8_SA(1, 0), a3, voffA);
            PG8_BAR; PG8_WAIT_L(0); PG8_MMA(1, 0, At, B0); PG8_BAR; PG8_SCHED;
            PG8_STAGE(PG8_SB(1, 1), b3 + hstepB, voffB);
            PG8_WAIT_V(6); PG8_BAR; PG8_MMA(1, 1, At, B1); PG8_BAR;
            }
        }
        if constexpr (ALIGN_EPI) { if (wr == 0) PG8_BAR; }
        if constexpr (!Epi::AFTER_DRAIN) { E(acc, cur, wr, wc, fr, fq); S.done(cur); }
        if (!has_next) break;
#pragma unroll
        for (int a = 0; a < 2; ++a)
#pragma unroll
            for (int b = 0; b < 2; ++b)
#pragma unroll
                for (int m = 0; m < 4; ++m)
#pragma unroll
                    for (int n = 0; n < 2; ++n) acc[a][b][m][n] = (f32x4){0.f, 0.f, 0.f, 0.f};
        cur = nxt; cA = nA; cB = nB; ++ui;
        if constexpr (ALIGN_EPI) { if (wr == 1) PG8_BAR; }
    }
    PG8_WAIT_V(0);
    if constexpr (!ALIGN_EPI) { if (wr == 0) PG8_BAR; }
    PG8_BAR;
    if constexpr (Epi::AFTER_DRAIN) { E.fused(acc, cur, wr, wc, fr, fq, lds, wid, lane); S.done(cur); }
#undef PG8_SA
#undef PG8_SB
#undef PG8_STAGE
#undef PG8_LDA
#undef PG8_LDB
#undef PG8_MMA
#undef PG8_WAIT_V
#undef PG8_WAIT_L
#undef PG8_BAR
#undef PG8_SCHED
}
__device__ __forceinline__ unsigned cvt_pk_bf16(float lo, float hi) { unsigned r; asm volatile("v_cvt_pk_bf16_f32 %0, %1, %2" : "=v"(r) : "v"(lo), "v"(hi)); return r; }
__device__ __forceinline__ u32x4 pack8(const f32x4 a, const f32x4 b) { u32x4 w; w.x = cvt_pk_bf16(a[0], a[1]); w.y = cvt_pk_bf16(a[2], a[3]); w.z = cvt_pk_bf16(b[0], b[1]); w.w = cvt_pk_bf16(b[2], b[3]); return w; }

struct CarryOrder {
    int G, c;
    __device__ bool next(int i, Unit& u) const { const int L = i * G + c; if (L >= NG) return false; u.pm = L; u.pn = L; return true; }
    __device__ __forceinline__ void a_ready(const Unit&) const {}
    __device__ __forceinline__ void done(const Unit&) const {}
};
struct ChunkOrder {
    int G, c;
    __device__ bool next(int i, Unit& u) const { const int L = i * G + c; if (L >= 2 * NG) return false; u.pm = L >> 1; u.pn = L; return true; }
    __device__ __forceinline__ void a_ready(const Unit&) const {}
    __device__ __forceinline__ void done(const Unit&) const {}
};

struct EpiQKVU {
    static constexpr bool PERM = true, AFTER_DRAIN = false, MIDK = false;
    bf16_t* QKV; bf16_t* AALL;
    __device__ __forceinline__ void mid(f32x4 (&)[2][2][4][2], const Unit&, int, int) const {}
    __device__ __forceinline__ void operator()(const f32x4 (&acc)[2][2][4][2], const Unit& u, int wr, int wc, int fr, int fq) const {
        const int row0 = u.pm * BM + wr * 64 + fr;
#pragma unroll
        for (int bj = 0; bj < 2; ++bj) {
            const int ct = u.pn * BM + bj * HALF, cw = wc * 32 + 8 * fq;
            if (ct < 3072) {
                const int which = ct >> 10, head = (ct & 1023) >> 7;
                bf16_t* base = QKV + (size_t)(which * NH + head) * SEQ * HD + cw;
#pragma unroll
                for (int ai = 0; ai < 2; ++ai)
#pragma unroll
                    for (int m = 0; m < 4; ++m) { const int row = row0 + ai * HALF + m * 16; *(u32x4*)(base + (size_t)row * HD) = pack8(acc[ai][bj][m][0], acc[ai][bj][m][1]); }
            } else {
                const int cu = ct - 3072 + cw, g = cu >> 4, i0 = cu & 15;
#pragma unroll
                for (int ai = 0; ai < 2; ++ai)
#pragma unroll
                    for (int m = 0; m < 4; ++m) { const int row = row0 + ai * HALF + m * 16;
                        *(u32x4*)(AALL + ((size_t)(g * NCH + (row >> 5)) * KA + (row & 31) * GCH + i0)) = pack8(acc[ai][bj][m][0], acc[ai][bj][m][1]); }
            }
        }
    }
};

struct EpiCarry {
    static constexpr bool PERM = false, AFTER_DRAIN = true, MIDK = false;
    bf16_t* AALL; const float* P32;
    __device__ __forceinline__ void mid(f32x4 (&)[2][2][4][2], const Unit&, int, int) const {}
    __device__ __forceinline__ void operator()(const f32x4 (&)[2][2][4][2], const Unit&, int, int, int, int) const {}
    __device__ __forceinline__ void fused(f32x4 (&acc)[2][2][4][2], const Unit& u, int wr, int wc, int fr, int fq, PG8_LAS unsigned char* lds, int wid, int lane) const {
        PG8_LAS float* sS = (PG8_LAS float*)lds;
#pragma unroll
        for (int ai = 0; ai < 2; ++ai)
#pragma unroll
            for (int m = 0; m < 4; ++m) { const int r = ai * HALF + wr * 64 + m * 16 + fr;
#pragma unroll
                for (int n = 0; n < 2; ++n) *(PG8_LAS f32x4*)(sS + r * 128 + wc * 32 + 16 * n + 4 * fq) = acc[ai][0][m][n]; }
        asm volatile("s_waitcnt lgkmcnt(0)" ::: "memory"); __builtin_amdgcn_s_barrier(); asm volatile("" ::: "memory");
        if (wid == 0) {
            const int g = u.pm, p = lane;
            const float pr = P32[(g * NP + p) * 2], pi = P32[(g * NP + p) * 2 + 1];
            float xr = 0.f, xi = 0.f;
            bf16_t* dst = AALL + (size_t)g * NCH * KA + CL * GCH + p;
            for (int c = 0; c < NCH; ++c) {
                const unsigned w = cvt_pk_bf16(xr, xi);
                dst[(size_t)c * KA] = (bf16_t)(w & 0xffffu); dst[(size_t)c * KA + NP] = (bf16_t)(w >> 16);
                const float sr = sS[c * 128 + p], si = sS[c * 128 + NP + p];
                const float nr = pr * xr - pi * xi + sr, ni = pr * xi + pi * xr + si;
                xr = nr; xi = ni;
            }
        }
    }
};

struct EpiY {
    static constexpr bool PERM = true, AFTER_DRAIN = false, MIDK = false;
    bf16_t* YB;
    __device__ __forceinline__ void mid(f32x4 (&)[2][2][4][2], const Unit&, int, int) const {}
    __device__ __forceinline__ void operator()(const f32x4 (&acc)[2][2][4][2], const Unit& u, int wr, int wc, int fr, int fq) const {
        const int g = u.pm, j = u.pn & 1;
#pragma unroll
        for (int bj = 0; bj < 2; ++bj) { const int n0 = j * BM + bj * HALF + wc * 32 + 8 * fq, tl = n0 >> 4, h0 = n0 & 15;
#pragma unroll
            for (int ai = 0; ai < 2; ++ai)
#pragma unroll
                for (int m = 0; m < 4; ++m) { const int c = ai * HALF + wr * 64 + m * 16 + fr; const int t = CL * c + tl;
                    f32x4 a = acc[ai][bj][m][0], b = acc[ai][bj][m][1];
#pragma unroll
                    for (int e = 0; e < 4; ++e) { a[e] = gelu_tanh(a[e]); b[e] = gelu_tanh(b[e]); }
                    *(u32x4*)(YB + (size_t)t * SW + GCH * g + h0) = pack8(a, b); } }
    }
};

struct EpiGlu {
    static constexpr bool PERM = true, AFTER_DRAIN = false, MIDK = false;
    const bf16_t* YB; bf16_t* MIX; const float* bglu; float* SSQ;
    __device__ __forceinline__ void mid(f32x4 (&)[2][2][4][2], const Unit&, int, int) const {}
    __device__ __forceinline__ void operator()(const f32x4 (&acc)[2][2][4][2], const Unit& u, int wr, int wc, int fr, int fq) const {
        const int row0 = u.pm * BM + wr * 64 + fr;
        float ss[2][4];
#pragma unroll
        for (int ai = 0; ai < 2; ++ai)
#pragma unroll
            for (int m = 0; m < 4; ++m) ss[ai][m] = 0.f;
#pragma unroll
        for (int bj = 0; bj < 2; ++bj) { const int col0 = u.pn * BM + bj * HALF + wc * 32 + 8 * fq;
            const f32x4 b0 = *(const f32x4*)(bglu + col0), b1 = *(const f32x4*)(bglu + col0 + 4);
#pragma unroll
            for (int ai = 0; ai < 2; ++ai)
#pragma unroll
                for (int m = 0; m < 4; ++m) { const int row = row0 + ai * HALF + m * 16;
                    const u32x4 yw = *(const u32x4*)(YB + (size_t)row * SW + col0);
                    f32x4 ya = {bf_lo(yw.x), bf_hi(yw.x), bf_lo(yw.y), bf_hi(yw.y)}, yb = {bf_lo(yw.z), bf_hi(yw.z), bf_lo(yw.w), bf_hi(yw.w)};
                    const f32x4 za = acc[ai][bj][m][0] + b0, zb = acc[ai][bj][m][1] + b1;
                    float s = 0.f;
#pragma unroll
                    for (int e = 0; e < 4; ++e) { ya[e] *= fast_sigmoid(za[e]); yb[e] *= fast_sigmoid(zb[e]); s += ya[e] * ya[e] + yb[e] * yb[e]; }
                    ss[ai][m] += s;
                    *(u32x4*)(MIX + (size_t)row * DM + SW + col0) = pack8(ya, yb); } }
#pragma unroll
        for (int ai = 0; ai < 2; ++ai)
#pragma unroll
            for (int m = 0; m < 4; ++m) { float s = ss[ai][m]; s += __shfl_xor(s, 16); s += __shfl_xor(s, 32);
                if (fq == 0) SSQ[(size_t)(row0 + ai * HALF + m * 16) * 32 + 8 + u.pn * 4 + wc] = s; }
    }
};

struct EpiWout {
    static constexpr bool PERM = false, AFTER_DRAIN = false, MIDK = true;
    const PG8_LAS float* rtab;
    const float* X; const float* gt1; float* OUT;
    static __device__ __forceinline__ void rstds(const float* SSQ, int row, float& ra, float& rs) {
        const f32x4* p = (const f32x4*)(SSQ + (size_t)row * 32);
        const f32x4 a0 = p[0], a1 = p[1], s0 = p[2], s1 = p[3], s2 = p[4], s3 = p[5];
        const float sa = (a0[0] + a0[1]) + (a0[2] + a0[3]) + (a1[0] + a1[1]) + (a1[2] + a1[3]);
        const f32x4 st = (s0 + s1) + (s2 + s3); const float ssum = (st[0] + st[1]) + (st[2] + st[3]);
        ra = 1.0f / sqrtf(sa * (1.0f / AW) + EPS); rs = 1.0f / sqrtf(ssum * (1.0f / SW) + EPS);
    }
    __device__ __forceinline__ void mid(f32x4 (&acc)[2][2][4][2], const Unit& u, int wr, int fr) const {
#pragma unroll
        for (int ai = 0; ai < 2; ++ai)
#pragma unroll
            for (int m = 0; m < 4; ++m) { const float f = rtab[2 * (ai * HALF + wr * 64 + m * 16 + fr)];
#pragma unroll
                for (int bj = 0; bj < 2; ++bj)
#pragma unroll
                    for (int n = 0; n < 2; ++n) acc[ai][bj][m][n] *= f; }
    }
    __device__ __forceinline__ void operator()(const f32x4 (&acc)[2][2][4][2], const Unit& u, int wr, int wc, int fr, int fq) const {
        const int col0 = u.pn * BM + wc * 32 + 4 * fq;
        f32x4 gv[2][2];
#pragma unroll
        for (int bj = 0; bj < 2; ++bj)
#pragma unroll
            for (int n = 0; n < 2; ++n) gv[bj][n] = *(const f32x4*)(gt1 + col0 + bj * HALF + n * 16);
#pragma unroll
        for (int ai = 0; ai < 2; ++ai)
#pragma unroll
            for (int m = 0; m < 4; ++m) { const int rl = ai * HALF + wr * 64 + m * 16 + fr, row = u.pm * BM + rl; const float rs = rtab[2 * rl + 1];
                const size_t off = (size_t)row * DM + col0;
#pragma unroll
                for (int bj = 0; bj < 2; ++bj)
#pragma unroll
                    for (int n = 0; n < 2; ++n) { const f32x4 xv = *(const f32x4*)(X + off + bj * HALF + n * 16);
                        *(f32x4*)(OUT + off + bj * HALF + n * 16) = xv + gv[bj][n] * (acc[ai][bj][m][n] * rs); } }
    }
};

struct EpiUp {
    static constexpr bool PERM = true, AFTER_DRAIN = false, MIDK = false;
    bf16_t* ABUF; bf16_t* BBUF;
    __device__ __forceinline__ void mid(f32x4 (&)[2][2][4][2], const Unit&, int, int) const {}
    __device__ __forceinline__ void operator()(const f32x4 (&acc)[2][2][4][2], const Unit& u, int wr, int wc, int fr, int fq) const {
        const int row0 = u.pm * BM + wr * 64 + fr, col0 = u.pn * HALF + wc * 32 + 8 * fq;
#pragma unroll
        for (int bj = 0; bj < 2; ++bj) { bf16_t* base = (bj == 0 ? ABUF : BBUF) + col0;
#pragma unroll
            for (int ai = 0; ai < 2; ++ai)
#pragma unroll
                for (int m = 0; m < 4; ++m) { const int row = row0 + ai * HALF + m * 16; *(u32x4*)(base + (size_t)row * DFF) = pack8(acc[ai][bj][m][0], acc[ai][bj][m][1]); } }
    }
};

struct EpiDown {
    static constexpr bool PERM = false, AFTER_DRAIN = false, MIDK = false;
    const float* gt2; float* OUT; float* SSQ2;
    __device__ __forceinline__ void mid(f32x4 (&)[2][2][4][2], const Unit&, int, int) const {}
    __device__ __forceinline__ void operator()(const f32x4 (&acc)[2][2][4][2], const Unit& u, int wr, int wc, int fr, int fq) const {
        const int col0 = u.pn * BM + wc * 32 + 4 * fq;
        f32x4 gv[2][2];
#pragma unroll
        for (int bj = 0; bj < 2; ++bj)
#pragma unroll
            for (int n = 0; n < 2; ++n) gv[bj][n] = *(const f32x4*)(gt2 + col0 + bj * HALF + n * 16);
#pragma unroll
        for (int ai = 0; ai < 2; ++ai)
#pragma unroll
            for (int m = 0; m < 4; ++m) { const int row = u.pm * BM + ai * HALF + wr * 64 + m * 16 + fr; const size_t off = (size_t)row * DM + col0; float s = 0.f;
#pragma unroll
                for (int bj = 0; bj < 2; ++bj)
#pragma unroll
                    for (int n = 0; n < 2; ++n) { const f32x4 hv = *(const f32x4*)(OUT + off + bj * HALF + n * 16);
                        const f32x4 o = hv + gv[bj][n] * acc[ai][bj][m][n]; s += (o[0] * o[0] + o[1] * o[1]) + (o[2] * o[2] + o[3] * o[3]);
                        *(f32x4*)(OUT + off + bj * HALF + n * 16) = o; }
                s += __shfl_xor(s, 16); s += __shfl_xor(s, 32);
                if (fq == 0) SSQ2[(size_t)row * 32 + u.pn * 4 + wc] = s; }
    }
};
}
#include <hip/hip_bf16.h>
namespace att {
#define BIAS_LAS __attribute__((address_space(3)))
using bf16 = __hip_bfloat16;
typedef short bf16x8 __attribute__((ext_vector_type(8)));
typedef short s16x4 __attribute__((ext_vector_type(4)));
typedef float f32x16 __attribute__((ext_vector_type(16)));
typedef float f32x4 __attribute__((ext_vector_type(4)));
typedef unsigned u32x4 __attribute__((ext_vector_type(4)));
template <class A, class Bt> struct same_t { static constexpr bool v = false; };
template <class A> struct same_t<A, A> { static constexpr bool v = true; };
constexpr int D = 128, LDO = 2048;
constexpr float SCALE = 0.08838834764831845f;
constexpr float THR = 8.f;
constexpr bool WSKIP = false;
constexpr bool SEAM_PREFETCH = false;
constexpr int NW = 8, QBLK = 32, KVBLK = 64, QB = NW * QBLK;
constexpr int SHM_V = KVBLK * D * 2, SHM_K = KVBLK * D * 2;
constexpr int ATT_LDS = 2 * SHM_V + 2 * SHM_K + NW * 64 * 4;
constexpr int BIAS_OFF = 69632;
#define KSWZ(row, colB) ((row) * 256 + ((colB) ^ (((row) & 7) << 4)))
#define SBAR() __builtin_amdgcn_sched_barrier(0)
__device__ __forceinline__ int v_st(int k, int c) { const int kk = (k & ~0xC) | ((k & 4) << 1) | ((k & 8) >> 1); return ((kk >> 3) * 4 + (c >> 5)) * 512 + ((kk & 7) * 32 + (c & 31)) * 2; }
__device__ __forceinline__ int v_rd_base(int lane) { return ((lane & 3) << 3) | (((lane >> 2) & 3) << 6) | (((lane >> 4) & 1) << 5) | (((lane >> 5) & 1) << 8); }
constexpr int v_rd_off(int d0, int ks, int half) { return d0 * 512 + ks * 4096 + half * 2048; }
__device__ __forceinline__ int crow(int r, int hi) { return (r & 3) + 8 * (r >> 2) + 4 * hi; }
__device__ __forceinline__ unsigned cvtpk(float lo, float hi) {
    unsigned r; asm volatile("v_cvt_pk_bf16_f32 %0, %1, %2" : "=v"(r) : "v"(lo), "v"(hi)); return r;
}
__device__ __forceinline__ bf16x8 pack8(f32x4 a, f32x4 b) {
    u32x4 w = {cvtpk(a[0], a[1]), cvtpk(a[2], a[3]), cvtpk(b[0], b[1]), cvtpk(b[2], b[3])};
    return *reinterpret_cast<bf16x8*>(&w);
}
template <class T> __device__ __forceinline__ bf16x8 load8(const T* p) {
    if constexpr (same_t<T, float>::v) { return pack8(*(const f32x4*)p, *(const f32x4*)(p + 4)); }
    else { return *reinterpret_cast<const bf16x8*>(p); }
}
__device__ __forceinline__ void mask_tile(f32x16& p0, f32x16& p1, int dq, unsigned W) {
    const float NEG = -__builtin_inff();
#pragma unroll
    for (int r = 0; r < 16; ++r) {
        const int c = (r & 3) + 8 * (r >> 2);
        if ((unsigned)(dq - c) >= W) p0[r] = NEG;
        if ((unsigned)(dq - c - 32) >= W) p1[r] = NEG;
    }
}
__device__ __forceinline__ void partialSM(f32x16& p0, f32x16& p1, float& m_reg, float& mn, float& alpha) {
    float pmax = p0[0]; for (int r = 1; r < 16; ++r) pmax = fmaxf(pmax, p0[r]); for (int r = 0; r < 16; ++r) pmax = fmaxf(pmax, p1[r]);
    { auto rr = __builtin_amdgcn_permlane32_swap(__float_as_uint(pmax), __float_as_uint(pmax), false, false);
      pmax = fmaxf(__uint_as_float(rr[0]), __uint_as_float(rr[1])); }
    constexpr float C2 = 1.4426950408889634f * SCALE;
    if (__builtin_expect(__all((pmax - m_reg) * SCALE <= THR), 1)) { mn = m_reg; alpha = 1.f; }
    else { mn = fmaxf(m_reg, pmax); alpha = __builtin_amdgcn_exp2f((m_reg - mn) * C2); m_reg = mn; }
    const float mnL = -mn * C2;
    for (int r = 0; r < 16; ++r) p0[r] = fmaf(p0[r], C2, mnL); for (int r = 0; r < 16; ++r) p1[r] = fmaf(p1[r], C2, mnL);
    for (int r = 0; r < 16; ++r) p0[r] = __builtin_amdgcn_exp2f(p0[r]);
}
__device__ __forceinline__ void finishSM(f32x16& p0, f32x16& p1, float alpha, float& l_reg, bf16x8& pa0, bf16x8& pa1, bf16x8& pa2, bf16x8& pa3) {
    for (int r = 0; r < 16; ++r) p1[r] = __builtin_amdgcn_exp2f(p1[r]);
    float ps = 0; for (int r = 0; r < 16; ++r) ps += p0[r]; for (int r = 0; r < 16; ++r) ps += p1[r];
    { auto rr = __builtin_amdgcn_permlane32_swap(__float_as_uint(ps), __float_as_uint(ps), false, false);
      ps = __uint_as_float(rr[0]) + __uint_as_float(rr[1]); }
    l_reg = l_reg * alpha + ps;
#define PK4(P, B_, OUT) do { unsigned a0 = cvtpk(P[B_+0], P[B_+1]), a1 = cvtpk(P[B_+2], P[B_+3]);                          \
        unsigned b0 = cvtpk(P[B_+4], P[B_+5]), b1 = cvtpk(P[B_+6], P[B_+7]);                                             \
        auto r0 = __builtin_amdgcn_permlane32_swap(a0, b0, false, false); auto r1 = __builtin_amdgcn_permlane32_swap(a1, b1, false, false); \
        u32x4 w = {r0[0], r1[0], r0[1], r1[1]}; OUT = *reinterpret_cast<bf16x8*>(&w); } while (0)
    PK4(p0, 0, pa0); PK4(p0, 8, pa1); PK4(p1, 0, pa2); PK4(p1, 8, pa3);
#undef PK4
}
template <int KB, bool SK>
__device__ __forceinline__ void qkt(f32x16& p0, f32x16& p1, const char* K_lds, int r32, int hi, const bf16x8* qr, bool act, const BIAS_LAS float* bp) {
    if (SK && !act) { const float NEG = -__builtin_inff();
#pragma unroll
        for (int r = 0; r < 16; ++r) { p0[r] = NEG; p1[r] = NEG; } return; }
#ifdef NOBIAS
    p0 = f32x16{}; p1 = f32x16{};
#else
    { const BIAS_LAS f32x4* b4 = (const BIAS_LAS f32x4*)bp;
      const f32x4 t0 = b4[0], t1 = b4[2], t2 = b4[4], t3 = b4[6], t4 = b4[8], t5 = b4[10], t6 = b4[12], t7 = b4[14];
      p0 = f32x16{t0[0], t0[1], t0[2], t0[3], t1[0], t1[1], t1[2], t1[3], t2[0], t2[1], t2[2], t2[3], t3[0], t3[1], t3[2], t3[3]};
      p1 = f32x16{t4[0], t4[1], t4[2], t4[3], t5[0], t5[1], t5[2], t5[3], t6[0], t6[1], t6[2], t6[3], t7[0], t7[1], t7[2], t7[3]}; }
#endif
    const char* kb[4];
#pragma unroll
    for (int dd = 0; dd < 4; ++dd) kb[dd] = K_lds + KB * SHM_K + KSWZ(r32, (dd * 16 + hi * 8) * 2);
#pragma unroll
    for (int d0 = 0; d0 < 8; ++d0) { const char* a = kb[d0 & 3] + (d0 >> 2) * 128;
        bf16x8 b0 = *reinterpret_cast<const bf16x8*>(a);
        bf16x8 b1 = *reinterpret_cast<const bf16x8*>(a + 32 * 256);
        p0 = __builtin_amdgcn_mfma_f32_32x32x16_bf16(b0, qr[d0], p0, 0, 0, 0);
        p1 = __builtin_amdgcn_mfma_f32_32x32x16_bf16(b1, qr[d0], p1, 0, 0, 0); }
}
template <int VB, bool SK>
__device__ __forceinline__ void pv_tile(f32x16* o, int vb0, bf16x8 pa0, bf16x8 pa1, bf16x8 pa2, bf16x8 pa3, bool act) {
    if (SK && !act) return;
#define TRRD(dst, off) asm volatile("ds_read_b64_tr_b16 %0, %1 offset:%2" : "=&v"(dst) : "v"(vb0), "i"(off) : "memory")
#define PV_D0(d0) do { s16x4 l0, l1, l2, l3, h0, h1, h2, h3; constexpr int b_ = VB * SHM_V + v_rd_off(d0, 0, 0);     \
        TRRD(l0, b_); TRRD(h0, b_ + 2048); TRRD(l1, b_ + 4096); TRRD(h1, b_ + 6144); TRRD(l2, b_ + 8192); TRRD(h2, b_ + 10240); TRRD(l3, b_ + 12288); TRRD(h3, b_ + 14336); \
        asm volatile("s_waitcnt lgkmcnt(0)" ::: "memory"); SBAR();                 \
        o[d0] = __builtin_amdgcn_mfma_f32_32x32x16_bf16(pa0, (bf16x8){l0[0], l0[1], l0[2], l0[3], h0[0], h0[1], h0[2], h0[3]}, o[d0], 0, 0, 0);   \
        o[d0] = __builtin_amdgcn_mfma_f32_32x32x16_bf16(pa1, (bf16x8){l1[0], l1[1], l1[2], l1[3], h1[0], h1[1], h1[2], h1[3]}, o[d0], 0, 0, 0);   \
        o[d0] = __builtin_amdgcn_mfma_f32_32x32x16_bf16(pa2, (bf16x8){l2[0], l2[1], l2[2], l2[3], h2[0], h2[1], h2[2], h2[3]}, o[d0], 0, 0, 0);   \
        o[d0] = __builtin_amdgcn_mfma_f32_32x32x16_bf16(pa3, (bf16x8){l3[0], l3[1], l3[2], l3[3], h3[0], h3[1], h3[2], h3[3]}, o[d0], 0, 0, 0); } while (0)
    PV_D0(0); PV_D0(1); PV_D0(2); PV_D0(3);
#undef PV_D0
#undef TRRD
}
template <class TIn, class TOut> struct BlockRef { const TIn* Q; const TIn* K; const TIn* V; TOut* O; int P0; int JLO; float* SSQ; };
template <class TIn> struct Seam {
    bf16x8 qr[8];
    bf16x8 st_v0, st_v1, st_k0, st_k1; f32x4 sf0, sf1, sf2, sf3;
    f32x4 tq[16];
};
#define ROW(p, k0, rr) ((p) + (size_t)((k0) + (rr)) * D + sc)
#define VMW() asm volatile("s_waitcnt vmcnt(0)" ::: "memory")
#define VMWN(n) asm volatile("s_waitcnt vmcnt(%0)" :: "i"(n) : "memory")
#define SLOAD_H(Kp, Vp, k0) do { S.st_v0 = load8<TIn>(ROW(Vp, k0, sr)); S.st_v1 = load8<TIn>(ROW(Vp, k0, 32 + sr));              \
                         S.st_k0 = load8<TIn>(ROW(Kp, k0, sr)); S.st_k1 = load8<TIn>(ROW(Kp, k0, 32 + sr)); } while (0)
#define SWRITE_HK(bf) do { *(bf16x8*)(K_lds + (bf) * SHM_K + kws) = S.st_k0; *(bf16x8*)(K_lds + (bf) * SHM_K + kws + 32 * 256) = S.st_k1; } while (0)
#define SWRITE_HV(bf) do { *(bf16x8*)(V_lds + (bf) * SHM_V + vst0) = S.st_v0; *(bf16x8*)(V_lds + (bf) * SHM_V + vst1) = S.st_v1; } while (0)
#define SWRITE_H(bf) do { SWRITE_HV(bf); SWRITE_HK(bf); } while (0)
#define SLOAD_F(p, k0) do { S.sf0 = *(const f32x4*)ROW(p, k0, sr); S.sf1 = *(const f32x4*)(ROW(p, k0, sr) + 4);                \
                            S.sf2 = *(const f32x4*)ROW(p, k0, 32 + sr); S.sf3 = *(const f32x4*)(ROW(p, k0, 32 + sr) + 4); } while (0)
#define SWRITE_KF(bf) do { *(bf16x8*)(K_lds + (bf) * SHM_K + kws) = pack8(S.sf0, S.sf1); *(bf16x8*)(K_lds + (bf) * SHM_K + kws + 32 * 256) = pack8(S.sf2, S.sf3); } while (0)
#define SWRITE_VF(bf) do { *(bf16x8*)(V_lds + (bf) * SHM_V + vst0) = pack8(S.sf0, S.sf1); *(bf16x8*)(V_lds + (bf) * SHM_V + vst1) = pack8(S.sf2, S.sf3); } while (0)
template <class TIn, class TOut>
__device__ __forceinline__ void causal_swa_prime(const BlockRef<TIn, TOut>& cur, int W, char* lds, Seam<TIn>& S, const int wv) {
    constexpr bool F32 = same_t<TIn, float>::v;
    int tid_ = wv * 64 + ((int)__builtin_amdgcn_mbcnt_hi(~0u, __builtin_amdgcn_mbcnt_lo(~0u, 0u))); asm volatile("" : "+v"(tid_));
    const int tid = tid_, wid = __builtin_amdgcn_readfirstlane(tid >> 6), lane = tid & 63, r32 = lane & 31, hi = lane >> 5;
    const int sr = tid >> 4, sc = (tid & 15) * 8, kws = KSWZ(sr, sc * 2); char* K_lds = lds + 2 * SHM_V;
    const int kb0 = cur.JLO * KVBLK;
    for (int d0 = 0; d0 < 8; ++d0) S.qr[d0] = load8<TIn>(cur.Q + (size_t)(wid * QBLK + r32) * D + d0 * 16 + hi * 8);
    if constexpr (F32) { SLOAD_F((const float*)cur.K, kb0); VMW(); SWRITE_KF(0); SBAR(); SLOAD_F((const float*)cur.V, kb0); }
    else { SLOAD_H(cur.K, cur.V, kb0); VMW(); SWRITE_HK(0); }
    __syncthreads();
}
template <class TIn, class TOut>
__device__ __forceinline__ void causal_swa_block(const BlockRef<TIn, TOut>& cur, const BlockRef<TIn, TOut>& nxt, int skv, int W, char* lds, Seam<TIn>& S, const BIAS_LAS float* bias, const int wv) {
    constexpr bool F32 = same_t<TIn, float>::v;
    int tid_ = wv * 64 + ((int)__builtin_amdgcn_mbcnt_hi(~0u, __builtin_amdgcn_mbcnt_lo(~0u, 0u))); asm volatile("" : "+v"(tid_));
    const int tid = tid_, wid = __builtin_amdgcn_readfirstlane(tid >> 6), lane = tid & 63, r32 = lane & 31, hi = lane >> 5;
    const int j_lo = cur.JLO; const BIAS_LAS float* bias4 = bias + 4 * hi;
    int j_hi = (cur.P0 + QB - 1) / KVBLK + 1; if (j_hi > skv / KVBLK) j_hi = skv / KVBLK;
    const int NT = j_hi - j_lo;
    const int kbn = nxt.JLO * KVBLK;
    const int qlo = cur.P0 + wid * QBLK, qm = qlo + r32 - 4 * hi;
    char* V_lds = lds; char* K_lds = lds + 2 * SHM_V;
    float* ws = (float*)(lds + 2 * SHM_V + 2 * SHM_K) + wid * 64; float* li_l = ws, * al_l = ws + 32;
    float m_reg = -1e30f, l_reg = 0; f32x16 o[4] = {};
    const int sr = tid >> 4, sc = (tid & 15) * 8, vst0 = v_st(sr, sc), vst1 = v_st(32 + sr, sc), kws = KSWZ(sr, sc * 2);
    const int vb0 = (int)(uintptr_t)V_lds + v_rd_base(lane);
    const TIn* Kh = cur.K; const TIn* Vh = cur.V;
#define RESC(a) do { if (__any((a) < 1.f)) { if (hi == 0) al_l[r32] = (a); asm volatile("s_waitcnt lgkmcnt(0)" ::: "memory");              \
                     for (int d_ = 0; d_ < 4; ++d_) for (int r = 0; r < 16; ++r) o[d_][r] *= al_l[crow(r, hi)]; } } while (0)
#define KBASE(t) ((j_lo + (t)) * KVBLK)
#define BP(t) (bias4 + (t) * KVBLK)
#define ACT(t) (KBASE(t) <= qlo + QBLK - 1 && KBASE(t) + KVBLK - 1 >= qlo - W + 1)
#define MASKT(P0_, P1_, t) do { const int kb_ = KBASE(t); if ((!SK || ACT(t)) && (kb_ + KVBLK - 1 > qlo || kb_ <= qlo + QBLK - 1 - W)) mask_tile(P0_, P1_, qm - kb_, (unsigned)W); } while (0)
    constexpr int NQL = F32 ? 16 : 8;
    constexpr bool SK = WSKIP && !F32;
#define SEAM_K0() do { VMWN(NQL); if constexpr (F32) { SWRITE_KF(0); SBAR(); SLOAD_F((const float*)nxt.V, kbn); } else { SWRITE_HK(0); } SBAR(); } while (0)
    f32x16 pA0, pA1, pB0, pB1; float mnA, mnB, alA, alB; bf16x8 pa0, pa1, pa2, pa3;
    if constexpr (F32) { VMW(); SWRITE_VF(0); SBAR(); } else { SWRITE_HV(0); SBAR(); }
    if (NT > 1) { if constexpr (F32) SLOAD_F((const float*)Kh, KBASE(1)); else SLOAD_H(Kh, Vh, KBASE(1)); }
    SBAR(); qkt<0, SK>(pA0, pA1, K_lds, r32, hi, S.qr, ACT(0), BP(0));
    if constexpr (F32) { if (NT > 1) { VMW(); SWRITE_KF(1); SBAR(); SLOAD_F((const float*)Vh, KBASE(1)); } }
    MASKT(pA0, pA1, 0); partialSM(pA0, pA1, m_reg, mnA, alA);
    if (NT > 1) { VMW(); if constexpr (F32) { SWRITE_VF(1); SBAR(); if (NT > 2) SLOAD_F((const float*)Kh, KBASE(2)); } else SWRITE_H(1); }
    __syncthreads();
#define HALF_STEP(PX0, PX1, mnX, alX, PY0, PY1, alY, t, KB, VB, SB) do {                                                      \
        SBAR(); qkt<KB, SK>(PX0, PX1, K_lds, r32, hi, S.qr, ACT(t), BP(t));                                             \
        finishSM(PY0, PY1, alY, l_reg, pa0, pa1, pa2, pa3); SBAR();                                                           \
        if ((t) + 1 < NT) { if constexpr (F32) { VMW(); SWRITE_KF(SB); SBAR(); SLOAD_F((const float*)Vh, KBASE((t) + 1)); }  \
                            else { SLOAD_H(Kh, Vh, KBASE((t) + 1)); } SBAR(); }                                               \
        pv_tile<VB, SK>(o, vb0, pa0, pa1, pa2, pa3, ACT((t) - 1)); MASKT(PX0, PX1, (t)); partialSM(PX0, PX1, m_reg, mnX, alX);                                        \
        __syncthreads();                                                                                                      \
        if ((t) + 1 < NT) { VMW(); if constexpr (F32) { SWRITE_VF(SB); SBAR(); if ((t) + 2 < NT) SLOAD_F((const float*)Kh, KBASE((t) + 2)); } \
                            else { SWRITE_H(SB); } }                                                                          \
        RESC(alX); __syncthreads(); } while (0)
    for (int t = 1; t + 1 < NT; t += 2) {
        HALF_STEP(pB0, pB1, mnB, alB, pA0, pA1, alA, t, 1, 0, 0);
        HALF_STEP(pA0, pA1, mnA, alA, pB0, pB1, alB, t + 1, 0, 1, 1);
    }
    const bool even = (NT & 1) == 0;
    if (even) { SBAR(); qkt<1, SK>(pB0, pB1, K_lds, r32, hi, S.qr, ACT(NT - 1), BP(NT - 1)); SBAR(); }
#define QROW(e) (nxt.Q + (size_t)(wid * QBLK + r32) * D + ((e) >> 1) * 16 + hi * 8 + ((e) & 1) * 4)
    if constexpr (F32) { SLOAD_F((const float*)nxt.K, kbn); SBAR();
#pragma unroll
        for (int e = 0; e < 8; ++e) S.tq[e] = *(const f32x4*)QROW(e); }
    else if constexpr (SEAM_PREFETCH) { SLOAD_H(nxt.K, nxt.V, kbn); SBAR();
#pragma unroll
        for (int d0 = 0; d0 < 8; ++d0) S.qr[d0] = load8<TIn>(nxt.Q + (size_t)(wid * QBLK + r32) * D + d0 * 16 + hi * 8); }
    SBAR();
    finishSM(pA0, pA1, alA, l_reg, pa0, pa1, pa2, pa3); SBAR();
    if constexpr (F32) {
#pragma unroll
        for (int e = 8; e < 16; ++e) S.tq[e] = *(const f32x4*)QROW(e); SBAR(); }
#undef QROW
    pv_tile<0, SK>(o, vb0, pa0, pa1, pa2, pa3, ACT(even ? NT - 2 : NT - 1));
    if (even) { MASKT(pB0, pB1, NT - 1); partialSM(pB0, pB1, m_reg, mnB, alB); __syncthreads(); RESC(alB);
        finishSM(pB0, pB1, alB, l_reg, pa0, pa1, pa2, pa3); SBAR(); pv_tile<1, SK>(o, vb0, pa0, pa1, pa2, pa3, ACT(NT - 1)); }
    SBAR(); if constexpr (SEAM_PREFETCH) SEAM_K0();
    if (hi == 0) li_l[r32] = l_reg; asm volatile("s_waitcnt lgkmcnt(0)" ::: "memory");
    float rli[16];
#pragma unroll
    for (int r = 0; r < 16; ++r) rli[r] = __builtin_amdgcn_rcpf(li_l[crow(r, hi)]);
    TOut* Ow = cur.O + (size_t)(wid * QBLK) * LDO;
#pragma unroll
    for (int r = 0; r < 16; ++r) { int orow = crow(r, hi); asm volatile("" : "+v"(orow)); float sq = 0.f;
#pragma unroll
        for (int d0 = 0; d0 < 4; ++d0) { const float v = o[d0][r] * rli[r]; sq += v * v;
            { const float vn = __shfl_xor(v, 1);
                   if ((r32 & 1) == 0) *(unsigned*)(Ow + (size_t)orow * LDO + d0 * 32 + r32) = cvtpk(v, vn); } }
        sq += __shfl_xor(sq, 1); sq += __shfl_xor(sq, 2); sq += __shfl_xor(sq, 4); sq += __shfl_xor(sq, 8); sq += __shfl_xor(sq, 16);
        if (r32 == 0) cur.SSQ[(size_t)(wid * QBLK + orow) * 32] = sq; }
    if constexpr (F32) {
#pragma unroll
        for (int d0 = 0; d0 < 8; ++d0) S.qr[d0] = pack8(S.tq[2 * d0], S.tq[2 * d0 + 1]); }
    __syncthreads();
#undef RESC
#undef KBASE
#undef BP
#undef ACT
#undef MASKT
#undef SEAM_K0
#undef HALF_STEP
}
#undef ROW
#undef VMW
#undef VMWN
#undef SLOAD_H
#undef SWRITE_HK
#undef SWRITE_HV
#undef SWRITE_H
#undef SLOAD_F
#undef SWRITE_KF
#undef SWRITE_VF
}
#define LAS __attribute__((address_space(3)))
typedef unsigned short bf16_t;
struct Args { const float* in[26]; float* out; unsigned char* ws; };

#define XB_TMO      128
#define XB_XCNT(j)  (256  + 64 * (j))
#define XB_XSUB(j)  (1280 + 64 * (j))
#define XB_XGEN(j)  (2304 + 64 * (j))
#define XB_TOP      3328
#define XB_TOPGEN   3392
#define XCD_BAR_WORDS 3456
#define XB_SPIN_CAP (1u << 18)

__device__ __forceinline__ unsigned xb_ld(unsigned* p)              { return __hip_atomic_load(p, __ATOMIC_RELAXED, __HIP_MEMORY_SCOPE_AGENT); }
__device__ __forceinline__ unsigned xb_add(unsigned* p, unsigned v) { return __hip_atomic_fetch_add(p, v, __ATOMIC_RELAXED, __HIP_MEMORY_SCOPE_AGENT); }
__device__ __forceinline__ unsigned xb_xcc_id() { return (unsigned)__builtin_amdgcn_s_getreg((3 << 11) | 20) & 0xFu; }
#define XB_SPIN(cond, bar) do { unsigned _sp = 0; while (cond) { __builtin_amdgcn_s_sleep(1); \
    if ((++_sp & 255u) == 0u) { if (xb_ld(&(bar)[XB_TMO])) break; if (_sp > XB_SPIN_CAP) { atomicAdd(&(bar)[XB_TMO], 1u); break; } } } } while (0)

struct XcdBarrier {
    unsigned* bar; unsigned x;
    volatile LAS unsigned* st;
};

__device__ __forceinline__ XcdBarrier xcd_barrier_post(unsigned* bar, volatile LAS unsigned* st, bool t0) {
    XcdBarrier b; b.bar = bar; b.x = xb_xcc_id(); b.st = st;
    if (t0) (void)xb_add(&bar[XB_XCNT(b.x)], 1u);
    return b;
}
__device__ __forceinline__ void xcd_barrier_complete(unsigned* bar, unsigned x, unsigned& nloc, unsigned& nx) {
    const unsigned G = gridDim.x * gridDim.y * gridDim.z;
    unsigned sum, cnt, mine, sp = 0u;
    for (;;) {
        sum = 0u; cnt = 0u; mine = 0u;
#pragma unroll
        for (unsigned j = 0; j < 16; ++j) { const unsigned c = xb_ld(&bar[XB_XCNT(j)]); sum += c; cnt += (c > 0u) ? 1u : 0u; mine = (j == x) ? c : mine; }
        if (sum == G) break;
        __builtin_amdgcn_s_sleep(1);
        if ((++sp & 255u) == 0u) { if (xb_ld(&bar[XB_TMO])) break; if (sp > XB_SPIN_CAP) { atomicAdd(&bar[XB_TMO], 1u); break; } }
    }
    nloc = mine > 0u ? mine : 1u; nx = cnt > 0u ? cnt : 1u;
}

__device__ __forceinline__ void xcd_barrier(const XcdBarrier& b, bool t0) {
    asm volatile("s_waitcnt vmcnt(0)" ::: "memory");
    __syncthreads();
    if (t0) {
        unsigned* bar = b.bar;
        __builtin_amdgcn_s_waitcnt(0);
        unsigned nloc = b.st[0], nx = b.st[1];
        if (nloc == 0u) { xcd_barrier_complete(bar, b.x, nloc, nx); b.st[0] = nloc; b.st[1] = nx; }
        const unsigned old = xb_add(&bar[XB_XSUB(b.x)], 1u);
        const unsigned gen = old / nloc;
        if (old + 1u == (gen + 1u) * nloc) {
            __builtin_amdgcn_fence(__ATOMIC_RELEASE, "agent");
            asm volatile("s_waitcnt vmcnt(0)" ::: "memory");
            const unsigned og = xb_add(&bar[XB_TOP], 1u);
            const unsigned tg = og / nx;
            if (og + 1u == (tg + 1u) * nx) xb_add(&bar[XB_TOPGEN], 1u);
            else XB_SPIN(xb_ld(&bar[XB_TOPGEN]) == tg, bar);
            __builtin_amdgcn_fence(__ATOMIC_ACQUIRE, "agent");
            xb_add(&bar[XB_XGEN(b.x)], 1u);
            asm volatile("s_waitcnt vmcnt(0)" ::: "memory");
        } else {
            XB_SPIN(xb_ld(&bar[XB_XGEN(b.x)]) == gen, bar);
            __builtin_amdgcn_fence(__ATOMIC_ACQUIRE, "agent");
            asm volatile("s_waitcnt vmcnt(0)" ::: "memory");
        }
    }
    __syncthreads();
}

__device__ __forceinline__ float wave_sum(float v) {
#pragma unroll
    for (int o = 1; o < 64; o <<= 1) v += __shfl_xor(v, o);
    return v;
}
__device__ __forceinline__ unsigned pk2(float lo, float hi) { return pg8::cvt_pk_bf16(lo, hi); }

__device__ __forceinline__ void tr_item(const float* __restrict__ W, int ldw, int srccol0, int k0, bf16_t* __restrict__ WT, int K, int dstrow0,
                                        const float* rs0, const float* rs1, LAS float* scr, int lane) {
    float tv[32];
    const float* wp = W + (size_t)(k0 + (lane >> 5)) * ldw + srccol0 + (lane & 31);
#pragma unroll
    for (int i = 0; i < 32; ++i) tv[i] = wp[(size_t)(2 * i) * ldw];
#pragma unroll
    for (int i = 0; i < 32; ++i) { const int kk = 2 * i + (lane >> 5); float v = tv[i];
        if (rs0) { const int k = k0 + kk; v *= (k < 1024 ? rs0[k] : rs1[k - 1024]); }
        scr[kk * 33 + (lane & 31)] = v; }
    asm volatile("s_waitcnt lgkmcnt(0)" ::: "memory");
    const int c = lane & 7;
#pragma unroll
    for (int j = 0; j < 4; ++j) { const int n = (lane >> 3) + 8 * j; const LAS float* s = scr + (8 * c) * 33 + n;
        u32x4_t o; o.x = pk2(s[0 * 33], s[1 * 33]); o.y = pk2(s[2 * 33], s[3 * 33]); o.z = pk2(s[4 * 33], s[5 * 33]); o.w = pk2(s[6 * 33], s[7 * 33]);
        *(u32x4_t*)(WT + (size_t)(dstrow0 + n) * K + k0 + 8 * c) = o; }
    asm volatile("s_waitcnt lgkmcnt(0)" ::: "memory");
}

__device__ __forceinline__ void ssm_setup_item(const Args& a, unsigned char* ws, LAS unsigned char* lds, int g, int qtr, int tid) {
    LAS float* Bre = (LAS float*)lds; LAS float* Bim = Bre + 1024; LAS float* Cre = Bre + 2048; LAS float* Cim = Bre + 3072;
    LAS float* Pr = Bre + 4096; LAS float* Pi = Pr + 33 * 64; LAS float* MZr = Pi + 33 * 64; LAS float* MZi = MZr + 32 * 64; LAS float* KT = MZi + 32 * 64;
    const float* b_re = a.in[10] + (size_t)g * 1024; const float* b_im = a.in[11] + (size_t)g * 1024;
    const float* c_re = a.in[12] + (size_t)g * 1024; const float* c_im = a.in[13] + (size_t)g * 1024;
    for (int i = tid; i < 1024; i += 512) { Bre[i] = b_re[i]; Bim[i] = b_im[i]; Cre[i] = c_re[i]; Cim[i] = c_im[i]; }
    if (tid < 64) {
        const int p = tid; const float dt = expf(a.in[9][g]); const float ar = a.in[7][g * NP + p], ai = a.in[8][g * NP + p];
        const float mag = expf(dt * ar); const float abr = mag * cosf(dt * ai), abi = mag * sinf(dt * ai);
        const float nre = abr - 1.f, nim = abi, den = ar * ar + ai * ai;
        const float zr = (nre * ar + nim * ai) / den, zi = (nim * ar - nre * ai) / den;
        float pr = 1.f, pi = 0.f;
        for (int j = 0; j <= 32; ++j) {
            Pr[j * 64 + p] = pr; Pi[j * 64 + p] = pi;
            if (j < 32) { MZr[p * 32 + j] = pr * zr - pi * zi; MZi[p * 32 + j] = pr * zi + pi * zr; }
            const float nr = pr * abr - pi * abi, ni = pr * abi + pi * abr; pr = nr; pi = ni;
        }
        if (qtr == 0) { float* P32 = (float*)(ws + WS_P32); P32[(g * NP + p) * 2] = Pr[32 * 64 + p]; P32[(g * NP + p) * 2 + 1] = Pi[32 * 64 + p]; }
    }
    __syncthreads();
    const float* dsk = a.in[14] + g * GCH;
    {
        const int h = (tid & 255) >> 4, i = tid & 15, j0 = (tid >> 8) * 16;
        float acc[16];
#pragma unroll
        for (int jj = 0; jj < 16; ++jj) acc[jj] = 0.f;
        for (int p = 0; p < 64; ++p) {
            const float cr = Cre[h * 64 + p], ci = Cim[h * 64 + p], br = Bre[p * 16 + i], bi = Bim[p * 16 + i];
            const float cbr = cr * br - ci * bi, cbi = cr * bi + ci * br;
#pragma unroll
            for (int q = 0; q < 4; ++q) { const f32x4_t mr = *(const LAS f32x4_t*)(MZr + p * 32 + j0 + 4 * q), mi = *(const LAS f32x4_t*)(MZi + p * 32 + j0 + 4 * q);
#pragma unroll
                for (int e = 0; e < 4; ++e) acc[4 * q + e] += mr[e] * cbr - mi[e] * cbi; }
        }
        if (j0 == 0 && h == i) acc[0] += dsk[h];
#pragma unroll
        for (int jj = 0; jj < 16; ++jj) KT[((j0 + jj) << 8) + (h << 4) + i] = acc[jj];
    }
    __syncthreads();
    bf16_t* GC = (bf16_t*)(ws + WS_GC) + (size_t)g * 512 * KA;
    for (int ci = tid; ci < 128 * 80; ci += 512) {
        const int nl = ci / 80, ch = ci - nl * 80, n = qtr * 128 + nl, t = n >> 4, h = n & 15; float v[8];
        if (ch < 64) { const int s = ch >> 1, i0 = (ch & 1) * 8;
            if (s <= t) { const f32x4_t k0v = *(const LAS f32x4_t*)(KT + ((t - s) << 8) + (h << 4) + i0), k1v = *(const LAS f32x4_t*)(KT + ((t - s) << 8) + (h << 4) + i0 + 4);
                v[0] = k0v[0]; v[1] = k0v[1]; v[2] = k0v[2]; v[3] = k0v[3]; v[4] = k1v[0]; v[5] = k1v[1]; v[6] = k1v[2]; v[7] = k1v[3]; }
            else {
#pragma unroll
                for (int e = 0; e < 8; ++e) v[e] = 0.f; }
        } else { const int pp = (ch - 64) * 8;
#pragma unroll
            for (int e = 0; e < 8; ++e) { const int p = (pp + e) & 63; const float cr = Cre[h * 64 + p], cim = Cim[h * 64 + p], pr = Pr[(t + 1) * 64 + p], pi = Pi[(t + 1) * 64 + p];
                v[e] = (pp < 64) ? (cr * pr - cim * pi) : -(cr * pi + cim * pr); }
        }
        u32x4_t o; o.x = pk2(v[0], v[1]); o.y = pk2(v[2], v[3]); o.z = pk2(v[4], v[5]); o.w = pk2(v[6], v[7]);
        *(u32x4_t*)(GC + (size_t)n * KA + ch * 8) = o;
    }
    bf16_t* WE = (bf16_t*)(ws + WS_WEND) + (size_t)g * 256 * 512;
    for (int ci = tid; ci < 64 * 64; ci += 512) {
        const int rl = ci >> 6, ch = ci & 63, pr_ = qtr * 64 + rl, s = ch >> 1, i0 = (ch & 1) * 8, p = pr_ & 63; float v[8];
#pragma unroll
        for (int e = 0; e < 8; ++e) { const float mr = MZr[p * 32 + (31 - s)], mi = MZi[p * 32 + (31 - s)], br = Bre[p * 16 + i0 + e], bi = Bim[p * 16 + i0 + e];
            v[e] = (pr_ < 64) ? (mr * br - mi * bi) : ((pr_ < 128) ? (mr * bi + mi * br) : 0.f); }
        u32x4_t o; o.x = pk2(v[0], v[1]); o.y = pk2(v[2], v[3]); o.z = pk2(v[4], v[5]); o.w = pk2(v[6], v[7]);
        *(u32x4_t*)(WE + (size_t)pr_ * 512 + ch * 8) = o;
    }
    __syncthreads();
}

__device__ __forceinline__ void norm_mod_row(const float* xrow, bf16_t* orow, const LAS float* gs, const LAS float* shv, int lane, f32x4_t (&v)[8]) {
    const f32x4_t* xr = (const f32x4_t*)xrow + lane; float s = 0.f;
#pragma unroll
    for (int j = 0; j < 8; ++j) { v[j] = xr[64 * j]; s += (v[j][0] * v[j][0] + v[j][1] * v[j][1]) + (v[j][2] * v[j][2] + v[j][3] * v[j][3]); }
    const float rstd = 1.0f / sqrtf(wave_sum(s) * (1.0f / DM) + EPS);
#pragma unroll
    for (int j = 0; j < 8; ++j) { const int k = 4 * lane + 256 * j; const f32x4_t g4 = *(const LAS f32x4_t*)(gs + k), s4 = *(const LAS f32x4_t*)(shv + k);
        v[j] = v[j] * rstd * g4 + s4;
        u32x2_t o; o.x = pk2(v[j][0], v[j][1]); o.y = pk2(v[j][2], v[j][3]); *(u32x2_t*)(orow + k) = o; }
}

__global__ void __launch_bounds__(512, 2) fwd_kernel(Args a) {
    extern __shared__ __attribute__((aligned(16))) unsigned char lds_raw[];
    LAS unsigned char* lds = (LAS unsigned char*)lds_raw;
    const int wave = __builtin_amdgcn_readfirstlane((int)threadIdx.x >> 6), G = gridDim.x, bid = blockIdx.x;
#define lane ((int)__builtin_amdgcn_mbcnt_hi(~0u, __builtin_amdgcn_mbcnt_lo(~0u, 0u)))
#define tid (wave * 64 + lane)
    const int gw = bid * 8 + wave, NGW = G * 8;
    unsigned char* ws = a.ws;
    volatile LAS unsigned* xst = (volatile LAS unsigned*)(lds + LDS_BYTES - 64);
    if (tid < 2) xst[tid] = 0u;
    __syncthreads();
    XcdBarrier xbar = xcd_barrier_post((unsigned*)(ws + WS_CTL) + 4096, xst, tid == 0);
#define GRID_BAR() xcd_barrier(xbar, tid == 0)
#define MODP ((float*)(ws + WS_MODP))
#define MOD ((float*)(ws + WS_MOD))
#define LF ((float*)(ws + WS_LF))
#define CBR ((float*)(ws + WS_CBR))
#define SSQB ((float*)(ws + WS_SSQ))
#define SSQ2B ((float*)(ws + WS_SSQ2))
#define WDT ((bf16_t*)(ws + WS_WDT))
#define W1T ((bf16_t*)(ws + WS_W1T))
#define WGT ((bf16_t*)(ws + WS_WGT))
#define WOT ((bf16_t*)(ws + WS_WOT))
#define WUT ((bf16_t*)(ws + WS_WUT))
#define GC ((bf16_t*)(ws + WS_GC))
#define WEND ((bf16_t*)(ws + WS_WEND))
#define AALL ((bf16_t*)(ws + WS_AALL))
#define QKV ((bf16_t*)(ws + WS_QKV))
#define YB ((bf16_t*)(ws + WS_YB))
#define MIX ((bf16_t*)(ws + WS_MIX))
#define HN ((bf16_t*)(ws + WS_HN))
#define ABUF ((bf16_t*)(ws + WS_ABUF))
#define BBUF ((bf16_t*)(ws + WS_BBUF))
#define XIN (a.in[0])
#define OUT (a.out)


    {
        LAS f32x4_t* red = (LAS f32x4_t*)lds; const float* cvec = a.in[1]; const float* w_ada = a.in[2];
        for (int it = bid; it < 768; it += G) {
            const int nc = it % 48, ks = it / 48, n0 = nc * 256, k0 = ks * 128 + wave * 16;
            f32x4_t acc = {0.f, 0.f, 0.f, 0.f};
#pragma unroll
            for (int r = 0; r < 16; ++r) { const int k = k0 + r; const float cv = cvec[k]; const float sv = cv / (1.0f + expf(-cv));
                const f32x4_t w = *(const f32x4_t*)(w_ada + (size_t)k * (6 * DM) + n0 + 4 * lane); acc += sv * w; }
            red[wave * 64 + lane] = acc;
            __syncthreads();
            if (tid < 256) { float s = 0.f;
#pragma unroll
                for (int w = 0; w < 8; ++w) s += ((LAS float*)red)[w * 256 + tid];
                MODP[ks * (6 * DM) + n0 + tid] = s; }
            __syncthreads();
        }
    }
    for (int it = bid; it < 4 * NG; it += G) ssm_setup_item(a, ws, lds, it >> 2, it & 3, tid);
    __syncthreads();
    {
        LAS float* scr = (LAS float*)(lds + wave * 16384);
        constexpr int I_IN = 32 * 128, I_GLU = 16 * 32, I_OUT = 32 * 64, I_UP = 32 * 352, I_DN = 88 * 64, I_ALL = I_IN + I_GLU + I_OUT + I_UP + I_DN;
        for (int it = gw; it < I_ALL; it += NGW) {
            int r = it;
            if (r < I_IN) { const int kb = r / 128, n0 = 32 * (r % 128); tr_item(a.in[5], INW, n0 < 3072 ? n0 : n0 + 8, 64 * kb, W1T, DM, n0, nullptr, nullptr, scr, lane); continue; } r -= I_IN;
            if (r < I_GLU) { const int kb = r / 32, n0 = 32 * (r % 32); tr_item(a.in[15], SW, n0, 64 * kb, WGT, SW, n0, nullptr, nullptr, scr, lane); continue; } r -= I_GLU;
            if (r < I_OUT) { const int kb = r / 64, n0 = 32 * (r % 64); tr_item(a.in[19], DM, n0, 64 * kb, WOT, DM, n0, a.in[17], a.in[18], scr, lane); continue; } r -= I_OUT;
            if (r < I_UP) { const int kb = r / 352, n0 = 32 * (r % 352); const int pn = n0 >> 8, bj = (n0 >> 7) & 1, w = n0 & 127;
                tr_item(a.in[21], 2 * DFF, bj * DFF + 128 * pn + w, 64 * kb, WUT, DM, n0, nullptr, nullptr, scr, lane); continue; } r -= I_UP;
            { const int kb = r / 64, n0 = 32 * (r % 64); tr_item(a.in[24], DM, n0, 64 * kb, WDT, DFF, n0, nullptr, nullptr, scr, lane); }
        }
    }
    GRID_BAR();

    {
        LAS float* gs = (LAS float*)lds; LAS float* shv = gs + DM; LAS float* wf = shv + DM;
        const float* b_ada = a.in[3]; const float* g_mix = a.in[4]; const float* w_in = a.in[5];
        for (int k = tid; k < DM; k += 512) { float sh = b_ada[k], sc = b_ada[DM + k];
            for (int j = 0; j < 16; ++j) { sh += MODP[j * (6 * DM) + k]; sc += MODP[j * (6 * DM) + DM + k]; }
            gs[k] = g_mix[k] * (1.0f + sc); shv[k] = sh; }
        for (int i = tid; i < DM * 8; i += 512) wf[i] = w_in[(size_t)(i >> 3) * INW + 3072 + (i & 7)];
        for (int n = bid * 512 + tid; n < 6 * DM; n += G * 512) { float m = b_ada[n]; for (int j = 0; j < 16; ++j) m += MODP[j * (6 * DM) + n]; MOD[n] = m; }
        __syncthreads();
        const float* b_f = a.in[6];
        for (int row = gw; row < SEQ; row += NGW) {
            f32x4_t v[8]; norm_mod_row(XIN + (size_t)row * DM, HN + (size_t)row * DM, gs, shv, lane, v);
            f32x4_t f0 = {0.f, 0.f, 0.f, 0.f}, f1 = {0.f, 0.f, 0.f, 0.f};
#pragma unroll
            for (int j = 0; j < 8; ++j)
#pragma unroll
                for (int e = 0; e < 4; ++e) { const int k = 4 * lane + 256 * j + e; const f32x4_t w0 = *(const LAS f32x4_t*)(wf + k * 8), w1 = *(const LAS f32x4_t*)(wf + k * 8 + 4);
                    f0 += v[j][e] * w0; f1 += v[j][e] * w1; }
            float fd = 0.f;
#pragma unroll
            for (int h = 0; h < 8; ++h) { const float t = wave_sum(h < 4 ? f0[h & 3] : f1[h & 3]); if (lane == h) fd = t; }
            if (lane < 8) { const float z = fd + b_f[lane]; LF[lane * SEQ + row] = fminf(z, 0.f) - log1pf(expf(-fabsf(z))); }
        }
    }
    GRID_BAR();

    if (bid < NH) {
        LAS double* tot = (LAS double*)lds; const int h = bid; const float* src = LF + h * SEQ + tid * 16;
        float vals[16];
#pragma unroll
        for (int q = 0; q < 4; ++q) { const f32x4_t t = *(const f32x4_t*)(src + 4 * q); vals[4 * q] = t[0]; vals[4 * q + 1] = t[1]; vals[4 * q + 2] = t[2]; vals[4 * q + 3] = t[3]; }
        double run = 0.0;
#pragma unroll
        for (int e = 0; e < 16; ++e) run += (double)vals[e];
        tot[tid] = run;
        __syncthreads();
        double c = 0.0; for (int i = 0; i < tid; ++i) c += tot[i];
        float* dst = CBR + h * SEQ + tid * 16;
#pragma unroll
        for (int e = 0; e < 16; ++e) { c += (double)vals[e]; dst[e] = -(float)(c * 11.313708498984761); }
        __syncthreads();
    }
    {
        pg8::Gemm g{HN, W1T, SEQ, 4096, DM, DM, DM}; pg8::StaticOrder S; S.init(SEQ, 4096, G, bid);
        pg8::EpiQKVU E{QKV, AALL};
#ifndef NO_G1
        pg8::gemm_phase<pg8::EpiQKVU, pg8::StaticOrder, true, true>(lds, g, S, E, wave);
#endif
    }
    GRID_BAR();

    {
        pg8::Gemm g{AALL, WEND, NG * NCH, NG * 256, CL * GCH, KA, CL * GCH}; pg8::CarryOrder S{G, bid};
        pg8::EpiCarry E{AALL, (const float*)(ws + WS_P32)};
#ifndef NO_G2
        pg8::gemm_phase<pg8::EpiCarry, pg8::CarryOrder, false, true>(lds, g, S, E, wave);
#endif
        if (bid >= NG && G > NG + 2) {
            const int nw = (G - NG) * 8, per = nw / 16, w = (bid - NG) * 8 + wave, ha = w / per, j = w - ha * per;
            if (ha < 16) {
                const bf16_t* base = QKV + (size_t)ha * SEQ * HD; float mx = 0.f;
                for (int q4 = j; q4 < SEQ / 4; q4 += per) {
                    const u32x4_t v = *(const u32x4_t*)(base + (size_t)(4 * q4 + (lane >> 4)) * HD + (lane & 15) * 8);
                    float s = bf_lo(v.x) * bf_lo(v.x) + bf_hi(v.x) * bf_hi(v.x) + bf_lo(v.y) * bf_lo(v.y) + bf_hi(v.y) * bf_hi(v.y)
                            + bf_lo(v.z) * bf_lo(v.z) + bf_hi(v.z) * bf_hi(v.z) + bf_lo(v.w) * bf_lo(v.w) + bf_hi(v.w) * bf_hi(v.w);
                    s += __shfl_xor(s, 1); s += __shfl_xor(s, 2); s += __shfl_xor(s, 4); s += __shfl_xor(s, 8);
                    mx = fmaxf(mx, s);
                }
                mx = fmaxf(mx, __shfl_xor(mx, 16)); mx = fmaxf(mx, __shfl_xor(mx, 32));
                if (lane == 0) atomicMax((unsigned*)(ws + WS_NRM) + ha, __float_as_uint(mx));
            }
        }
    }
    GRID_BAR();

    {
        using abf = att::bf16;
        char* ldsg = (char*)lds_raw;
        BIAS_LAS float* bias = (BIAS_LAS float*)(lds + att::BIAS_OFF);
        att::Seam<abf> Sm;
        if (bid < NH * (SEQ / att::QB)) { const int it = bid;
            const int head = it & 7, qb = (SEQ / att::QB - 1) - (it >> 3), P0 = qb * att::QB;
            const float qk = sqrtf(__uint_as_float(((const unsigned*)(ws + WS_NRM))[head]) * __uint_as_float(((const unsigned*)(ws + WS_NRM))[8 + head]));
            const float thr = 1131.4f + 2.02f * qk + 1.0f;
            const int jlo = __syncthreads_count((tid < P0 / 64) && (CBR[head * SEQ + P0] - CBR[head * SEQ + 64 * tid + 63] > thr));
            for (int k = 64 * jlo + tid * 4; k < P0 + att::QB; k += 2048) *(BIAS_LAS f32x4_t*)(bias + (k - 64 * jlo)) = *(const f32x4_t*)(CBR + head * SEQ + k);
            __syncthreads();
            att::BlockRef<abf, abf> cur;
            cur.Q = (const abf*)QKV + ((size_t)(0 * NH + head) * SEQ + P0) * HD; cur.K = (const abf*)QKV + (size_t)(1 * NH + head) * SEQ * HD; cur.V = (const abf*)QKV + (size_t)(2 * NH + head) * SEQ * HD;
            cur.O = (abf*)MIX + (size_t)P0 * DM + head * HD; cur.P0 = P0; cur.JLO = jlo; cur.SSQ = SSQB + (size_t)P0 * 32 + head;
#ifndef NO_ATT
            att::causal_swa_prime<abf, abf>(cur, 1 << 30, ldsg, Sm, wave);
            att::causal_swa_block<abf, abf>(cur, cur, SEQ, 1 << 30, ldsg, Sm, bias, wave);
#endif
        }
        asm volatile("s_waitcnt vmcnt(0)" ::: "memory");
        __syncthreads();
        pg8::Gemm g{AALL, GC, NG * NCH, NG * 512, KA, KA, KA}; pg8::ChunkOrder S{G, G - 1 - bid};
        pg8::EpiY E{YB};
#ifndef NO_G3
        pg8::gemm_phase<pg8::EpiY, pg8::ChunkOrder, true, true>(lds, g, S, E, wave);
#endif
    }
    GRID_BAR();

    {
        pg8::Gemm g{YB, WGT, SEQ, SW, SW, SW, SW}; pg8::StaticOrder S; S.init(SEQ, SW, G, bid);
        pg8::EpiGlu E{YB, MIX, a.in[16], SSQB};
#ifndef NO_G4
        pg8::gemm_phase<pg8::EpiGlu, pg8::StaticOrder, true, true>(lds, g, S, E, wave);
#endif
    }
    GRID_BAR();

    {
        pg8::Gemm g{MIX, WOT, SEQ, DM, DM, DM, DM}; pg8::StaticOrder S; S.init(SEQ, DM, G, bid);
        LAS float* rtab = (LAS float*)(lds + RING_BYTES);
        { pg8::Unit u0; if (S.next(0, u0) && tid < 256) { float ra, rs; pg8::EpiWout::rstds(SSQB, u0.pm * 256 + tid, ra, rs); rtab[2 * tid] = ra / rs; rtab[2 * tid + 1] = rs; } }
        __syncthreads();
        pg8::EpiWout E{rtab, XIN, MOD + 2 * DM, OUT};
#ifndef NO_G5
        pg8::gemm_phase<pg8::EpiWout, pg8::StaticOrder, true, true>(lds, g, S, E, wave);
#endif
    }
    GRID_BAR();

    {
        LAS float* gs = (LAS float*)lds; LAS float* shv = gs + DM; const float* g_ffn = a.in[20];
        for (int k = tid; k < DM; k += 512) { gs[k] = g_ffn[k] * (1.0f + MOD[4 * DM + k]); shv[k] = MOD[3 * DM + k]; }
        __syncthreads();
        for (int row = gw; row < SEQ; row += NGW) { f32x4_t v[8]; norm_mod_row(OUT + (size_t)row * DM, HN + (size_t)row * DM, gs, shv, lane, v); }
    }
    GRID_BAR();

    {
        pg8::Gemm g{HN, WUT, SEQ, 2 * DFF, DM, DM, DM}; pg8::StaticOrder S; S.init(SEQ, 2 * DFF, G, bid);
        pg8::EpiUp E{ABUF, BBUF};
#ifndef NO_G6
        pg8::gemm_phase<pg8::EpiUp, pg8::StaticOrder, true, true>(lds, g, S, E, wave);
#endif
    }
    GRID_BAR();

    {
        const float* cw = a.in[22]; const float* cbias = a.in[23];
        constexpr int NCC = DFF / 8, NRB = SEQ / 16;
        for (int id = bid * 512 + tid; id < NRB * NCC; id += G * 512) {
            const int rb = id / NCC, cc = id - rb * NCC, col = cc * 8, t0 = rb * 16;
            float w0[8], w1[8], w2[8], cb[8], am2[8], am1[8];
#pragma unroll
            for (int q = 0; q < 2; ++q) { const f32x4_t u0 = *(const f32x4_t*)(cw + col + 4 * q), u1 = *(const f32x4_t*)(cw + DFF + col + 4 * q), u2 = *(const f32x4_t*)(cw + 2 * DFF + col + 4 * q), u3 = *(const f32x4_t*)(cbias + col + 4 * q);
#pragma unroll
                for (int e = 0; e < 4; ++e) { w0[4 * q + e] = u0[e]; w1[4 * q + e] = u1[e]; w2[4 * q + e] = u2[e]; cb[4 * q + e] = u3[e]; } }
#pragma unroll
            for (int e = 0; e < 8; ++e) { am2[e] = 0.f; am1[e] = 0.f; }
            if (t0 > 0) { const u32x4_t p2 = *(const u32x4_t*)(ABUF + (size_t)(t0 - 2) * DFF + col), p1 = *(const u32x4_t*)(ABUF + (size_t)(t0 - 1) * DFF + col);
                am2[0] = bf_lo(p2.x); am2[1] = bf_hi(p2.x); am2[2] = bf_lo(p2.y); am2[3] = bf_hi(p2.y); am2[4] = bf_lo(p2.z); am2[5] = bf_hi(p2.z); am2[6] = bf_lo(p2.w); am2[7] = bf_hi(p2.w);
                am1[0] = bf_lo(p1.x); am1[1] = bf_hi(p1.x); am1[2] = bf_lo(p1.y); am1[3] = bf_hi(p1.y); am1[4] = bf_lo(p1.z); am1[5] = bf_hi(p1.z); am1[6] = bf_lo(p1.w); am1[7] = bf_hi(p1.w); }
            for (int r = 0; r < 16; ++r) {
                const size_t off = (size_t)(t0 + r) * DFF + col;
                const u32x4_t pa = *(const u32x4_t*)(ABUF + off), pb = *(const u32x4_t*)(BBUF + off);
                float av[8], bv[8], gv[8];
                av[0] = bf_lo(pa.x); av[1] = bf_hi(pa.x); av[2] = bf_lo(pa.y); av[3] = bf_hi(pa.y); av[4] = bf_lo(pa.z); av[5] = bf_hi(pa.z); av[6] = bf_lo(pa.w); av[7] = bf_hi(pa.w);
                bv[0] = bf_lo(pb.x); bv[1] = bf_hi(pb.x); bv[2] = bf_lo(pb.y); bv[3] = bf_hi(pb.y); bv[4] = bf_lo(pb.z); bv[5] = bf_hi(pb.z); bv[6] = bf_lo(pb.w); bv[7] = bf_hi(pb.w);
#pragma unroll
                for (int e = 0; e < 8; ++e) { const float cv = cb[e] + w0[e] * am2[e] + w1[e] * am1[e] + w2[e] * av[e]; gv[e] = cv * fast_sigmoid(cv) * bv[e]; am2[e] = am1[e]; am1[e] = av[e]; }
                u32x4_t o; o.x = pk2(gv[0], gv[1]); o.y = pk2(gv[2], gv[3]); o.z = pk2(gv[4], gv[5]); o.w = pk2(gv[6], gv[7]);
                *(u32x4_t*)(BBUF + off) = o;
            }
        }
    }
    GRID_BAR();

    {
        pg8::Gemm g{BBUF, WDT, SEQ, DM, DFF, DFF, DFF}; pg8::StaticOrder S; S.init(SEQ, DM, G, bid);
        pg8::EpiDown E{MOD + 5 * DM, OUT, SSQ2B};
#ifndef NO_G7
        pg8::gemm_phase<pg8::EpiDown, pg8::StaticOrder, true, true>(lds, g, S, E, wave);
#endif
    }
    GRID_BAR();

    {
        const float* gf = a.in[25];
        for (int row = gw; row < SEQ; row += NGW) {
            const float part = lane < 32 ? SSQ2B[(size_t)row * 32 + lane] : 0.f;
            const float rstd = 1.0f / sqrtf(wave_sum(part) * (1.0f / DM) + EPS);
            f32x4_t* orow = (f32x4_t*)(OUT + (size_t)row * DM) + lane; const f32x4_t* g4 = (const f32x4_t*)gf + lane;
#pragma unroll
            for (int j = 0; j < 8; ++j) orow[64 * j] = orow[64 * j] * rstd * g4[64 * j];
        }
    }
}

extern "C" void kernel_launch(void* const* d_in, const int* in_sizes, int n_in, void* d_out, int out_size, void* d_ws, size_t ws_size, hipStream_t stream) {
    static int grid = 0;
    if (grid == 0) {
        if (n_in != 26 || out_size != SEQ * DM || ws_size < WS_END) { fprintf(stderr, "kernel_launch: unexpected shapes (n_in %d out %d ws %zu)\n", n_in, out_size, ws_size); grid = -1; return; }
        int dev = 0, cus = 0, per_cu = 0;
        (void)hipGetDevice(&dev); (void)hipDeviceGetAttribute(&cus, hipDeviceAttributeMultiprocessorCount, dev);
        if (hipFuncSetAttribute((const void*)fwd_kernel, hipFuncAttributeMaxDynamicSharedMemorySize, LDS_BYTES) != hipSuccess) { fprintf(stderr, "kernel_launch: hipFuncSetAttribute failed\n"); grid = -1; return; }
        if (hipOccupancyMaxActiveBlocksPerMultiprocessor(&per_cu, (const void*)fwd_kernel, 512, LDS_BYTES) != hipSuccess || per_cu < 1) { fprintf(stderr, "kernel_launch: occupancy query gave %d\n", per_cu); per_cu = 1; }
        (void)hipGetLastError();
        grid = cus;
        if (grid > 256) grid = 256;
    }
    if (grid < 0) return;
    (void)hipMemsetAsync((char*)d_ws + WS_CTL, 0, CTL_ZERO_BYTES, stream);
    Args a{};
    for (int i = 0; i < 26; ++i) a.in[i] = (const float*)d_in[i];
    a.out = (float*)d_out; a.ws = (unsigned char*)d_ws;
    void* args[] = {&a};
    hipError_t e = hipLaunchCooperativeKernel((const void*)fwd_kernel, dim3(grid), dim3(512), args, LDS_BYTES, stream);
    if (e != hipSuccess) fprintf(stderr, "cooperative launch failed: %s (grid %d)\n", hipGetErrorString(e), grid);
}
```

```cpp
#include <hip/hip_runtime.h>
#include <hip/hip_cooperative_groups.h>
#include <cstdio>
#include <cstdint>
namespace cg = cooperative_groups;

constexpr int SEQ = 8192, DM = 2048, AW = 1024, HD = 128, NH = 8, SW = 1024, NG = 64, GCH = 16, NP = 64, INW = 4104, DFF = 5632;
constexpr int CL = 32, NCH = SEQ / CL;
constexpr int KA = CL * GCH + 2 * NP;
constexpr float EPS = 1e-6f;
constexpr size_t MiB = 1u << 20, KiB = 1024;
constexpr size_t WS_CTL = 0, CTL_ZERO_BYTES = 1 * MiB;
constexpr size_t WS_NRM = 512 * KiB;
constexpr size_t WS_MODP = 1 * MiB;
constexpr size_t WS_MOD = 2 * MiB;
constexpr size_t WS_LF = 2 * MiB + 64 * KiB;
constexpr size_t WS_CBR = 2 * MiB + 320 * KiB;
constexpr size_t WS_P32 = 2 * MiB + 576 * KiB;
constexpr size_t WS_SSQ = 3 * MiB;
constexpr size_t WS_SSQ2 = 4 * MiB;
constexpr size_t WS_WDT = 8 * MiB;
constexpr size_t WS_W1T = 30 * MiB;
constexpr size_t WS_WGT = 46 * MiB;
constexpr size_t WS_WOT = 48 * MiB;
constexpr size_t WS_WUT = 56 * MiB;
constexpr size_t WS_GC = 100 * MiB;
constexpr size_t WS_WEND = 140 * MiB;
constexpr size_t WS_AALL = 156 * MiB;
constexpr size_t WS_QKV = 176 * MiB;
constexpr size_t WS_YB = 224 * MiB;
constexpr size_t WS_MIX = 240 * MiB;
constexpr size_t WS_HN = 280 * MiB;
constexpr size_t WS_ABUF = 100 * MiB;
constexpr size_t WS_BBUF = 188 * MiB;
constexpr size_t WS_HALO = 312 * MiB;
constexpr size_t WS_END = 318 * MiB;
static_assert(WS_ABUF + (size_t)SEQ * DFF * 2 <= WS_BBUF && WS_BBUF + (size_t)SEQ * DFF * 2 <= WS_HN && WS_HN + (size_t)SEQ * DM * 2 <= WS_HALO && WS_HALO + (size_t)32 * 6 * DFF * 4 <= WS_END, "ws map");
static_assert(WS_WUT + (size_t)2 * DFF * DM * 2 <= WS_GC && WS_GC + (size_t)NG * 512 * KA * 2 <= WS_WEND && WS_WEND + (size_t)NG * 256 * 512 * 2 <= WS_AALL && WS_AALL + (size_t)NG * 256 * KA * 2 <= WS_QKV, "ws map 2");
static_assert(WS_QKV + (size_t)3 * SEQ * AW * 2 <= WS_YB && WS_YB + (size_t)SEQ * SW * 2 <= WS_MIX && WS_MIX + (size_t)SEQ * DM * 2 <= WS_HN, "ws map 3");
static_assert(WS_WDT + (size_t)DM * DFF * 2 <= WS_W1T && WS_W1T + (size_t)4096 * DM * 2 <= WS_WGT && WS_WOT + (size_t)DM * DM * 2 <= WS_WUT, "ws map 4");
constexpr int LDS_BYTES = 147456;
constexpr int RING_BYTES = 131072;

typedef float f32x4_t __attribute__((ext_vector_type(4)));
typedef unsigned u32x4_t __attribute__((ext_vector_type(4)));
typedef unsigned u32x2_t __attribute__((ext_vector_type(2)));
__device__ __forceinline__ float bf_lo(unsigned w) { return __uint_as_float(w << 16); }
__device__ __forceinline__ float bf_hi(unsigned w) { return __uint_as_float(w & 0xffff0000u); }
__device__ __forceinline__ float fast_sigmoid(float z) { return __builtin_amdgcn_rcpf(1.0f + __builtin_amdgcn_exp2f(-1.4426950408889634f * z)); }
__device__ __forceinline__ float gelu_tanh(float v) { const float z = 1.5957691216057308f * (v + 0.044715f * v * v * v); return v * fast_sigmoid(z); }

namespace pg8 {
#define PG8_LAS __attribute__((address_space(3)))
typedef unsigned short bf16_t;
typedef short bf16x8 __attribute__((ext_vector_type(8)));
typedef float f32x4 __attribute__((ext_vector_type(4)));
typedef unsigned u32x4 __attribute__((ext_vector_type(4)));
constexpr int BM = 256, BK = 64, HALF = 128, HTB = HALF * BK * 2  , STAGE_BYTES = 8 * HTB, NXCD = 8, WGM = 8;

__host__ __device__ __forceinline__ int lds_byte(int r, int c) { const int st = (r >> 4) * 2 + (c >> 5), rr = r & 15, cc = c & 31, ob = rr * 64 + cc * 2; return st * 1024 + (ob ^ (((ob >> 9) & 1) << 5)); }
__host__ __device__ __forceinline__ void stage_rc(int b, int& R, int& C) { const int st = b / 1024, sb = b % 1024, swz = sb ^ (((sb >> 9) & 1) << 5); R = (st >> 1) * 16 + swz / 64; C = (st & 1) * 32 + (swz % 64) / 2; }
__host__ __device__ __forceinline__ int perm32(int rho) { const int n = rho >> 4, i = rho & 15; return 8 * (i >> 2) + 4 * n + (i & 3); }

struct Unit { int pm, pn; };
struct Gemm { const bf16_t* A; const bf16_t* Bt; int M, N, K, lda, ldb; };

struct StaticOrder {
    int nM, nN, nwg, G, c;
    __host__ __device__ __forceinline__ void init(int M, int N, int G_, int c_) { nM = M / BM; nN = N / BM; nwg = nM * nN; G = G_; c = c_; }
    __host__ __device__ __forceinline__ bool next(int i, Unit& u) const {
        const long L = (long)i * G + c; if (L >= nwg) return false;
        int wgid = (int)L; { const int q = nwg / NXCD, r = nwg % NXCD, xcd = wgid % NXCD, off = wgid / NXCD; wgid = (xcd < r ? xcd * (q + 1) : r * (q + 1) + (xcd - r) * q) + off; }
        const int nig = WGM * nN, gid = wgid / nig, fm = gid * WGM, gsz = (nM - fm) < WGM ? (nM - fm) : WGM;
        u.pm = fm + ((wgid % nig) % gsz); u.pn = (wgid % nig) / gsz; return true;
    }
    __device__ __forceinline__ void a_ready(const Unit&) const {}
    __device__ __forceinline__ void done(const Unit&) const {}
};


template <class Epi, class Sched, bool ALIGN_EPI = false, bool SP2 = false>
__device__ __forceinline__ void gemm_phase(PG8_LAS unsigned char* lds, const Gemm g, const Sched& S, const Epi& E, const int wv  ) {
    int tid_ = wv * 64 + ((int)__builtin_amdgcn_mbcnt_hi(~0u, __builtin_amdgcn_mbcnt_lo(~0u, 0u))); asm volatile("" : "+v"(tid_));
    const int tid = tid_, wid = __builtin_amdgcn_readfirstlane(tid >> 6), lane = tid & 63, wr = wid >> 2, wc = wid & 3, fr = lane & 15, fq = lane >> 4;
    const int K = g.K, nt = K / BK;
    unsigned voffA[2], voffB[2];
#pragma unroll
    for (int i = 0; i < 2; ++i) { int R, C; stage_rc(tid * 16 + i * 8192, R, C); const int Rb = Epi::PERM ? ((R & ~31) + perm32(R & 31)) : R;
        voffA[i] = (unsigned)(R * g.lda + C) * 2u; voffB[i] = (unsigned)(Rb * g.ldb + C) * 2u; }
    const size_t kstep = (size_t)(BK * 2);
    const size_t hstepA = (size_t)HALF * g.lda * 2, hstepB = (size_t)HALF * g.ldb * 2;
    const size_t tstepA = 2 * hstepA, tstepB = 2 * hstepB;
    const unsigned ldsw = (unsigned)wid * 1024u;
    const int aoff = lds_byte(wr * 64 + fr, fq * 8), boff = lds_byte(wc * 32 + fr, fq * 8);
#define PG8_SA(b, h) (((b) * 2 + (h)) * HTB)
#define PG8_SB(b, h) ((4 + (b) * 2 + (h)) * HTB)
#define PG8_STAGE(bufoff, gbase, voff) do { _Pragma("unroll") for (int _i = 0; _i < 2; ++_i) \
        __builtin_amdgcn_global_load_lds((const unsigned*)((const char*)(gbase) + (voff)[_i]), (PG8_LAS unsigned*)(lds + (bufoff) + ldsw + _i * 8192), 16, 0, 0); } while (0)
#define PG8_LDA(dst, b, h) do { _Pragma("unroll") for (int m = 0; m < 4; ++m) _Pragma("unroll") for (int k = 0; k < 2; ++k) dst[m][k] = *(const PG8_LAS bf16x8*)(lds + PG8_SA(b, h) + aoff + m * 2048 + k * 1024); } while (0)
#define PG8_LDB(dst, b, h) do { _Pragma("unroll") for (int n = 0; n < 2; ++n) _Pragma("unroll") for (int k = 0; k < 2; ++k) dst[n][k] = *(const PG8_LAS bf16x8*)(lds + PG8_SB(b, h) + boff + n * 2048 + k * 1024); } while (0)
#define PG8_MMA(ai, bj, At, Bt) do { __builtin_amdgcn_s_setprio(1); _Pragma("unroll") for (int m = 0; m < 4; ++m) _Pragma("unroll") for (int n = 0; n < 2; ++n) _Pragma("unroll") for (int k = 0; k < 2; ++k) \
        acc[ai][bj][m][n] = __builtin_amdgcn_mfma_f32_16x16x32_bf16(Bt[n][k], At[m][k], acc[ai][bj][m][n], 0, 0, 0); __builtin_amdgcn_s_setprio(0); } while (0)
#define PG8_WAIT_V(n) asm volatile("s_waitcnt vmcnt(" #n ")" ::: "memory")
#define PG8_WAIT_L(n) asm volatile("s_waitcnt lgkmcnt(" #n ")" ::: "memory")
#define PG8_BAR __builtin_amdgcn_s_barrier()
#define PG8_SCHED __builtin_amdgcn_sched_barrier(0)
    Unit cur, nxt; int ui = 0;
    if (!S.next(0, cur)) return;
    f32x4 acc[2][2][4][2];
#pragma unroll
    for (int a = 0; a < 2; ++a)
#pragma unroll
        for (int b = 0; b < 2; ++b)
#pragma unroll
            for (int m = 0; m < 4; ++m)
#pragma unroll
                for (int n = 0; n < 2; ++n) acc[a][b][m][n] = (f32x4){0.f, 0.f, 0.f, 0.f};
    bf16x8 At[4][2], B0[2][2], B1[2][2];
    const char* cA = (const char*)g.A + (size_t)cur.pm * tstepA; const char* cB = (const char*)g.Bt + (size_t)cur.pn * tstepB;
    S.a_ready(cur);
    if constexpr (SP2) {
        PG8_STAGE(PG8_SB(0, 0), cB, voffB); PG8_STAGE(PG8_SB(0, 1), cB + hstepB, voffB); PG8_STAGE(PG8_SA(0, 0), cA, voffA); PG8_STAGE(PG8_SA(0, 1), cA + hstepA, voffA);
        if (wr == 1) PG8_BAR;
        PG8_WAIT_V(2); PG8_BAR;
        PG8_STAGE(PG8_SB(1, 0), cB + kstep, voffB); PG8_STAGE(PG8_SA(1, 0), cA + kstep, voffA); PG8_STAGE(PG8_SB(1, 1), cB + hstepB + kstep, voffB);
        PG8_WAIT_V(6); PG8_BAR;
    } else {
        PG8_STAGE(PG8_SB(0, 0), cB, voffB); PG8_STAGE(PG8_SA(0, 0), cA, voffA); PG8_STAGE(PG8_SB(0, 1), cB + hstepB, voffB); PG8_STAGE(PG8_SA(0, 1), cA + hstepA, voffA);
        if (wr == 1) PG8_BAR;
        PG8_WAIT_V(4); PG8_BAR;
        PG8_STAGE(PG8_SB(1, 0), cB + kstep, voffB); PG8_STAGE(PG8_SA(1, 0), cA + kstep, voffA); PG8_STAGE(PG8_SB(1, 1), cB + hstepB + kstep, voffB);
        PG8_WAIT_V(6); PG8_BAR;
    }
    for (;;) {
        const bool has_next = S.next(ui + 1, nxt);
        const char* nA = has_next ? (const char*)g.A + (size_t)nxt.pm * tstepA : cA; const char* nB = has_next ? (const char*)g.Bt + (size_t)nxt.pn * tstepB : cB;
        for (int t = 0; t < nt; t += 2) {
            const bool last = (t == nt - 2);
            const char* a1 = cA + (size_t)(t + 1) * kstep;
            const char* a2 = last ? nA : cA + (size_t)(t + 2) * kstep; const char* b2 = last ? nB : cB + (size_t)(t + 2) * kstep;
            const char* a3 = a2 + kstep; const char* b3 = b2 + kstep;
            if (last && has_next) S.a_ready(nxt);
            if constexpr (Epi::MIDK) { if (t == (nt >> 1)) E.mid(acc, cur, wr, fr); }
            if constexpr (SP2) {
            PG8_LDB(B0, 0, 0); PG8_LDB(B1, 0, 1); PG8_SCHED; PG8_LDA(At, 0, 0); PG8_STAGE(PG8_SA(1, 1), a1 + hstepA, voffA);
            PG8_WAIT_V(8); PG8_WAIT_L(0); PG8_BAR; PG8_MMA(0, 0, At, B0); PG8_MMA(0, 1, At, B1); PG8_BAR; PG8_SCHED;
            PG8_LDA(At, 0, 1); PG8_STAGE(PG8_SB(0, 0), b2, voffB); PG8_STAGE(PG8_SB(0, 1), b2 + hstepB, voffB); PG8_STAGE(PG8_SA(0, 0), a2, voffA);
            PG8_WAIT_V(8); PG8_WAIT_L(0); PG8_BAR; PG8_MMA(1, 0, At, B0); PG8_MMA(1, 1, At, B1); PG8_BAR; PG8_SCHED;
            PG8_LDB(B0, 1, 0); PG8_LDB(B1, 1, 1); PG8_SCHED; PG8_LDA(At, 1, 0); PG8_STAGE(PG8_SA(0, 1), a2 + hstepA, voffA);
            PG8_WAIT_V(8); PG8_WAIT_L(0); PG8_BAR; PG8_MMA(0, 0, At, B0); PG8_MMA(0, 1, At, B1); PG8_BAR; PG8_SCHED;
            PG8_LDA(At, 1, 1); PG8_STAGE(PG8_SB(1, 0), b3, voffB); PG8_STAGE(PG8_SB(1, 1), b3 + hstepB, voffB); PG8_STAGE(PG8_SA(1, 0), a3, voffA);
            PG8_WAIT_V(8); PG8_WAIT_L(0); PG8_BAR; PG8_MMA(1, 0, At, B0); PG8_MMA(1, 1, At, B1); PG8_BAR; PG8_SCHED;
            } else {
            PG8_LDB(B0, 0, 0); PG8_SCHED; PG8_LDA(At, 0, 0); PG8_STAGE(PG8_SA(1, 1), a1 + hstepA, voffA);
            PG8_WAIT_L(8); PG8_BAR; PG8_WAIT_L(0); PG8_MMA(0, 0, At, B0); PG8_BAR; PG8_SCHED;
            PG8_LDB(B1, 0, 1); PG8_STAGE(PG8_SB(0, 0), b2, voffB);
            PG8_BAR; PG8_WAIT_L(0); PG8_MMA(0, 1, At, B1); PG8_BAR;
            PG8_LDA(At, 0, 1); PG8_STAGE(PG8_SA(0, 0), a2, voffA);
            PG8_BAR; PG8_WAIT_L(0); PG8_MMA(1, 0, At, B0); PG8_BAR; PG8_SCHED;
            PG8_STAGE(PG8_SB(0, 1), b2 + hstepB, voffB);
            PG8_WAIT_V(6); PG8_BAR; PG8_MMA(1, 1, At, B1); PG8_BAR;
            PG8_LDB(B0, 1, 0); PG8_SCHED; PG8_LDA(At, 1, 0); PG8_STAGE(PG8_SA(0, 1), a2 + hstepA, voffA);
            PG8_WAIT_L(8); PG8_BAR; PG8_WAIT_L(0); PG8_MMA(0, 0, At, B0); PG8_BAR; PG8_SCHED;
            PG8_LDB(B1, 1, 1); PG8_STAGE(PG8_SB(1, 0), b3, voffB);
            PG8_BAR; PG8_WAIT_L(0); PG8_MMA(0, 1, At, B1); PG8_BAR;
            PG8_LDA(At, 1, 1); PG8_STAGE(PG8_SA(1, 0), a3, voffA);
            PG8_BAR; PG8_WAIT_L(0); PG8_MMA(1, 0, At, B0); PG8_BAR; PG8_SCHED;
            PG8_STAGE(PG8_SB(1, 1), b3 + hstepB, voffB);
            PG8_WAIT_V(6); PG8_BAR; PG8_MMA(1, 1, At, B1); PG8_BAR;
            }
        }
        if constexpr (ALIGN_EPI) { if (wr == 0) PG8_BAR; }
        if constexpr (!Epi::AFTER_DRAIN) { E(acc, cur, wr, wc, fr, fq); S.done(cur); }
        if (!has_next) break;
#pragma unroll
        for (int a = 0; a < 2; ++a)
#pragma unroll
            for (int b = 0; b < 2; ++b)
#pragma unroll
                for (int m = 0; m < 4; ++m)
#pragma unroll
                    for (int n = 0; n < 2; ++n) acc[a][b][m][n] = (f32x4){0.f, 0.f, 0.f, 0.f};
        cur = nxt; cA = nA; cB = nB; ++ui;
        if constexpr (ALIGN_EPI) { if (wr == 1) PG8_BAR; }
    }
    PG8_WAIT_V(0);
    if constexpr (!ALIGN_EPI) { if (wr == 0) PG8_BAR; }
    PG8_BAR;
    if constexpr (Epi::AFTER_DRAIN) { E.fused(acc, cur, wr, wc, fr, fq, lds, wid, lane); S.done(cur); }
#undef PG8_SA
#undef PG8_SB
#undef PG8_STAGE
#undef PG8_LDA
#undef PG8_LDB
#undef PG8_MMA
#undef PG8_WAIT_V
#undef PG8_WAIT_L
#undef PG8_BAR
#undef PG8_SCHED
}
__device__ __forceinline__ unsigned cvt_pk_bf16(float lo, float hi) { unsigned r; asm volatile("v_cvt_pk_bf16_f32 %0, %1, %2" : "=v"(r) : "v"(lo), "v"(hi)); return r; }
__device__ __forceinline__ u32x4 pack8(const f32x4 a, const f32x4 b) { u32x4 w; w.x = cvt_pk_bf16(a[0], a[1]); w.y = cvt_pk_bf16(a[2], a[3]); w.z = cvt_pk_bf16(b[0], b[1]); w.w = cvt_pk_bf16(b[2], b[3]); return w; }

struct CarryOrder {
    int G, c;
    __device__ __forceinline__ bool next(int i, Unit& u) const { const int L = i * G + c; if (L >= NG) return false; u.pm = L; u.pn = L; return true; }
    __device__ __forceinline__ void a_ready(const Unit&) const {}
    __device__ __forceinline__ void done(const Unit&) const {}
};
struct ChunkOrder {
    int G, c;
    __device__ __forceinline__ bool next(int i, Unit& u) const { const int L = i * G + c; if (L >= 2 * NG) return false; u.pm = L >> 1; u.pn = L; return true; }
    __device__ __forceinline__ void a_ready(const Unit&) const {}
    __device__ __forceinline__ void done(const Unit&) const {}
};

struct EpiQKVU {
    static constexpr bool PERM = true, AFTER_DRAIN = false, MIDK = false;
    bf16_t* QKV; bf16_t* AALL;
    __device__ __forceinline__ void mid(f32x4 (&)[2][2][4][2], const Unit&, int, int) const {}
    __device__ __forceinline__ void operator()(const f32x4 (&acc)[2][2][4][2], const Unit& u, int wr, int wc, int fr, int fq) const {
        const int row0 = u.pm * BM + wr * 64 + fr;
#pragma unroll
        for (int bj = 0; bj < 2; ++bj) {
            const int ct = u.pn * BM + bj * HALF, cw = wc * 32 + 8 * fq;
            if (ct < 3072) {
                const int which = ct >> 10, head = (ct & 1023) >> 7;
                bf16_t* base = QKV + (size_t)(which * NH + head) * SEQ * HD + cw;
#pragma unroll
                for (int ai = 0; ai < 2; ++ai)
#pragma unroll
                    for (int m = 0; m < 4; ++m) { const int row = row0 + ai * HALF + m * 16; *(u32x4*)(base + (size_t)row * HD) = pack8(acc[ai][bj][m][0], acc[ai][bj][m][1]); }
            } else {
                const int cu = ct - 3072 + cw, g = cu >> 4, i0 = cu & 15;
#pragma unroll
                for (int ai = 0; ai < 2; ++ai)
#pragma unroll
                    for (int m = 0; m < 4; ++m) { const int row = row0 + ai * HALF + m * 16;
                        *(u32x4*)(AALL + ((size_t)(g * NCH + (row >> 5)) * KA + (row & 31) * GCH + i0)) = pack8(acc[ai][bj][m][0], acc[ai][bj][m][1]); }
            }
        }
    }
};

struct EpiCarry {
    static constexpr bool PERM = false, AFTER_DRAIN = true, MIDK = false;
    bf16_t* AALL; const float* P32;
    __device__ __forceinline__ void mid(f32x4 (&)[2][2][4][2], const Unit&, int, int) const {}
    __device__ __forceinline__ void operator()(const f32x4 (&)[2][2][4][2], const Unit&, int, int, int, int) const {}
    __device__ __forceinline__ void fused(f32x4 (&acc)[2][2][4][2], const Unit& u, int wr, int wc, int fr, int fq, PG8_LAS unsigned char* lds, int wid, int lane) const {
        PG8_LAS float* sS = (PG8_LAS float*)lds;
#pragma unroll
        for (int ai = 0; ai < 2; ++ai)
#pragma unroll
            for (int m = 0; m < 4; ++m) { const int r = ai * HALF + wr * 64 + m * 16 + fr;
#pragma unroll
                for (int n = 0; n < 2; ++n) *(PG8_LAS f32x4*)(sS + r * 128 + wc * 32 + 16 * n + 4 * fq) = acc[ai][0][m][n]; }
        asm volatile("s_waitcnt lgkmcnt(0)" ::: "memory"); __builtin_amdgcn_s_barrier(); asm volatile("" ::: "memory");
        if (wid == 0) {
            const int g = u.pm, p = lane;
            const float pr = P32[(g * NP + p) * 2], pi = P32[(g * NP + p) * 2 + 1];
            float xr = 0.f, xi = 0.f;
            bf16_t* dst = AALL + (size_t)g * NCH * KA + CL * GCH + p;
            for (int c = 0; c < NCH; ++c) {
                const unsigned w = cvt_pk_bf16(xr, xi);
                dst[(size_t)c * KA] = (bf16_t)(w & 0xffffu); dst[(size_t)c * KA + NP] = (bf16_t)(w >> 16);
                const float sr = sS[c * 128 + p], si = sS[c * 128 + NP + p];
                const float nr = pr * xr - pi * xi + sr, ni = pr * xi + pi * xr + si;
                xr = nr; xi = ni;
            }
        }
    }
};

struct EpiY {
    static constexpr bool PERM = true, AFTER_DRAIN = false, MIDK = false;
    bf16_t* YB;
    __device__ __forceinline__ void mid(f32x4 (&)[2][2][4][2], const Unit&, int, int) const {}
    __device__ __forceinline__ void operator()(const f32x4 (&acc)[2][2][4][2], const Unit& u, int wr, int wc, int fr, int fq) const {
        const int g = u.pm, j = u.pn & 1;
#pragma unroll
        for (int bj = 0; bj < 2; ++bj) { const int n0 = j * BM + bj * HALF + wc * 32 + 8 * fq, tl = n0 >> 4, h0 = n0 & 15;
#pragma unroll
            for (int ai = 0; ai < 2; ++ai)
#pragma unroll
                for (int m = 0; m < 4; ++m) { const int c = ai * HALF + wr * 64 + m * 16 + fr; const int t = CL * c + tl;
                    f32x4 a = acc[ai][bj][m][0], b = acc[ai][bj][m][1];
#pragma unroll
                    for (int e = 0; e < 4; ++e) { a[e] = gelu_tanh(a[e]); b[e] = gelu_tanh(b[e]); }
                    *(u32x4*)(YB + (size_t)t * SW + GCH * g + h0) = pack8(a, b); } }
    }
};

struct EpiGlu {
    static constexpr bool PERM = true, AFTER_DRAIN = false, MIDK = false;
    const bf16_t* YB; bf16_t* MIX; const float* bglu; float* SSQ;
    __device__ __forceinline__ void mid(f32x4 (&)[2][2][4][2], const Unit&, int, int) const {}
    __device__ __forceinline__ void operator()(const f32x4 (&acc)[2][2][4][2], const Unit& u, int wr, int wc, int fr, int fq) const {
        const int row0 = u.pm * BM + wr * 64 + fr;
        float ss[2][4];
#pragma unroll
        for (int ai = 0; ai < 2; ++ai)
#pragma unroll
            for (int m = 0; m < 4; ++m) ss[ai][m] = 0.f;
#pragma unroll
        for (int bj = 0; bj < 2; ++bj) { const int col0 = u.pn * BM + bj * HALF + wc * 32 + 8 * fq;
            const f32x4 b0 = *(const f32x4*)(bglu + col0), b1 = *(const f32x4*)(bglu + col0 + 4);
#pragma unroll
            for (int ai = 0; ai < 2; ++ai)
#pragma unroll
                for (int m = 0; m < 4; ++m) { const int row = row0 + ai * HALF + m * 16;
                    const u32x4 yw = *(const u32x4*)(YB + (size_t)row * SW + col0);
                    f32x4 ya = {bf_lo(yw.x), bf_hi(yw.x), bf_lo(yw.y), bf_hi(yw.y)}, yb = {bf_lo(yw.z), bf_hi(yw.z), bf_lo(yw.w), bf_hi(yw.w)};
                    const f32x4 za = acc[ai][bj][m][0] + b0, zb = acc[ai][bj][m][1] + b1;
                    float s = 0.f;
#pragma unroll
                    for (int e = 0; e < 4; ++e) { ya[e] *= fast_sigmoid(za[e]); yb[e] *= fast_sigmoid(zb[e]); s += ya[e] * ya[e] + yb[e] * yb[e]; }
                    ss[ai][m] += s;
                    *(u32x4*)(MIX + (size_t)row * DM + SW + col0) = pack8(ya, yb); } }
#pragma unroll
        for (int ai = 0; ai < 2; ++ai)
#pragma unroll
            for (int m = 0; m < 4; ++m) { float s = ss[ai][m]; s += __shfl_xor(s, 16); s += __shfl_xor(s, 32);
                if (fq == 0) SSQ[(size_t)(row0 + ai * HALF + m * 16) * 32 + 8 + u.pn * 4 + wc] = s; }
    }
};

struct EpiWout {
    static constexpr bool PERM = false, AFTER_DRAIN = false, MIDK = true;
    const PG8_LAS float* rtab;
    const float* X; const float* gt1; float* OUT;
    static __device__ __forceinline__ void rstds(const float* SSQ, int row, float& ra, float& rs) {
        const f32x4* p = (const f32x4*)(SSQ + (size_t)row * 32);
        const f32x4 a0 = p[0], a1 = p[1], s0 = p[2], s1 = p[3], s2 = p[4], s3 = p[5];
        const float sa = (a0[0] + a0[1]) + (a0[2] + a0[3]) + (a1[0] + a1[1]) + (a1[2] + a1[3]);
        const f32x4 st = (s0 + s1) + (s2 + s3); const float ssum = (st[0] + st[1]) + (st[2] + st[3]);
        ra = 1.0f / sqrtf(sa * (1.0f / AW) + EPS); rs = 1.0f / sqrtf(ssum * (1.0f / SW) + EPS);
    }
    __device__ __forceinline__ void mid(f32x4 (&acc)[2][2][4][2], const Unit& u, int wr, int fr) const {
#pragma unroll
        for (int ai = 0; ai < 2; ++ai)
#pragma unroll
            for (int m = 0; m < 4; ++m) { const float f = rtab[2 * (ai * HALF + wr * 64 + m * 16 + fr)];
#pragma unroll
                for (int bj = 0; bj < 2; ++bj)
#pragma unroll
                    for (int n = 0; n < 2; ++n) acc[ai][bj][m][n] *= f; }
    }
    __device__ __forceinline__ void operator()(const f32x4 (&acc)[2][2][4][2], const Unit& u, int wr, int wc, int fr, int fq) const {
        const int col0 = u.pn * BM + wc * 32 + 4 * fq;
        f32x4 gv[2][2];
#pragma unroll
        for (int bj = 0; bj < 2; ++bj)
#pragma unroll
            for (int n = 0; n < 2; ++n) gv[bj][n] = *(const f32x4*)(gt1 + col0 + bj * HALF + n * 16);
#pragma unroll
        for (int ai = 0; ai < 2; ++ai)
#pragma unroll
            for (int m = 0; m < 4; ++m) { const int rl = ai * HALF + wr * 64 + m * 16 + fr, row = u.pm * BM + rl; const float rs = rtab[2 * rl + 1];
                const size_t off = (size_t)row * DM + col0;
#pragma unroll
                for (int bj = 0; bj < 2; ++bj)
#pragma unroll
                    for (int n = 0; n < 2; ++n) { const f32x4 xv = *(const f32x4*)(X + off + bj * HALF + n * 16);
                        *(f32x4*)(OUT + off + bj * HALF + n * 16) = xv + gv[bj][n] * (acc[ai][bj][m][n] * rs); } }
    }
};

__device__ __forceinline__ float dpp_ror1(float v) { return __int_as_float(__builtin_amdgcn_update_dpp(0, __float_as_int(v), 0x121, 0xf, 0xf, false)); }
__device__ __forceinline__ float dpp_ror2(float v) { return __int_as_float(__builtin_amdgcn_update_dpp(0, __float_as_int(v), 0x122, 0xf, 0xf, false)); }
struct EpiUpConv {
    static constexpr bool PERM = true, AFTER_DRAIN = false, MIDK = false;
    bf16_t* GB; float* HALO; const float* cw; const float* cbias; PG8_LAS float* xch;
    __device__ __forceinline__ void mid(f32x4 (&)[2][2][4][2], const Unit&, int, int) const {}
    __device__ __forceinline__ void operator()(const f32x4 (&acc)[2][2][4][2], const Unit& u, int wr, int wc, int fr, int fq) const {
        const int col0 = u.pn * HALF + wc * 32 + 8 * fq;
        if (fr >= 14) {
#pragma unroll
            for (int ai = 0; ai < 2; ++ai) { PG8_LAS float* d = xch + ((((ai * 2 + wr) * 4 + wc) * 2 + (fr - 14)) * 4 + fq) * 8;
                *(PG8_LAS f32x4*)d = acc[ai][0][3][0]; *(PG8_LAS f32x4*)(d + 4) = acc[ai][0][3][1]; }
            if (wr == 1) { float* h = HALO + ((size_t)u.pm * 6 + (fr - 14)) * DFF + col0; *(f32x4*)h = acc[1][0][3][0]; *(f32x4*)(h + 4) = acc[1][0][3][1]; }
        }
        if (wr == 0 && fr < 2) { float* h = HALO + ((size_t)u.pm * 6 + 2 + fr) * DFF + col0; *(f32x4*)h = acc[0][0][0][0]; *(f32x4*)(h + 4) = acc[0][0][0][1];
            h += 2 * DFF; *(f32x4*)h = acc[0][1][0][0]; *(f32x4*)(h + 4) = acc[0][1][0][1]; }
        asm volatile("s_waitcnt lgkmcnt(0)" ::: "memory"); __builtin_amdgcn_s_barrier(); asm volatile("" ::: "memory");
        float w0[8], w1[8], w2[8], cb[8];
#pragma unroll
        for (int q = 0; q < 2; ++q) { const f32x4 u0 = *(const f32x4*)(cw + col0 + 4 * q), u1 = *(const f32x4*)(cw + DFF + col0 + 4 * q), u2 = *(const f32x4*)(cw + 2 * DFF + col0 + 4 * q), u3 = *(const f32x4*)(cbias + col0 + 4 * q);
#pragma unroll
            for (int e = 0; e < 4; ++e) { w0[4 * q + e] = u0[e]; w1[4 * q + e] = u1[e]; w2[4 * q + e] = u2[e]; cb[4 * q + e] = u3[e]; } }
#pragma unroll
        for (int ai = 0; ai < 2; ++ai) {
            f32x4 pg0 = {0.f, 0.f, 0.f, 0.f}, pg1 = {0.f, 0.f, 0.f, 0.f};
            if (wr == 1 || ai == 1) { const int pai = (wr == 1) ? ai : 0, pwr = (wr == 1) ? 0 : 1;
                const PG8_LAS float* s = xch + ((((pai * 2 + pwr) * 4 + wc) * 2 + (fr & 1)) * 4 + fq) * 8; pg0 = *(const PG8_LAS f32x4*)s; pg1 = *(const PG8_LAS f32x4*)(s + 4); }
#pragma unroll
            for (int m = 0; m < 4; ++m) {
                const f32x4 a0 = acc[ai][0][m][0], a1 = acc[ai][0][m][1], b0 = acc[ai][1][m][0], b1 = acc[ai][1][m][1];
                const f32x4 q0 = (m == 0) ? pg0 : acc[ai][0][m > 0 ? m - 1 : 0][0], q1 = (m == 0) ? pg1 : acc[ai][0][m > 0 ? m - 1 : 0][1];
                f32x4 g0, g1;
#pragma unroll
                for (int e = 0; e < 4; ++e) {
                    const float r1a = dpp_ror1(a0[e]), r1qa = dpp_ror1(q0[e]), r2a = dpp_ror2(a0[e]), r2qa = dpp_ror2(q0[e]);
                    const float r1b = dpp_ror1(a1[e]), r1qb = dpp_ror1(q1[e]), r2b = dpp_ror2(a1[e]), r2qb = dpp_ror2(q1[e]);
                    const float p1a = (fr >= 1) ? r1a : r1qa, p2a = (fr >= 2) ? r2a : r2qa, p1b = (fr >= 1) ? r1b : r1qb, p2b = (fr >= 2) ? r2b : r2qb;
                    const float ca = cb[e] + w0[e] * p2a + w1[e] * p1a + w2[e] * a0[e], cc = cb[4 + e] + w0[4 + e] * p2b + w1[4 + e] * p1b + w2[4 + e] * a1[e];
                    g0[e] = ca * fast_sigmoid(ca) * b0[e]; g1[e] = cc * fast_sigmoid(cc) * b1[e];
                }
                const int row = u.pm * BM + ai * HALF + wr * 64 + m * 16 + fr;
                *(u32x4*)(GB + (size_t)row * DFF + col0) = pack8(g0, g1);
            }
        }
    }
};

struct EpiDown {
    static constexpr bool PERM = false, AFTER_DRAIN = false, MIDK = false;
    const float* gt2; float* OUT; float* SSQ2;
    __device__ __forceinline__ void mid(f32x4 (&)[2][2][4][2], const Unit&, int, int) const {}
    __device__ __forceinline__ void operator()(const f32x4 (&acc)[2][2][4][2], const Unit& u, int wr, int wc, int fr, int fq) const {
        const int col0 = u.pn * BM + wc * 32 + 4 * fq;
        f32x4 gv[2][2];
#pragma unroll
        for (int bj = 0; bj < 2; ++bj)
#pragma unroll
            for (int n = 0; n < 2; ++n) gv[bj][n] = *(const f32x4*)(gt2 + col0 + bj * HALF + n * 16);
#pragma unroll
        for (int ai = 0; ai < 2; ++ai)
#pragma unroll
            for (int m = 0; m < 4; ++m) { const int row = u.pm * BM + ai * HALF + wr * 64 + m * 16 + fr; const size_t off = (size_t)row * DM + col0; float s = 0.f;
#pragma unroll
                for (int bj = 0; bj < 2; ++bj)
#pragma unroll
                    for (int n = 0; n < 2; ++n) { const f32x4 hv = *(const f32x4*)(OUT + off + bj * HALF + n * 16);
                        const f32x4 o = hv + gv[bj][n] * acc[ai][bj][m][n]; s += (o[0] * o[0] + o[1] * o[1]) + (o[2] * o[2] + o[3] * o[3]);
                        *(f32x4*)(OUT + off + bj * HALF + n * 16) = o; }
                s += __shfl_xor(s, 16); s += __shfl_xor(s, 32);
                if (fq == 0) SSQ2[(size_t)row * 32 + u.pn * 4 + wc] = s; }
    }
};
}
#include <hip/hip_bf16.h>
namespace att {
#define BIAS_LAS __attribute__((address_space(3)))
using bf16 = __hip_bfloat16;
typedef short bf16x8 __attribute__((ext_vector_type(8)));
typedef short s16x4 __attribute__((ext_vector_type(4)));
typedef float f32x16 __attribute__((ext_vector_type(16)));
typedef float f32x4 __attribute__((ext_vector_type(4)));
typedef unsigned u32x4 __attribute__((ext_vector_type(4)));
template <class A, class Bt> struct same_t { static constexpr bool v = false; };
template <class A> struct same_t<A, A> { static constexpr bool v = true; };
constexpr int D = 128, LDO = 2048;
constexpr float SCALE = 0.08838834764831845f;
constexpr float THR = 8.f;
constexpr bool WSKIP = false;
constexpr bool SEAM_PREFETCH = false;
constexpr int NW = 8, QBLK = 32, KVBLK = 64, QB = NW * QBLK;
constexpr int SHM_V = KVBLK * D * 2, SHM_K = KVBLK * D * 2;
constexpr int ATT_LDS = 2 * SHM_V + 2 * SHM_K + NW * 64 * 4;
constexpr int BIAS_OFF = 69632;
#define KSWZ(row, colB) ((row) * 256 + ((colB) ^ (((row) & 7) << 4)))
#define SBAR() __builtin_amdgcn_sched_barrier(0)
__device__ __forceinline__ int v_st(int k, int c) { const int kk = (k & ~0xC) | ((k & 4) << 1) | ((k & 8) >> 1); return ((kk >> 3) * 4 + (c >> 5)) * 512 + ((kk & 7) * 32 + (c & 31)) * 2; }
__device__ __forceinline__ int v_rd_base(int lane) { return ((lane & 3) << 3) | (((lane >> 2) & 3) << 6) | (((lane >> 4) & 1) << 5) | (((lane >> 5) & 1) << 8); }
constexpr int v_rd_off(int d0, int ks, int half) { return d0 * 512 + ks * 4096 + half * 2048; }
__device__ __forceinline__ int crow(int r, int hi) { return (r & 3) + 8 * (r >> 2) + 4 * hi; }
__device__ __forceinline__ unsigned cvtpk(float lo, float hi) {
    unsigned r; asm volatile("v_cvt_pk_bf16_f32 %0, %1, %2" : "=v"(r) : "v"(lo), "v"(hi)); return r;
}
__device__ __forceinline__ bf16x8 pack8(f32x4 a, f32x4 b) {
    u32x4 w = {cvtpk(a[0], a[1]), cvtpk(a[2], a[3]), cvtpk(b[0], b[1]), cvtpk(b[2], b[3])};
    return *reinterpret_cast<bf16x8*>(&w);
}
template <class T> __device__ __forceinline__ bf16x8 load8(const T* p) {
    if constexpr (same_t<T, float>::v) { return pack8(*(const f32x4*)p, *(const f32x4*)(p + 4)); }
    else { return *reinterpret_cast<const bf16x8*>(p); }
}
__device__ __forceinline__ void mask_tile(f32x16& p0, f32x16& p1, int dq, unsigned W) {
    const float NEG = -__builtin_inff();
#pragma unroll
    for (int r = 0; r < 16; ++r) {
        const int c = (r & 3) + 8 * (r >> 2);
        if ((unsigned)(dq - c) >= W) p0[r] = NEG;
        if ((unsigned)(dq - c - 32) >= W) p1[r] = NEG;
    }
}
__device__ __forceinline__ void partialSM(f32x16& p0, f32x16& p1, float& m_reg, float& mn, float& alpha) {
    float pmax = p0[0]; for (int r = 1; r < 16; ++r) pmax = fmaxf(pmax, p0[r]); for (int r = 0; r < 16; ++r) pmax = fmaxf(pmax, p1[r]);
    { auto rr = __builtin_amdgcn_permlane32_swap(__float_as_uint(pmax), __float_as_uint(pmax), false, false);
      pmax = fmaxf(__uint_as_float(rr[0]), __uint_as_float(rr[1])); }
    constexpr float C2 = 1.4426950408889634f * SCALE;
    if (__builtin_expect(__all((pmax - m_reg) * SCALE <= THR), 1)) { mn = m_reg; alpha = 1.f; }
    else { mn = fmaxf(m_reg, pmax); alpha = __builtin_amdgcn_exp2f((m_reg - mn) * C2); m_reg = mn; }
    const float mnL = -mn * C2;
    for (int r = 0; r < 16; ++r) p0[r] = fmaf(p0[r], C2, mnL); for (int r = 0; r < 16; ++r) p1[r] = fmaf(p1[r], C2, mnL);
    for (int r = 0; r < 16; ++r) p0[r] = __builtin_amdgcn_exp2f(p0[r]);
}
__device__ __forceinline__ void finishSM(f32x16& p0, f32x16& p1, float alpha, float& l_reg, bf16x8& pa0, bf16x8& pa1, bf16x8& pa2, bf16x8& pa3) {
    for (int r = 0; r < 16; ++r) p1[r] = __builtin_amdgcn_exp2f(p1[r]);
    float ps = 0; for (int r = 0; r < 16; ++r) ps += p0[r]; for (int r = 0; r < 16; ++r) ps += p1[r];
    { auto rr = __builtin_amdgcn_permlane32_swap(__float_as_uint(ps), __float_as_uint(ps), false, false);
      ps = __uint_as_float(rr[0]) + __uint_as_float(rr[1]); }
    l_reg = l_reg * alpha + ps;
#define PK4(P, B_, OUT) do { unsigned a0 = cvtpk(P[B_+0], P[B_+1]), a1 = cvtpk(P[B_+2], P[B_+3]);                          \
        unsigned b0 = cvtpk(P[B_+4], P[B_+5]), b1 = cvtpk(P[B_+6], P[B_+7]);                                             \
        auto r0 = __builtin_amdgcn_permlane32_swap(a0, b0, false, false); auto r1 = __builtin_amdgcn_permlane32_swap(a1, b1, false, false); \
        u32x4 w = {r0[0], r1[0], r0[1], r1[1]}; OUT = *reinterpret_cast<bf16x8*>(&w); } while (0)
    PK4(p0, 0, pa0); PK4(p0, 8, pa1); PK4(p1, 0, pa2); PK4(p1, 8, pa3);
#undef PK4
}
template <int KB, bool SK>
__device__ __forceinline__ void qkt(f32x16& p0, f32x16& p1, const char* K_lds, int r32, int hi, const bf16x8* qr, bool act, const BIAS_LAS float* bp) {
    if (SK && !act) { const float NEG = -__builtin_inff();
#pragma unroll
        for (int r = 0; r < 16; ++r) { p0[r] = NEG; p1[r] = NEG; } return; }
#ifdef NOBIAS
    p0 = f32x16{}; p1 = f32x16{};
#else
    { const BIAS_LAS f32x4* b4 = (const BIAS_LAS f32x4*)bp;
      const f32x4 t0 = b4[0], t1 = b4[2], t2 = b4[4], t3 = b4[6], t4 = b4[8], t5 = b4[10], t6 = b4[12], t7 = b4[14];
      p0 = f32x16{t0[0], t0[1], t0[2], t0[3], t1[0], t1[1], t1[2], t1[3], t2[0], t2[1], t2[2], t2[3], t3[0], t3[1], t3[2], t3[3]};
      p1 = f32x16{t4[0], t4[1], t4[2], t4[3], t5[0], t5[1], t5[2], t5[3], t6[0], t6[1], t6[2], t6[3], t7[0], t7[1], t7[2], t7[3]}; }
#endif
    const char* kb[4];
#pragma unroll
    for (int dd = 0; dd < 4; ++dd) kb[dd] = K_lds + KB * SHM_K + KSWZ(r32, (dd * 16 + hi * 8) * 2);
#pragma unroll
    for (int d0 = 0; d0 < 8; ++d0) { const char* a = kb[d0 & 3] + (d0 >> 2) * 128;
        bf16x8 b0 = *reinterpret_cast<const bf16x8*>(a);
        bf16x8 b1 = *reinterpret_cast<const bf16x8*>(a + 32 * 256);
        p0 = __builtin_amdgcn_mfma_f32_32x32x16_bf16(b0, qr[d0], p0, 0, 0, 0);
        p1 = __builtin_amdgcn_mfma_f32_32x32x16_bf16(b1, qr[d0], p1, 0, 0, 0); }
}
template <int VB, bool SK>
__device__ __forceinline__ void pv_tile(f32x16* o, int vb0, bf16x8 pa0, bf16x8 pa1, bf16x8 pa2, bf16x8 pa3, bool act) {
    if (SK && !act) return;
#define TRRD(dst, off) asm volatile("ds_read_b64_tr_b16 %0, %1 offset:%2" : "=&v"(dst) : "v"(vb0), "i"(off) : "memory")
#define PV_D0(d0) do { s16x4 l0, l1, l2, l3, h0, h1, h2, h3; constexpr int b_ = VB * SHM_V + v_rd_off(d0, 0, 0);     \
        TRRD(l0, b_); TRRD(h0, b_ + 2048); TRRD(l1, b_ + 4096); TRRD(h1, b_ + 6144); TRRD(l2, b_ + 8192); TRRD(h2, b_ + 10240); TRRD(l3, b_ + 12288); TRRD(h3, b_ + 14336); \
        asm volatile("s_waitcnt lgkmcnt(0)" ::: "memory"); SBAR();                 \
        o[d0] = __builtin_amdgcn_mfma_f32_32x32x16_bf16(pa0, (bf16x8){l0[0], l0[1], l0[2], l0[3], h0[0], h0[1], h0[2], h0[3]}, o[d0], 0, 0, 0);   \
        o[d0] = __builtin_amdgcn_mfma_f32_32x32x16_bf16(pa1, (bf16x8){l1[0], l1[1], l1[2], l1[3], h1[0], h1[1], h1[2], h1[3]}, o[d0], 0, 0, 0);   \
        o[d0] = __builtin_amdgcn_mfma_f32_32x32x16_bf16(pa2, (bf16x8){l2[0], l2[1], l2[2], l2[3], h2[0], h2[1], h2[2], h2[3]}, o[d0], 0, 0, 0);   \
        o[d0] = __builtin_amdgcn_mfma_f32_32x32x16_bf16(pa3, (bf16x8){l3[0], l3[1], l3[2], l3[3], h3[0], h3[1], h3[2], h3[3]}, o[d0], 0, 0, 0); } while (0)
    PV_D0(0); PV_D0(1); PV_D0(2); PV_D0(3);
#undef PV_D0
#undef TRRD
}
template <class TIn, class TOut> struct BlockRef { const TIn* Q; const TIn* K; const TIn* V; TOut* O; int P0; int JLO; float* SSQ; };
template <class TIn> struct Seam {
    bf16x8 qr[8];
    bf16x8 st_v0, st_v1, st_k0, st_k1; f32x4 sf0, sf1, sf2, sf3;
    f32x4 tq[16];
};
#define ROW(p, k0, rr) ((p) + (size_t)((k0) + (rr)) * D + sc)
#define VMW() asm volatile("s_waitcnt vmcnt(0)" ::: "memory")
#define VMWN(n) asm volatile("s_waitcnt vmcnt(%0)" :: "i"(n) : "memory")
#define SLOAD_H(Kp, Vp, k0) do { S.st_v0 = load8<TIn>(ROW(Vp, k0, sr)); S.st_v1 = load8<TIn>(ROW(Vp, k0, 32 + sr));              \
                         S.st_k0 = load8<TIn>(ROW(Kp, k0, sr)); S.st_k1 = load8<TIn>(ROW(Kp, k0, 32 + sr)); } while (0)
#define SWRITE_HK(bf) do { *(bf16x8*)(K_lds + (bf) * SHM_K + kws) = S.st_k0; *(bf16x8*)(K_lds + (bf) * SHM_K + kws + 32 * 256) = S.st_k1; } while (0)
#define SWRITE_HV(bf) do { *(bf16x8*)(V_lds + (bf) * SHM_V + vst0) = S.st_v0; *(bf16x8*)(V_lds + (bf) * SHM_V + vst1) = S.st_v1; } while (0)
#define SWRITE_H(bf) do { SWRITE_HV(bf); SWRITE_HK(bf); } while (0)
#define SLOAD_F(p, k0) do { S.sf0 = *(const f32x4*)ROW(p, k0, sr); S.sf1 = *(const f32x4*)(ROW(p, k0, sr) + 4);                \
                            S.sf2 = *(const f32x4*)ROW(p, k0, 32 + sr); S.sf3 = *(const f32x4*)(ROW(p, k0, 32 + sr) + 4); } while (0)
#define SWRITE_KF(bf) do { *(bf16x8*)(K_lds + (bf) * SHM_K + kws) = pack8(S.sf0, S.sf1); *(bf16x8*)(K_lds + (bf) * SHM_K + kws + 32 * 256) = pack8(S.sf2, S.sf3); } while (0)
#define SWRITE_VF(bf) do { *(bf16x8*)(V_lds + (bf) * SHM_V + vst0) = pack8(S.sf0, S.sf1); *(bf16x8*)(V_lds + (bf) * SHM_V + vst1) = pack8(S.sf2, S.sf3); } while (0)
template <class TIn, class TOut>
__device__ __forceinline__ void causal_swa_prime(const BlockRef<TIn, TOut>& cur, int W, char* lds, Seam<TIn>& S, const int wv) {
    constexpr bool F32 = same_t<TIn, float>::v;
    int tid_ = wv * 64 + ((int)__builtin_amdgcn_mbcnt_hi(~0u, __builtin_amdgcn_mbcnt_lo(~0u, 0u))); asm volatile("" : "+v"(tid_));
    const int tid = tid_, wid = __builtin_amdgcn_readfirstlane(tid >> 6), lane = tid & 63, r32 = lane & 31, hi = lane >> 5;
    const int sr = tid >> 4, sc = (tid & 15) * 8, kws = KSWZ(sr, sc * 2); char* K_lds = lds + 2 * SHM_V;
    const int kb0 = cur.JLO * KVBLK;
    for (int d0 = 0; d0 < 8; ++d0) S.qr[d0] = load8<TIn>(cur.Q + (size_t)(wid * QBLK + r32) * D + d0 * 16 + hi * 8);
    if constexpr (F32) { SLOAD_F((const float*)cur.K, kb0); VMW(); SWRITE_KF(0); SBAR(); SLOAD_F((const float*)cur.V, kb0); }
    else { SLOAD_H(cur.K, cur.V, kb0); VMW(); SWRITE_HK(0); }
    __syncthreads();
}
template <class TIn, class TOut>
__device__ __forceinline__ void causal_swa_block(const BlockRef<TIn, TOut>& cur, const BlockRef<TIn, TOut>& nxt, int skv, int W, char* lds, Seam<TIn>& S, const BIAS_LAS float* bias, const int wv) {
    constexpr bool F32 = same_t<TIn, float>::v;
    int tid_ = wv * 64 + ((int)__builtin_amdgcn_mbcnt_hi(~0u, __builtin_amdgcn_mbcnt_lo(~0u, 0u))); asm volatile("" : "+v"(tid_));
    const int tid = tid_, wid = __builtin_amdgcn_readfirstlane(tid >> 6), lane = tid & 63, r32 = lane & 31, hi = lane >> 5;
    const int j_lo = cur.JLO; const BIAS_LAS float* bias4 = bias + 4 * hi;
    int j_hi = (cur.P0 + QB - 1) / KVBLK + 1; if (j_hi > skv / KVBLK) j_hi = skv / KVBLK;
    const int NT = j_hi - j_lo;
    const int kbn = nxt.JLO * KVBLK;
    const int qlo = cur.P0 + wid * QBLK, qm = qlo + r32 - 4 * hi;
    char* V_lds = lds; char* K_lds = lds + 2 * SHM_V;
    float* ws = (float*)(lds + 2 * SHM_V + 2 * SHM_K) + wid * 64; float* li_l = ws, * al_l = ws + 32;
    float m_reg = -1e30f, l_reg = 0; f32x16 o[4] = {};
    const int sr = tid >> 4, sc = (tid & 15) * 8, vst0 = v_st(sr, sc), vst1 = v_st(32 + sr, sc), kws = KSWZ(sr, sc * 2);
    const int vb0 = (int)(uintptr_t)V_lds + v_rd_base(lane);
    const TIn* Kh = cur.K; const TIn* Vh = cur.V;
#define RESC(a) do { if (__any((a) < 1.f)) { if (hi == 0) al_l[r32] = (a); asm volatile("s_waitcnt lgkmcnt(0)" ::: "memory");              \
                     for (int d_ = 0; d_ < 4; ++d_) for (int r = 0; r < 16; ++r) o[d_][r] *= al_l[crow(r, hi)]; } } while (0)
#define KBASE(t) ((j_lo + (t)) * KVBLK)
#define BP(t) (bias4 + (t) * KVBLK)
#define ACT(t) (KBASE(t) <= qlo + QBLK - 1 && KBASE(t) + KVBLK - 1 >= qlo - W + 1)
#define MASKT(P0_, P1_, t) do { const int kb_ = KBASE(t); if ((!SK || ACT(t)) && (kb_ + KVBLK - 1 > qlo || kb_ <= qlo + QBLK - 1 - W)) mask_tile(P0_, P1_, qm - kb_, (unsigned)W); } while (0)
    constexpr int NQL = F32 ? 16 : 8;
    constexpr bool SK = WSKIP && !F32;
#define SEAM_K0() do { VMWN(NQL); if constexpr (F32) { SWRITE_KF(0); SBAR(); SLOAD_F((const float*)nxt.V, kbn); } else { SWRITE_HK(0); } SBAR(); } while (0)
    f32x16 pA0, pA1, pB0, pB1; float mnA, mnB, alA, alB; bf16x8 pa0, pa1, pa2, pa3;
    if constexpr (F32) { VMW(); SWRITE_VF(0); SBAR(); } else { SWRITE_HV(0); SBAR(); }
    if (NT > 1) { if constexpr (F32) SLOAD_F((const float*)Kh, KBASE(1)); else SLOAD_H(Kh, Vh, KBASE(1)); }
    SBAR(); qkt<0, SK>(pA0, pA1, K_lds, r32, hi, S.qr, ACT(0), BP(0));
    if constexpr (F32) { if (NT > 1) { VMW(); SWRITE_KF(1); SBAR(); SLOAD_F((const float*)Vh, KBASE(1)); } }
    MASKT(pA0, pA1, 0); partialSM(pA0, pA1, m_reg, mnA, alA);
    if (NT > 1) { VMW(); if constexpr (F32) { SWRITE_VF(1); SBAR(); if (NT > 2) SLOAD_F((const float*)Kh, KBASE(2)); } else SWRITE_H(1); }
    __syncthreads();
#define HALF_STEP(PX0, PX1, mnX, alX, PY0, PY1, alY, t, KB, VB, SB) do {                                                      \
        SBAR(); qkt<KB, SK>(PX0, PX1, K_lds, r32, hi, S.qr, ACT(t), BP(t));                                             \
        finishSM(PY0, PY1, alY, l_reg, pa0, pa1, pa2, pa3); SBAR();                                                           \
        if ((t) + 1 < NT) { if constexpr (F32) { VMW(); SWRITE_KF(SB); SBAR(); SLOAD_F((const float*)Vh, KBASE((t) + 1)); }  \
                            else { SLOAD_H(Kh, Vh, KBASE((t) + 1)); } SBAR(); }                                               \
        pv_tile<VB, SK>(o, vb0, pa0, pa1, pa2, pa3, ACT((t) - 1)); MASKT(PX0, PX1, (t)); partialSM(PX0, PX1, m_reg, mnX, alX);                                        \
        __syncthreads();                                                                                                      \
        if ((t) + 1 < NT) { VMW(); if constexpr (F32) { SWRITE_VF(SB); SBAR(); if ((t) + 2 < NT) SLOAD_F((const float*)Kh, KBASE((t) + 2)); } \
                            else { SWRITE_H(SB); } }                                                                          \
        RESC(alX); __syncthreads(); } while (0)
    for (int t = 1; t + 1 < NT; t += 2) {
        HALF_STEP(pB0, pB1, mnB, alB, pA0, pA1, alA, t, 1, 0, 0);
        HALF_STEP(pA0, pA1, mnA, alA, pB0, pB1, alB, t + 1, 0, 1, 1);
    }
    const bool even = (NT & 1) == 0;
    if (even) { SBAR(); qkt<1, SK>(pB0, pB1, K_lds, r32, hi, S.qr, ACT(NT - 1), BP(NT - 1)); SBAR(); }
#define QROW(e) (nxt.Q + (size_t)(wid * QBLK + r32) * D + ((e) >> 1) * 16 + hi * 8 + ((e) & 1) * 4)
    if constexpr (F32) { SLOAD_F((const float*)nxt.K, kbn); SBAR();
#pragma unroll
        for (int e = 0; e < 8; ++e) S.tq[e] = *(const f32x4*)QROW(e); }
    else if constexpr (SEAM_PREFETCH) { SLOAD_H(nxt.K, nxt.V, kbn); SBAR();
#pragma unroll
        for (int d0 = 0; d0 < 8; ++d0) S.qr[d0] = load8<TIn>(nxt.Q + (size_t)(wid * QBLK + r32) * D + d0 * 16 + hi * 8); }
    SBAR();
    finishSM(pA0, pA1, alA, l_reg, pa0, pa1, pa2, pa3); SBAR();
    if constexpr (F32) {
#pragma unroll
        for (int e = 8; e < 16; ++e) S.tq[e] = *(const f32x4*)QROW(e); SBAR(); }
#undef QROW
    pv_tile<0, SK>(o, vb0, pa0, pa1, pa2, pa3, ACT(even ? NT - 2 : NT - 1));
    if (even) { MASKT(pB0, pB1, NT - 1); partialSM(pB0, pB1, m_reg, mnB, alB); __syncthreads(); RESC(alB);
        finishSM(pB0, pB1, alB, l_reg, pa0, pa1, pa2, pa3); SBAR(); pv_tile<1, SK>(o, vb0, pa0, pa1, pa2, pa3, ACT(NT - 1)); }
    SBAR(); if constexpr (SEAM_PREFETCH) SEAM_K0();
    if (hi == 0) li_l[r32] = l_reg; asm volatile("s_waitcnt lgkmcnt(0)" ::: "memory");
    float rli[16];
#pragma unroll
    for (int r = 0; r < 16; ++r) rli[r] = __builtin_amdgcn_rcpf(li_l[crow(r, hi)]);
    TOut* Ow = cur.O + (size_t)(wid * QBLK) * LDO;
#pragma unroll
    for (int r = 0; r < 16; ++r) { int orow = crow(r, hi); asm volatile("" : "+v"(orow)); float sq = 0.f;
#pragma unroll
        for (int d0 = 0; d0 < 4; ++d0) { const float v = o[d0][r] * rli[r]; sq += v * v;
            { const float vn = __shfl_xor(v, 1);
                   if ((r32 & 1) == 0) *(unsigned*)(Ow + (size_t)orow * LDO + d0 * 32 + r32) = cvtpk(v, vn); } }
        sq += __shfl_xor(sq, 1); sq += __shfl_xor(sq, 2); sq += __shfl_xor(sq, 4); sq += __shfl_xor(sq, 8); sq += __shfl_xor(sq, 16);
        if (r32 == 0) cur.SSQ[(size_t)(wid * QBLK + orow) * 32] = sq; }
    if constexpr (F32) {
#pragma unroll
        for (int d0 = 0; d0 < 8; ++d0) S.qr[d0] = pack8(S.tq[2 * d0], S.tq[2 * d0 + 1]); }
    __syncthreads();
#undef RESC
#undef KBASE
#undef BP
#undef ACT
#undef MASKT
#undef SEAM_K0
#undef HALF_STEP
}
#undef ROW
#undef VMW
#undef VMWN
#undef SLOAD_H
#undef SWRITE_HK
#undef SWRITE_HV
#undef SWRITE_H
#undef SLOAD_F
#undef SWRITE_KF
#undef SWRITE_VF
}
#define LAS __attribute__((address_space(3)))
typedef unsigned short bf16_t;
struct Args { const float* in[26]; float* out; unsigned char* ws; };

#define XB_TMO      128
#define XB_XCNT(j)  (256  + 64 * (j))
#define XB_XSUB(j)  (1280 + 64 * (j))
#define XB_XGEN(j)  (2304 + 64 * (j))
#define XB_TOP      3328
#define XB_TOPGEN   3392
#define XCD_BAR_WORDS 3456
#define XB_SPIN_CAP (1u << 18)

__device__ __forceinline__ unsigned xb_ld(unsigned* p)              { return __hip_atomic_load(p, __ATOMIC_RELAXED, __HIP_MEMORY_SCOPE_AGENT); }
__device__ __forceinline__ unsigned xb_add(unsigned* p, unsigned v) { return __hip_atomic_fetch_add(p, v, __ATOMIC_RELAXED, __HIP_MEMORY_SCOPE_AGENT); }
__device__ __forceinline__ unsigned xb_xcc_id() { return (unsigned)__builtin_amdgcn_s_getreg((3 << 11) | 20) & 0xFu; }
#define XB_SPIN(cond, bar) do { unsigned _sp = 0; while (cond) { __builtin_amdgcn_s_sleep(1); \
    if ((++_sp & 255u) == 0u) { if (xb_ld(&(bar)[XB_TMO])) break; if (_sp > XB_SPIN_CAP) { atomicAdd(&(bar)[XB_TMO], 1u); break; } } } } while (0)

struct XcdBarrier {
    unsigned* bar; unsigned x;
    volatile LAS unsigned* st;
};

__device__ __forceinline__ XcdBarrier xcd_barrier_post(unsigned* bar, volatile LAS unsigned* st, bool t0) {
    XcdBarrier b; b.bar = bar; b.x = xb_xcc_id(); b.st = st;
    if (t0) (void)xb_add(&bar[XB_XCNT(b.x)], 1u);
    return b;
}
__device__ __forceinline__ void xcd_barrier_complete(unsigned* bar, unsigned x, unsigned& nloc, unsigned& nx) {
    const unsigned G = gridDim.x * gridDim.y * gridDim.z;
    unsigned sum, cnt, mine, sp = 0u;
    for (;;) {
        sum = 0u; cnt = 0u; mine = 0u;
#pragma unroll
        for (unsigned j = 0; j < 16; ++j) { const unsigned c = xb_ld(&bar[XB_XCNT(j)]); sum += c; cnt += (c > 0u) ? 1u : 0u; mine = (j == x) ? c : mine; }
        if (sum == G) break;
        __builtin_amdgcn_s_sleep(1);
        if ((++sp & 255u) == 0u) { if (xb_ld(&bar[XB_TMO])) break; if (sp > XB_SPIN_CAP) { atomicAdd(&bar[XB_TMO], 1u); break; } }
    }
    nloc = mine > 0u ? mine : 1u; nx = cnt > 0u ? cnt : 1u;
}

__device__ __forceinline__ void xcd_barrier(const XcdBarrier& b, bool t0) {
    asm volatile("s_waitcnt vmcnt(0)" ::: "memory");
    __syncthreads();
    if (t0) {
        unsigned* bar = b.bar;
        __builtin_amdgcn_s_waitcnt(0);
        unsigned nloc = b.st[0], nx = b.st[1];
        if (nloc == 0u) { xcd_barrier_complete(bar, b.x, nloc, nx); b.st[0] = nloc; b.st[1] = nx; }
        const unsigned old = xb_add(&bar[XB_XSUB(b.x)], 1u);
        const unsigned gen = old / nloc;
        if (old + 1u == (gen + 1u) * nloc) {
            __builtin_amdgcn_fence(__ATOMIC_RELEASE, "agent");
            asm volatile("s_waitcnt vmcnt(0)" ::: "memory");
            const unsigned og = xb_add(&bar[XB_TOP], 1u);
            const unsigned tg = og / nx;
            if (og + 1u == (tg + 1u) * nx) xb_add(&bar[XB_TOPGEN], 1u);
            else XB_SPIN(xb_ld(&bar[XB_TOPGEN]) == tg, bar);
            __builtin_amdgcn_fence(__ATOMIC_ACQUIRE, "agent");
            xb_add(&bar[XB_XGEN(b.x)], 1u);
            asm volatile("s_waitcnt vmcnt(0)" ::: "memory");
        } else {
            XB_SPIN(xb_ld(&bar[XB_XGEN(b.x)]) == gen, bar);
            __builtin_amdgcn_fence(__ATOMIC_ACQUIRE, "agent");
            asm volatile("s_waitcnt vmcnt(0)" ::: "memory");
        }
    }
    __syncthreads();
}

__device__ __forceinline__ float wave_sum(float v) {
#pragma unroll
    for (int o = 1; o < 64; o <<= 1) v += __shfl_xor(v, o);
    return v;
}
__device__ __forceinline__ unsigned pk2(float lo, float hi) { return pg8::cvt_pk_bf16(lo, hi); }

__device__ __forceinline__ void tr_item(const float* __restrict__ W, int ldw, int srccol0, int k0, bf16_t* __restrict__ WT, int K, int dstrow0,
                                        const float* rs0, const float* rs1, LAS float* scr, int lane) {
    float tv[32];
    const float* wp = W + (size_t)(k0 + (lane >> 5)) * ldw + srccol0 + (lane & 31);
#pragma unroll
    for (int i = 0; i < 32; ++i) tv[i] = wp[(size_t)(2 * i) * ldw];
#pragma unroll
    for (int i = 0; i < 32; ++i) { const int kk = 2 * i + (lane >> 5); float v = tv[i];
        if (rs0) { const int k = k0 + kk; v *= (k < 1024 ? rs0[k] : rs1[k - 1024]); }
        scr[kk * 33 + (lane & 31)] = v; }
    asm volatile("s_waitcnt lgkmcnt(0)" ::: "memory");
    const int c = lane & 7;
#pragma unroll
    for (int j = 0; j < 4; ++j) { const int n = (lane >> 3) + 8 * j; const LAS float* s = scr + (8 * c) * 33 + n;
        u32x4_t o; o.x = pk2(s[0 * 33], s[1 * 33]); o.y = pk2(s[2 * 33], s[3 * 33]); o.z = pk2(s[4 * 33], s[5 * 33]); o.w = pk2(s[6 * 33], s[7 * 33]);
        *(u32x4_t*)(WT + (size_t)(dstrow0 + n) * K + k0 + 8 * c) = o; }
    asm volatile("s_waitcnt lgkmcnt(0)" ::: "memory");
}

__device__ __forceinline__ void ssm_setup_item(const Args& a, unsigned char* ws, LAS unsigned char* lds, int g, int qtr, int tid) {
    LAS float* Bre = (LAS float*)lds; LAS float* Bim = Bre + 1024; LAS float* Cre = Bre + 2048; LAS float* Cim = Bre + 3072;
    LAS float* Pr = Bre + 4096; LAS float* Pi = Pr + 33 * 64; LAS float* MZr = Pi + 33 * 64; LAS float* MZi = MZr + 32 * 64; LAS float* KT = MZi + 32 * 64;
    const float* b_re = a.in[10] + (size_t)g * 1024; const float* b_im = a.in[11] + (size_t)g * 1024;
    const float* c_re = a.in[12] + (size_t)g * 1024; const float* c_im = a.in[13] + (size_t)g * 1024;
    for (int i = tid; i < 1024; i += 512) { Bre[i] = b_re[i]; Bim[i] = b_im[i]; Cre[i] = c_re[i]; Cim[i] = c_im[i]; }
    if (tid < 64) {
        const int p = tid; const float dt = expf(a.in[9][g]); const float ar = a.in[7][g * NP + p], ai = a.in[8][g * NP + p];
        const float mag = expf(dt * ar); const float abr = mag * cosf(dt * ai), abi = mag * sinf(dt * ai);
        const float nre = abr - 1.f, nim = abi, den = ar * ar + ai * ai;
        const float zr = (nre * ar + nim * ai) / den, zi = (nim * ar - nre * ai) / den;
        float pr = 1.f, pi = 0.f;
        for (int j = 0; j <= 32; ++j) {
            Pr[j * 64 + p] = pr; Pi[j * 64 + p] = pi;
            if (j < 32) { MZr[p * 32 + j] = pr * zr - pi * zi; MZi[p * 32 + j] = pr * zi + pi * zr; }
            const float nr = pr * abr - pi * abi, ni = pr * abi + pi * abr; pr = nr; pi = ni;
        }
        if (qtr == 0) { float* P32 = (float*)(ws + WS_P32); P32[(g * NP + p) * 2] = Pr[32 * 64 + p]; P32[(g * NP + p) * 2 + 1] = Pi[32 * 64 + p]; }
    }
    __syncthreads();
    const float* dsk = a.in[14] + g * GCH;
    {
        const int h = (tid & 255) >> 4, i = tid & 15, j0 = (tid >> 8) * 16;
        float acc[16];
#pragma unroll
        for (int jj = 0; jj < 16; ++jj) acc[jj] = 0.f;
        for (int p = 0; p < 64; ++p) {
            const float cr = Cre[h * 64 + p], ci = Cim[h * 64 + p], br = Bre[p * 16 + i], bi = Bim[p * 16 + i];
            const float cbr = cr * br - ci * bi, cbi = cr * bi + ci * br;
#pragma unroll
            for (int q = 0; q < 4; ++q) { const f32x4_t mr = *(const LAS f32x4_t*)(MZr + p * 32 + j0 + 4 * q), mi = *(const LAS f32x4_t*)(MZi + p * 32 + j0 + 4 * q);
#pragma unroll
                for (int e = 0; e < 4; ++e) acc[4 * q + e] += mr[e] * cbr - mi[e] * cbi; }
        }
        if (j0 == 0 && h == i) acc[0] += dsk[h];
#pragma unroll
        for (int jj = 0; jj < 16; ++jj) KT[((j0 + jj) << 8) + (h << 4) + i] = acc[jj];
    }
    __syncthreads();
    bf16_t* GC = (bf16_t*)(ws + WS_GC) + (size_t)g * 512 * KA;
    for (int ci = tid; ci < 128 * 80; ci += 512) {
        const int nl = ci / 80, ch = ci - nl * 80, n = qtr * 128 + nl, t = n >> 4, h = n & 15; float v[8];
        if (ch < 64) { const int s = ch >> 1, i0 = (ch & 1) * 8;
            if (s <= t) { const f32x4_t k0v = *(const LAS f32x4_t*)(KT + ((t - s) << 8) + (h << 4) + i0), k1v = *(const LAS f32x4_t*)(KT + ((t - s) << 8) + (h << 4) + i0 + 4);
                v[0] = k0v[0]; v[1] = k0v[1]; v[2] = k0v[2]; v[3] = k0v[3]; v[4] = k1v[0]; v[5] = k1v[1]; v[6] = k1v[2]; v[7] = k1v[3]; }
            else {
#pragma unroll
                for (int e = 0; e < 8; ++e) v[e] = 0.f; }
        } else { const int pp = (ch - 64) * 8;
#pragma unroll
            for (int e = 0; e < 8; ++e) { const int p = (pp + e) & 63; const float cr = Cre[h * 64 + p], cim = Cim[h * 64 + p], pr = Pr[(t + 1) * 64 + p], pi = Pi[(t + 1) * 64 + p];
                v[e] = (pp < 64) ? (cr * pr - cim * pi) : -(cr * pi + cim * pr); }
        }
        u32x4_t o; o.x = pk2(v[0], v[1]); o.y = pk2(v[2], v[3]); o.z = pk2(v[4], v[5]); o.w = pk2(v[6], v[7]);
        *(u32x4_t*)(GC + (size_t)n * KA + ch * 8) = o;
    }
    bf16_t* WE = (bf16_t*)(ws + WS_WEND) + (size_t)g * 256 * 512;
    for (int ci = tid; ci < 64 * 64; ci += 512) {
        const int rl = ci >> 6, ch = ci & 63, pr_ = qtr * 64 + rl, s = ch >> 1, i0 = (ch & 1) * 8, p = pr_ & 63; float v[8];
#pragma unroll
        for (int e = 0; e < 8; ++e) { const float mr = MZr[p * 32 + (31 - s)], mi = MZi[p * 32 + (31 - s)], br = Bre[p * 16 + i0 + e], bi = Bim[p * 16 + i0 + e];
            v[e] = (pr_ < 64) ? (mr * br - mi * bi) : ((pr_ < 128) ? (mr * bi + mi * br) : 0.f); }
        u32x4_t o; o.x = pk2(v[0], v[1]); o.y = pk2(v[2], v[3]); o.z = pk2(v[4], v[5]); o.w = pk2(v[6], v[7]);
        *(u32x4_t*)(WE + (size_t)pr_ * 512 + ch * 8) = o;
    }
    __syncthreads();
}

__device__ __forceinline__ void norm_mod_row(const float* xrow, bf16_t* orow, const LAS float* gs, const LAS float* shv, int lane, f32x4_t (&v)[8]) {
    const f32x4_t* xr = (const f32x4_t*)xrow + lane; float s = 0.f;
#pragma unroll
    for (int j = 0; j < 8; ++j) { v[j] = xr[64 * j]; s += (v[j][0] * v[j][0] + v[j][1] * v[j][1]) + (v[j][2] * v[j][2] + v[j][3] * v[j][3]); }
    const float rstd = 1.0f / sqrtf(wave_sum(s) * (1.0f / DM) + EPS);
#pragma unroll
    for (int j = 0; j < 8; ++j) { const int k = 4 * lane + 256 * j; const f32x4_t g4 = *(const LAS f32x4_t*)(gs + k), s4 = *(const LAS f32x4_t*)(shv + k);
        v[j] = v[j] * rstd * g4 + s4;
        u32x2_t o; o.x = pk2(v[j][0], v[j][1]); o.y = pk2(v[j][2], v[j][3]); *(u32x2_t*)(orow + k) = o; }
}

__global__ void __launch_bounds__(512, 2) fwd_kernel(Args a) {
    extern __shared__ __attribute__((aligned(16))) unsigned char lds_raw[];
    LAS unsigned char* lds = (LAS unsigned char*)lds_raw;
    const int wave = __builtin_amdgcn_readfirstlane((int)threadIdx.x >> 6), G = gridDim.x, bid = blockIdx.x;
#define lane ((int)__builtin_amdgcn_mbcnt_hi(~0u, __builtin_amdgcn_mbcnt_lo(~0u, 0u)))
#define tid (wave * 64 + lane)
    const int gw = bid * 8 + wave, NGW = G * 8;
    unsigned char* ws = a.ws;
    volatile LAS unsigned* xst = (volatile LAS unsigned*)(lds + LDS_BYTES - 64);
    if (tid < 2) xst[tid] = 0u;
    __syncthreads();
    XcdBarrier xbar = xcd_barrier_post((unsigned*)(ws + WS_CTL) + 4096, xst, tid == 0);
#define GRID_BAR() xcd_barrier(xbar, tid == 0)
#define MODP ((float*)(ws + WS_MODP))
#define MOD ((float*)(ws + WS_MOD))
#define LF ((float*)(ws + WS_LF))
#define CBR ((float*)(ws + WS_CBR))
#define SSQB ((float*)(ws + WS_SSQ))
#define SSQ2B ((float*)(ws + WS_SSQ2))
#define WDT ((bf16_t*)(ws + WS_WDT))
#define W1T ((bf16_t*)(ws + WS_W1T))
#define WGT ((bf16_t*)(ws + WS_WGT))
#define WOT ((bf16_t*)(ws + WS_WOT))
#define WUT ((bf16_t*)(ws + WS_WUT))
#define GC ((bf16_t*)(ws + WS_GC))
#define WEND ((bf16_t*)(ws + WS_WEND))
#define AALL ((bf16_t*)(ws + WS_AALL))
#define QKV ((bf16_t*)(ws + WS_QKV))
#define YB ((bf16_t*)(ws + WS_YB))
#define MIX ((bf16_t*)(ws + WS_MIX))
#define HN ((bf16_t*)(ws + WS_HN))
#define ABUF ((bf16_t*)(ws + WS_ABUF))
#define BBUF ((bf16_t*)(ws + WS_BBUF))
#define XIN (a.in[0])
#define OUT (a.out)


    {
        LAS f32x4_t* red = (LAS f32x4_t*)lds; const float* cvec = a.in[1]; const float* w_ada = a.in[2];
        for (int it = bid; it < 768; it += G) {
            const int nc = it % 48, ks = it / 48, n0 = nc * 256, k0 = ks * 128 + wave * 16;
            f32x4_t acc = {0.f, 0.f, 0.f, 0.f};
#pragma unroll
            for (int r = 0; r < 16; ++r) { const int k = k0 + r; const float cv = cvec[k]; const float sv = cv / (1.0f + expf(-cv));
                const f32x4_t w = *(const f32x4_t*)(w_ada + (size_t)k * (6 * DM) + n0 + 4 * lane); acc += sv * w; }
            red[wave * 64 + lane] = acc;
            __syncthreads();
            if (tid < 256) { float s = 0.f;
#pragma unroll
                for (int w = 0; w < 8; ++w) s += ((LAS float*)red)[w * 256 + tid];
                MODP[ks * (6 * DM) + n0 + tid] = s; }
            __syncthreads();
        }
    }
    for (int it = bid; it < 4 * NG; it += G) ssm_setup_item(a, ws, lds, it >> 2, it & 3, tid);
    __syncthreads();
    {
        LAS float* scr = (LAS float*)(lds + wave * 16384);
        constexpr int I_IN = 32 * 128, I_GLU = 16 * 32, I_OUT = 32 * 64, I_UP = 32 * 352, I_DN = 88 * 64, I_ALL = I_IN + I_GLU + I_OUT + I_UP + I_DN;
        for (int it = gw; it < I_ALL; it += NGW) {
            int r = it;
            if (r < I_IN) { const int kb = r / 128, n0 = 32 * (r % 128); tr_item(a.in[5], INW, n0 < 3072 ? n0 : n0 + 8, 64 * kb, W1T, DM, n0, nullptr, nullptr, scr, lane); continue; } r -= I_IN;
            if (r < I_GLU) { const int kb = r / 32, n0 = 32 * (r % 32); tr_item(a.in[15], SW, n0, 64 * kb, WGT, SW, n0, nullptr, nullptr, scr, lane); continue; } r -= I_GLU;
            if (r < I_OUT) { const int kb = r / 64, n0 = 32 * (r % 64); tr_item(a.in[19], DM, n0, 64 * kb, WOT, DM, n0, a.in[17], a.in[18], scr, lane); continue; } r -= I_OUT;
            if (r < I_UP) { const int kb = r / 352, n0 = 32 * (r % 352); const int pn = n0 >> 8, bj = (n0 >> 7) & 1, w = n0 & 127;
                tr_item(a.in[21], 2 * DFF, bj * DFF + 128 * pn + w, 64 * kb, WUT, DM, n0, nullptr, nullptr, scr, lane); continue; } r -= I_UP;
            { const int kb = r / 64, n0 = 32 * (r % 64); tr_item(a.in[24], DM, n0, 64 * kb, WDT, DFF, n0, nullptr, nullptr, scr, lane); }
        }
    }
    GRID_BAR();

    {
        LAS float* gs = (LAS float*)lds; LAS float* shv = gs + DM; LAS float* wf = shv + DM;
        const float* b_ada = a.in[3]; const float* g_mix = a.in[4]; const float* w_in = a.in[5];
        for (int k = tid; k < DM; k += 512) { float sh = b_ada[k], sc = b_ada[DM + k];
            for (int j = 0; j < 16; ++j) { sh += MODP[j * (6 * DM) + k]; sc += MODP[j * (6 * DM) + DM + k]; }
            gs[k] = g_mix[k] * (1.0f + sc); shv[k] = sh; }
        for (int i = tid; i < DM * 8; i += 512) wf[i] = w_in[(size_t)(i >> 3) * INW + 3072 + (i & 7)];
        for (int n = bid * 512 + tid; n < 6 * DM; n += G * 512) { float m = b_ada[n]; for (int j = 0; j < 16; ++j) m += MODP[j * (6 * DM) + n]; MOD[n] = m; }
        __syncthreads();
        const float* b_f = a.in[6];
        for (int row = gw; row < SEQ; row += NGW) {
            f32x4_t v[8]; norm_mod_row(XIN + (size_t)row * DM, HN + (size_t)row * DM, gs, shv, lane, v);
            f32x4_t f0 = {0.f, 0.f, 0.f, 0.f}, f1 = {0.f, 0.f, 0.f, 0.f};
#pragma unroll
            for (int j = 0; j < 8; ++j)
#pragma unroll
                for (int e = 0; e < 4; ++e) { const int k = 4 * lane + 256 * j + e; const f32x4_t w0 = *(const LAS f32x4_t*)(wf + k * 8), w1 = *(const LAS f32x4_t*)(wf + k * 8 + 4);
                    f0 += v[j][e] * w0; f1 += v[j][e] * w1; }
            float fd = 0.f;
#pragma unroll
            for (int h = 0; h < 8; ++h) { const float t = wave_sum(h < 4 ? f0[h & 3] : f1[h & 3]); if (lane == h) fd = t; }
            if (lane < 8) { const float z = fd + b_f[lane]; LF[lane * SEQ + row] = fminf(z, 0.f) - log1pf(expf(-fabsf(z))); }
        }
    }
    GRID_BAR();

    if (bid < NH) {
        LAS double* tot = (LAS double*)lds; const int h = bid; const float* src = LF + h * SEQ + tid * 16;
        float vals[16];
#pragma unroll
        for (int q = 0; q < 4; ++q) { const f32x4_t t = *(const f32x4_t*)(src + 4 * q); vals[4 * q] = t[0]; vals[4 * q + 1] = t[1]; vals[4 * q + 2] = t[2]; vals[4 * q + 3] = t[3]; }
        double run = 0.0;
#pragma unroll
        for (int e = 0; e < 16; ++e) run += (double)vals[e];
        tot[tid] = run;
        __syncthreads();
        double c = 0.0; for (int i = 0; i < tid; ++i) c += tot[i];
        float* dst = CBR + h * SEQ + tid * 16;
#pragma unroll
        for (int e = 0; e < 16; ++e) { c += (double)vals[e]; dst[e] = -(float)(c * 11.313708498984761); }
        __syncthreads();
    }
    {
        pg8::Gemm g{HN, W1T, SEQ, 4096, DM, DM, DM}; pg8::StaticOrder S; S.init(SEQ, 4096, G, bid);
        pg8::EpiQKVU E{QKV, AALL};
#ifndef NO_G1
        pg8::gemm_phase<pg8::EpiQKVU, pg8::StaticOrder, true, true>(lds, g, S, E, wave);
#endif
    }
    GRID_BAR();

    {
        pg8::Gemm g{AALL, WEND, NG * NCH, NG * 256, CL * GCH, KA, CL * GCH}; pg8::CarryOrder S{G, bid};
        pg8::EpiCarry E{AALL, (const float*)(ws + WS_P32)};
#ifndef NO_G2
        pg8::gemm_phase<pg8::EpiCarry, pg8::CarryOrder, false, true>(lds, g, S, E, wave);
#endif
        if (bid >= NG && G > NG + 2) {
            const int nw = (G - NG) * 8, per = nw / 16, w = (bid - NG) * 8 + wave, ha = w / per, j = w - ha * per;
            if (ha < 16) {
                const bf16_t* base = QKV + (size_t)ha * SEQ * HD; float mx = 0.f;
                for (int q4 = j; q4 < SEQ / 4; q4 += per) {
                    const u32x4_t v = *(const u32x4_t*)(base + (size_t)(4 * q4 + (lane >> 4)) * HD + (lane & 15) * 8);
                    float s = bf_lo(v.x) * bf_lo(v.x) + bf_hi(v.x) * bf_hi(v.x) + bf_lo(v.y) * bf_lo(v.y) + bf_hi(v.y) * bf_hi(v.y)
                            + bf_lo(v.z) * bf_lo(v.z) + bf_hi(v.z) * bf_hi(v.z) + bf_lo(v.w) * bf_lo(v.w) + bf_hi(v.w) * bf_hi(v.w);
                    s += __shfl_xor(s, 1); s += __shfl_xor(s, 2); s += __shfl_xor(s, 4); s += __shfl_xor(s, 8);
                    mx = fmaxf(mx, s);
                }
                mx = fmaxf(mx, __shfl_xor(mx, 16)); mx = fmaxf(mx, __shfl_xor(mx, 32));
                if (lane == 0) atomicMax((unsigned*)(ws + WS_NRM) + ha, __float_as_uint(mx));
            }
        }
    }
    GRID_BAR();

    {
        using abf = att::bf16;
        char* ldsg = (char*)lds_raw;
        BIAS_LAS float* bias = (BIAS_LAS float*)(lds + att::BIAS_OFF);
        att::Seam<abf> Sm;
        if (bid < NH * (SEQ / att::QB)) { const int it = bid;
            const int head = it & 7, qb = (SEQ / att::QB - 1) - (it >> 3), P0 = qb * att::QB;
            const float qk = sqrtf(__uint_as_float(((const unsigned*)(ws + WS_NRM))[head]) * __uint_as_float(((const unsigned*)(ws + WS_NRM))[8 + head]));
            const float thr = 1131.4f + 2.02f * qk + 1.0f;
            const int jlo = __syncthreads_count((tid < P0 / 64) && (CBR[head * SEQ + P0] - CBR[head * SEQ + 64 * tid + 63] > thr));
            for (int k = 64 * jlo + tid * 4; k < P0 + att::QB; k += 2048) *(BIAS_LAS f32x4_t*)(bias + (k - 64 * jlo)) = *(const f32x4_t*)(CBR + head * SEQ + k);
            __syncthreads();
            att::BlockRef<abf, abf> cur;
            cur.Q = (const abf*)QKV + ((size_t)(0 * NH + head) * SEQ + P0) * HD; cur.K = (const abf*)QKV + (size_t)(1 * NH + head) * SEQ * HD; cur.V = (const abf*)QKV + (size_t)(2 * NH + head) * SEQ * HD;
            cur.O = (abf*)MIX + (size_t)P0 * DM + head * HD; cur.P0 = P0; cur.JLO = jlo; cur.SSQ = SSQB + (size_t)P0 * 32 + head;
#ifndef NO_ATT
            att::causal_swa_prime<abf, abf>(cur, 1 << 30, ldsg, Sm, wave);
            att::causal_swa_block<abf, abf>(cur, cur, SEQ, 1 << 30, ldsg, Sm, bias, wave);
#endif
        }
        asm volatile("s_waitcnt vmcnt(0)" ::: "memory");
        __syncthreads();
        pg8::Gemm g{AALL, GC, NG * NCH, NG * 512, KA, KA, KA}; pg8::ChunkOrder S{G, G - 1 - bid};
        pg8::EpiY E{YB};
#ifndef NO_G3
        pg8::gemm_phase<pg8::EpiY, pg8::ChunkOrder, true, true>(lds, g, S, E, wave);
#endif
    }
    GRID_BAR();

    {
        pg8::Gemm g{YB, WGT, SEQ, SW, SW, SW, SW}; pg8::StaticOrder S; S.init(SEQ, SW, G, bid);
        pg8::EpiGlu E{YB, MIX, a.in[16], SSQB};
#ifndef NO_G4
        pg8::gemm_phase<pg8::EpiGlu, pg8::StaticOrder, true, true>(lds, g, S, E, wave);
#endif
    }
    GRID_BAR();

    {
        pg8::Gemm g{MIX, WOT, SEQ, DM, DM, DM, DM}; pg8::StaticOrder S; S.init(SEQ, DM, G, bid);
        LAS float* rtab = (LAS float*)(lds + RING_BYTES);
        { pg8::Unit u0; if (S.next(0, u0) && tid < 256) { float ra, rs; pg8::EpiWout::rstds(SSQB, u0.pm * 256 + tid, ra, rs); rtab[2 * tid] = ra / rs; rtab[2 * tid + 1] = rs; } }
        __syncthreads();
        pg8::EpiWout E{rtab, XIN, MOD + 2 * DM, OUT};
#ifndef NO_G5
        pg8::gemm_phase<pg8::EpiWout, pg8::StaticOrder, true, true>(lds, g, S, E, wave);
#endif
    }
    GRID_BAR();

    {
        LAS float* gs = (LAS float*)lds; LAS float* shv = gs + DM; const float* g_ffn = a.in[20];
        for (int k = tid; k < DM; k += 512) { gs[k] = g_ffn[k] * (1.0f + MOD[4 * DM + k]); shv[k] = MOD[3 * DM + k]; }
        __syncthreads();
        for (int row = gw; row < SEQ; row += NGW) { f32x4_t v[8]; norm_mod_row(OUT + (size_t)row * DM, HN + (size_t)row * DM, gs, shv, lane, v); }
    }
    GRID_BAR();

    {
        pg8::Gemm g{HN, WUT, SEQ, 2 * DFF, DM, DM, DM}; pg8::StaticOrder S; S.init(SEQ, 2 * DFF, G, bid);
        pg8::EpiUpConv E{BBUF, (float*)(ws + WS_HALO), a.in[22], a.in[23], (LAS float*)(lds + RING_BYTES + 2048)};
#ifndef NO_G6
        pg8::gemm_phase<pg8::EpiUpConv, pg8::StaticOrder, true, true>(lds, g, S, E, wave);
#endif
    }
    GRID_BAR();

    {
        const float* cw = a.in[22]; const float* cbias = a.in[23]; const float* HALO = (const float*)(ws + WS_HALO);
        constexpr int NCC = DFF / 8;
        for (int id = bid * 512 + tid; id < 31 * 2 * NCC; id += G * 512) {
            const int cc = id % NCC, rr = id / NCC, r = rr & 1, pm = 1 + (rr >> 1), col = cc * 8;
            const float* hm2 = HALO + ((size_t)(pm - 1) * 6 + r) * DFF + col;
            const float* hm1 = r == 0 ? HALO + ((size_t)(pm - 1) * 6 + 1) * DFF + col : HALO + ((size_t)pm * 6 + 2) * DFF + col;
            const float* hc = HALO + ((size_t)pm * 6 + 2 + r) * DFF + col; const float* hb = HALO + ((size_t)pm * 6 + 4 + r) * DFF + col;
            float gv[8];
#pragma unroll
            for (int q = 0; q < 2; ++q) { const f32x4_t u0 = *(const f32x4_t*)(cw + col + 4 * q), u1 = *(const f32x4_t*)(cw + DFF + col + 4 * q), u2 = *(const f32x4_t*)(cw + 2 * DFF + col + 4 * q), u3 = *(const f32x4_t*)(cbias + col + 4 * q);
                const f32x4_t am2 = *(const f32x4_t*)(hm2 + 4 * q), am1 = *(const f32x4_t*)(hm1 + 4 * q), ac = *(const f32x4_t*)(hc + 4 * q), bv = *(const f32x4_t*)(hb + 4 * q);
#pragma unroll
                for (int e = 0; e < 4; ++e) { const float cv = u3[e] + u0[e] * am2[e] + u1[e] * am1[e] + u2[e] * ac[e]; gv[4 * q + e] = cv * fast_sigmoid(cv) * bv[e]; } }
            u32x4_t o; o.x = pk2(gv[0], gv[1]); o.y = pk2(gv[2], gv[3]); o.z = pk2(gv[4], gv[5]); o.w = pk2(gv[6], gv[7]);
            *(u32x4_t*)(BBUF + (size_t)(pm * 256 + r) * DFF + col) = o;
        }
    }
    GRID_BAR();

    {
        pg8::Gemm g{BBUF, WDT, SEQ, DM, DFF, DFF, DFF}; pg8::StaticOrder S; S.init(SEQ, DM, G, bid);
        pg8::EpiDown E{MOD + 5 * DM, OUT, SSQ2B};
#ifndef NO_G7
        pg8::gemm_phase<pg8::EpiDown, pg8::StaticOrder, true, true>(lds, g, S, E, wave);
#endif
    }
    GRID_BAR();

    {
        const float* gf = a.in[25];
        for (int row = gw; row < SEQ; row += NGW) {
            const float part = lane < 32 ? SSQ2B[(size_t)row * 32 + lane] : 0.f;
            const float rstd = 1.0f / sqrtf(wave_sum(part) * (1.0f / DM) + EPS);
            f32x4_t* orow = (f32x4_t*)(OUT + (size_t)row * DM) + lane; const f32x4_t* g4 = (const f32x4_t*)gf + lane;
#pragma unroll
            for (int j = 0; j < 8; ++j) orow[64 * j] = orow[64 * j] * rstd * g4[64 * j];
        }
    }
}

extern "C" void kernel_launch(void* const* d_in, const int* in_sizes, int n_in, void* d_out, int out_size, void* d_ws, size_t ws_size, hipStream_t stream) {
    static int grid = 0;
    if (grid == 0) {
        if (n_in != 26 || out_size != SEQ * DM || ws_size < WS_END) { fprintf(stderr, "kernel_launch: unexpected shapes (n_in %d out %d ws %zu)\n", n_in, out_size, ws_size); grid = -1; return; }
        int dev = 0, cus = 0, per_cu = 0;
        (void)hipGetDevice(&dev); (void)hipDeviceGetAttribute(&cus, hipDeviceAttributeMultiprocessorCount, dev);
        if (hipFuncSetAttribute((const void*)fwd_kernel, hipFuncAttributeMaxDynamicSharedMemorySize, LDS_BYTES) != hipSuccess) { fprintf(stderr, "kernel_launch: hipFuncSetAttribute failed\n"); grid = -1; return; }
        if (hipOccupancyMaxActiveBlocksPerMultiprocessor(&per_cu, (const void*)fwd_kernel, 512, LDS_BYTES) != hipSuccess || per_cu < 1) { fprintf(stderr, "kernel_launch: occupancy query gave %d\n", per_cu); per_cu = 1; }
        (void)hipGetLastError();
        grid = cus;
        if (grid > 256) grid = 256;
    }
    if (grid < 0) return;
    (void)hipMemsetAsync((char*)d_ws + WS_CTL, 0, CTL_ZERO_BYTES, stream);
    Args a{};
    for (int i = 0; i < 26; ++i) a.in[i] = (const float*)d_in[i];
    a.out = (float*)d_out; a.ws = (unsigned char*)d_ws;
    void* args[] = {&a};
    hipError_t e = hipLaunchCooperativeKernel((const void*)fwd_kernel, dim3(grid), dim3(512), args, LDS_BYTES, stream);
    if (e != hipSuccess) fprintf(stderr, "cooperative launch failed: %s (grid %d)\n", hipGetErrorString(e), grid);
}
```
